# Optimizing an MI355X kernel written in HIP

```python
import jax, jax.numpy as jnp
from jax import lax
import numpy as np

D_MODEL = 1024
BATCH = 16
SEQ = 2048
DEPTH = 4

N_MIXERS = 3
GRID_W = 64
PLE_DIM = 256
EPS = 1e-6
BLOCK_Q = 128

MLA_HEADS = 16
MLA_NOPE = 64
MLA_ROPE = 32
MLA_V = 64
MLA_Q_RANK = 256
MLA_KV_RANK = 128
MLA_THETA = 10000.0

SWA_HEADS = 16
SWA_KV_HEADS = 4
SWA_HEAD_DIM = 64
SWA_WINDOW = 128

AX_HEADS = 8
AX_KV_HEADS = 4
AX_HEAD_DIM = 128
AX_THETA = 10000.0

FFN_DIM = 2816
N_EXPERTS = 8
TOP_K = 2
EXPERT_DIM = 3584

N_MLA = (DEPTH + 2) // 3
N_SWA = (DEPTH + 1) // 3
N_AX = DEPTH // 3
N_DENSE = (DEPTH + 1) // 2
N_MOE = DEPTH // 2

kernel_name = 'hybrid_mla_swa_axial_moe_encoder'


def rms_norm(x, gain):
    xf = x.astype(jnp.float32)
    y = xf * lax.rsqrt(jnp.mean(xf * xf, axis=-1, keepdims=True) + EPS)
    return (y * gain.astype(jnp.float32)).astype(x.dtype)


def rope_tables(pos, dim, theta):
    inv = theta ** (-jnp.arange(0, dim, 2, dtype=jnp.float32) / dim)
    ang = pos.astype(jnp.float32)[:, None] * inv[None, :]
    return jnp.cos(ang), jnp.sin(ang)


def apply_rope(x, cos, sin):
    x1, x2 = jnp.split(x, 2, axis=-1)
    c = cos[:, None, :].astype(x.dtype)
    s = sin[:, None, :].astype(x.dtype)
    return jnp.concatenate([x1 * c - x2 * s, x1 * s + x2 * c], axis=-1)


def alibi_slopes(n):
    return jnp.asarray(2.0 ** (-8.0 * np.arange(1, n + 1) / n), dtype=jnp.float32)


def dense_block_attention(q, k, v, scale):
    B, S, Hq, dk = q.shape
    G = k.shape[2]
    R = Hq // G
    dv = v.shape[-1]
    nb = S // BLOCK_Q
    qb = q.reshape(B, nb, BLOCK_Q, G, R, dk).transpose(1, 0, 2, 3, 4, 5)

    def one_block(qi):
        s = jnp.einsum('bqgrd,bkgd->bgrqk', qi, k, preferred_element_type=jnp.float32) * scale
        pr = jax.nn.softmax(s, axis=-1)
        return jnp.einsum('bgrqk,bkgd->bqgrd', pr.astype(v.dtype), v)

    o = lax.map(one_block, qb)
    return o.transpose(1, 0, 2, 3, 4, 5).reshape(B, S, Hq * dv)


def windowed_attention(q, k, v, sink, scale):
    B, S, Hq, dk = q.shape
    G = k.shape[2]
    R = Hq // G
    dv = v.shape[-1]
    nb = S // BLOCK_Q
    W = SWA_WINDOW
    span = BLOCK_Q + 2 * W
    pad = ((0, 0), (W, W), (0, 0), (0, 0))
    kp = jnp.pad(k, pad)
    vp = jnp.pad(v, pad)
    qb = q.reshape(B, nb, BLOCK_Q, G, R, dk).transpose(1, 0, 2, 3, 4, 5)
    slopes = alibi_slopes(Hq).reshape(G, R)
    sink_f = sink.astype(jnp.float32).reshape(G, R)

    def one_block(args):
        j, qi = args
        start = j * BLOCK_Q
        kj = lax.dynamic_slice_in_dim(kp, start, span, axis=1)
        vj = lax.dynamic_slice_in_dim(vp, start, span, axis=1)
        t_pos = start + jnp.arange(BLOCK_Q)
        s_pos = start - W + jnp.arange(span)
        dist = jnp.abs(t_pos[:, None] - s_pos[None, :])
        valid = (dist <= W) & (s_pos[None, :] >= 0) & (s_pos[None, :] < S)
        logits = jnp.einsum('bqgrd,bkgd->bgrqk', qi, kj, preferred_element_type=jnp.float32) * scale
        logits = logits - slopes[:, :, None, None] * dist.astype(jnp.float32)
        logits = jnp.where(valid, logits, -jnp.inf)
        sink_col = jnp.broadcast_to(sink_f[None, :, :, None, None], logits.shape[:-1] + (1,))
        pr = jax.nn.softmax(jnp.concatenate([logits, sink_col], axis=-1), axis=-1)[..., :-1]
        return jnp.einsum('bgrqk,bkgd->bqgrd', pr.astype(vj.dtype), vj)

    o = lax.map(one_block, (jnp.arange(nb), qb))
    return o.transpose(1, 0, 2, 3, 4, 5).reshape(B, S, Hq * dv)


def mla_mixer(h, cos, sin, w_down, q_norm, w_uq, kv_norm, w_ukv, q_gain, k_gain, w_o):
    B, S, _ = h.shape
    down = h @ w_down
    c_q, c_kv, k_rope = jnp.split(down, [MLA_Q_RANK, MLA_Q_RANK + MLA_KV_RANK], axis=-1)
    q = (rms_norm(c_q, q_norm) @ w_uq).reshape(B, S, MLA_HEADS, MLA_NOPE + MLA_ROPE)
    kv = (rms_norm(c_kv, kv_norm) @ w_ukv).reshape(B, S, MLA_HEADS, MLA_NOPE + MLA_V)
    k_nope, v = jnp.split(kv, [MLA_NOPE], axis=-1)
    k_rope = jnp.broadcast_to(k_rope[:, :, None, :], (B, S, MLA_HEADS, MLA_ROPE))
    k = jnp.concatenate([k_nope, k_rope], axis=-1)
    q = rms_norm(q, q_gain)
    k = rms_norm(k, k_gain)
    q = jnp.concatenate([q[..., :MLA_NOPE], apply_rope(q[..., MLA_NOPE:], cos, sin)], axis=-1)
    k = jnp.concatenate([k[..., :MLA_NOPE], apply_rope(k[..., MLA_NOPE:], cos, sin)], axis=-1)
    o = dense_block_attention(q, k, v, (MLA_NOPE + MLA_ROPE) ** -0.5)
    return o @ w_o


def swa_mixer(h, w_qkv, q_gain, k_gain, sink, w_o):
    B, S, _ = h.shape
    qkv = h @ w_qkv
    q, k, v = jnp.split(qkv, [SWA_HEADS * SWA_HEAD_DIM, (SWA_HEADS + SWA_KV_HEADS) * SWA_HEAD_DIM], axis=-1)
    q = rms_norm(q.reshape(B, S, SWA_HEADS, SWA_HEAD_DIM), q_gain)
    k = rms_norm(k.reshape(B, S, SWA_KV_HEADS, SWA_HEAD_DIM), k_gain)
    v = v.reshape(B, S, SWA_KV_HEADS, SWA_HEAD_DIM)
    o = windowed_attention(q, k, v, sink, SWA_HEAD_DIM ** -0.5)
    return o @ w_o


def axial_mixer(h, cos_r, sin_r, cos_c, sin_c, w_qkv, q_gain, k_gain, w_o):
    B, S, _ = h.shape
    qkv = h @ w_qkv
    q, k, v = jnp.split(qkv, [AX_HEADS * AX_HEAD_DIM, (AX_HEADS + AX_KV_HEADS) * AX_HEAD_DIM], axis=-1)
    q = rms_norm(q.reshape(B, S, AX_HEADS, AX_HEAD_DIM), q_gain)
    k = rms_norm(k.reshape(B, S, AX_KV_HEADS, AX_HEAD_DIM), k_gain)
    v = v.reshape(B, S, AX_KV_HEADS, AX_HEAD_DIM)
    half = AX_HEAD_DIM // 2
    q = jnp.concatenate([apply_rope(q[..., :half], cos_r, sin_r), apply_rope(q[..., half:], cos_c, sin_c)], axis=-1)
    k = jnp.concatenate([apply_rope(k[..., :half], cos_r, sin_r), apply_rope(k[..., half:], cos_c, sin_c)], axis=-1)
    o = dense_block_attention(q, k, v, AX_HEAD_DIM ** -0.5)
    return o @ w_o


def swiglu(h, w_gate, w_up, w_down):
    return (jax.nn.silu(h @ w_gate) * (h @ w_up)) @ w_down


def moe_swiglu(h, w_router, b_router, w_gate, w_up, w_down):
    B, S, D = h.shape
    t = h.reshape(B * S, D)
    logits = (t @ w_router).astype(jnp.float32) + b_router.astype(jnp.float32)
    top_val, top_idx = lax.top_k(logits, TOP_K)
    top_w = jax.nn.softmax(top_val, axis=-1)
    gates = jnp.sum(jax.nn.one_hot(top_idx, N_EXPERTS, dtype=jnp.float32) * top_w[..., None], axis=1)
    out = jnp.zeros_like(t)
    for e in range(N_EXPERTS):
        y_e = swiglu(t, w_gate[e], w_up[e], w_down[e])
        out = out + gates[:, e:e + 1].astype(t.dtype) * y_e
    return out.reshape(B, S, D)


def setup_inputs(seed: int = 0) -> dict:
    key = jax.random.key(seed)
    ks = iter(jax.random.split(key, 40))

    def w(shape, fan_in):
        return jax.random.normal(next(ks), shape, jnp.float32) * (fan_in ** -0.5)

    def gain(shape):
        return 1.0 + 0.02 * jax.random.normal(next(ks), shape, jnp.float32)

    D = D_MODEL
    mla_down = MLA_Q_RANK + MLA_KV_RANK + MLA_ROPE
    mla_qk = MLA_NOPE + MLA_ROPE
    swa_qkv = (SWA_HEADS + 2 * SWA_KV_HEADS) * SWA_HEAD_DIM
    ax_qkv = (AX_HEADS + 2 * AX_KV_HEADS) * AX_HEAD_DIM
    return {
        'x': jax.random.normal(next(ks), (BATCH, SEQ, D), jnp.float32),
        'p': jax.random.normal(next(ks), (DEPTH, BATCH, SEQ, PLE_DIM), jnp.float32),
        'attn_norm': gain((DEPTH, D)),
        'ffn_norm': gain((DEPTH, D)),
        'ple_norm': gain((DEPTH, D)),
        'ple_w_in': w((DEPTH, PLE_DIM, D), PLE_DIM),
        'ple_w_gate': w((DEPTH, D, D), D),
        'mla_w_down': w((N_MLA, D, mla_down), D),
        'mla_q_norm': gain((N_MLA, MLA_Q_RANK)),
        'mla_w_uq': w((N_MLA, MLA_Q_RANK, MLA_HEADS * mla_qk), MLA_Q_RANK),
        'mla_kv_norm': gain((N_MLA, MLA_KV_RANK)),
        'mla_w_ukv': w((N_MLA, MLA_KV_RANK, MLA_HEADS * (MLA_NOPE + MLA_V)), MLA_KV_RANK),
        'mla_q_gain': gain((N_MLA, mla_qk)),
        'mla_k_gain': gain((N_MLA, mla_qk)),
        'mla_w_o': w((N_MLA, MLA_HEADS * MLA_V, D), MLA_HEADS * MLA_V),
        'swa_w_qkv': w((N_SWA, D, swa_qkv), D),
        'swa_q_gain': gain((N_SWA, SWA_HEAD_DIM)),
        'swa_k_gain': gain((N_SWA, SWA_HEAD_DIM)),
        'swa_sink': 0.5 * jax.random.normal(next(ks), (N_SWA, SWA_HEADS), jnp.float32),
        'swa_w_o': w((N_SWA, SWA_HEADS * SWA_HEAD_DIM, D), SWA_HEADS * SWA_HEAD_DIM),
        'ax_w_qkv': w((N_AX, D, ax_qkv), D),
        'ax_q_gain': gain((N_AX, AX_HEAD_DIM)),
        'ax_k_gain': gain((N_AX, AX_HEAD_DIM)),
        'ax_w_o': w((N_AX, AX_HEADS * AX_HEAD_DIM, D), AX_HEADS * AX_HEAD_DIM),
        'ffn_w_gate': w((N_DENSE, D, FFN_DIM), D),
        'ffn_w_up': w((N_DENSE, D, FFN_DIM), D),
        'ffn_w_down': w((N_DENSE, FFN_DIM, D), FFN_DIM),
        'moe_w_router': w((N_MOE, D, N_EXPERTS), D),
        'moe_b_router': 0.01 * jax.random.normal(next(ks), (N_MOE, N_EXPERTS), jnp.float32),
        'moe_w_gate': w((N_MOE, N_EXPERTS, D, EXPERT_DIM), D),
        'moe_w_up': w((N_MOE, N_EXPERTS, D, EXPERT_DIM), D),
        'moe_w_down': w((N_MOE, N_EXPERTS, EXPERT_DIM, D), EXPERT_DIM),
    }


def reference(x, p, attn_norm, ffn_norm, ple_norm, ple_w_in, ple_w_gate,
              mla_w_down, mla_q_norm, mla_w_uq, mla_kv_norm, mla_w_ukv, mla_q_gain, mla_k_gain, mla_w_o,
              swa_w_qkv, swa_q_gain, swa_k_gain, swa_sink, swa_w_o,
              ax_w_qkv, ax_q_gain, ax_k_gain, ax_w_o,
              ffn_w_gate, ffn_w_up, ffn_w_down,
              moe_w_router, moe_b_router, moe_w_gate, moe_w_up, moe_w_down):
    S = x.shape[1]
    pos = jnp.arange(S)
    ROWS = S // GRID_W
    row = jnp.repeat(jnp.arange(ROWS), GRID_W)
    col = pos % GRID_W
    cos_1d, sin_1d = rope_tables(pos, MLA_ROPE, MLA_THETA)
    cos_r, sin_r = rope_tables(row, AX_HEAD_DIM // 2, AX_THETA)
    cos_c, sin_c = rope_tables(col, AX_HEAD_DIM // 2, AX_THETA)

    for i in range(DEPTH):
        h = rms_norm(x, attn_norm[i])
        kind = i % N_MIXERS
        j = i // N_MIXERS
        if kind == 0:
            mix = mla_mixer(h, cos_1d, sin_1d, mla_w_down[j], mla_q_norm[j], mla_w_uq[j],
                            mla_kv_norm[j], mla_w_ukv[j], mla_q_gain[j], mla_k_gain[j], mla_w_o[j])
        elif kind == 1:
            mix = swa_mixer(h, swa_w_qkv[j], swa_q_gain[j], swa_k_gain[j], swa_sink[j], swa_w_o[j])
        else:
            mix = axial_mixer(h, cos_r, sin_r, cos_c, sin_c, ax_w_qkv[j], ax_q_gain[j], ax_k_gain[j], ax_w_o[j])
        x = x + mix

        h = rms_norm(x, ffn_norm[i])
        f = i // 2
        if i % 2 == 0:
            x = x + swiglu(h, ffn_w_gate[f], ffn_w_up[f], ffn_w_down[f])
        else:
            x = x + moe_swiglu(h, moe_w_router[f], moe_b_router[f], moe_w_gate[f], moe_w_up[f], moe_w_down[f])

        ple = (p[i] @ ple_w_in[i]) * jax.nn.sigmoid(rms_norm(x, ple_norm[i]) @ ple_w_gate[i])
        x = x + ple
    return x
```

```cpp
#include <hip/hip_runtime.h>
#include <cstdio>
#include <cstdint>

#ifndef MK_N_LAUNCHES
#define MK_N_LAUNCHES 1
#endif

#define GAS __attribute__((address_space(1)))
#define LAS __attribute__((address_space(3)))
typedef unsigned short bf16;
typedef short bf16x8 __attribute__((ext_vector_type(8)));
typedef float f32x4 __attribute__((ext_vector_type(4)));
typedef float f32x16 __attribute__((ext_vector_type(16)));
typedef unsigned u32x4 __attribute__((ext_vector_type(4)));
typedef unsigned u32x2 __attribute__((ext_vector_type(2)));
typedef float f32x2 __attribute__((ext_vector_type(2)));

constexpr int NB = 16, S = 2048, T = NB * S, D = 1024, DEPTH = 4;
constexpr int FF = 2816, EF = 3584, NE = 8, PLE = 256;
constexpr float EPS = 1e-6f, LOG2E = 1.4426950408889634f;
constexpr int NWAVES = 8, NTHREADS = 512;
constexpr int MOE_ROWS = 2 * T + NE * 256;

enum { I_X = 0, I_P, I_ATTN_NORM, I_FFN_NORM, I_PLE_NORM, I_PLE_W_IN, I_PLE_W_GATE, I_MLA_W_DOWN, I_MLA_Q_NORM, I_MLA_W_UQ, I_MLA_KV_NORM, I_MLA_W_UKV,
       I_MLA_Q_GAIN, I_MLA_K_GAIN, I_MLA_W_O, I_SWA_W_QKV, I_SWA_Q_GAIN, I_SWA_K_GAIN, I_SWA_SINK, I_SWA_W_O, I_AX_W_QKV, I_AX_Q_GAIN, I_AX_K_GAIN, I_AX_W_O,
       I_FFN_W_GATE, I_FFN_W_UP, I_FFN_W_DOWN, I_MOE_W_ROUTER, I_MOE_B_ROUTER, I_MOE_W_GATE, I_MOE_W_UP, I_MOE_W_DOWN, N_IN };

constexpr size_t MiB = 1u << 20;
constexpr size_t WS_CTL = 0, CTL_ZERO_BYTES = 8 * MiB;
constexpr size_t WS_WT = 8 * MiB;
constexpr size_t WS_WMOE = 72 * MiB;
constexpr size_t WS_XB = 240 * MiB;
constexpr size_t WS_PB = 304 * MiB;
constexpr size_t WS_MOEL = 368 * MiB;
constexpr size_t WS_ACT = 372 * MiB;
constexpr size_t WS_PT = 966 * MiB;
constexpr size_t WS_END = 1030 * MiB;
constexpr size_t A_C = 0, A_QR = 32 * MiB, A_KV = 128 * MiB, A_O = 288 * MiB;
constexpr size_t A_XA = 352 * MiB;
constexpr size_t A_HID = 0;
constexpr size_t A_Y = 462 * MiB;
static_assert((size_t)MOE_ROWS * EF * 2 <= A_Y && A_Y + (size_t)MOE_ROWS * D * 2 <= 594 * MiB, "act map");
constexpr size_t WT_DOWN = 0, WT_UQ = 1048576, WT_UKV = 1835008, WT_WO = 3145728, WT_SQKV = 7340032, WT_AQKV = 8912896, WT_FGU = 11010048, WT_FDN = 22544384,
                 WT_PIN = 28311552, WT_PG = 29360128, WT_TOTAL = 33554432;
static_assert(WT_TOTAL * 2 <= 64 * MiB, "weights");
constexpr size_t WM_GU = 0, WM_DN = (size_t)NE * 7168 * 1024;
constexpr int CW_BAR = 4096;
constexpr int CW_MOECNT = 16384;
constexpr int CW_ROUTEPUB = 32768;
constexpr size_t CTL_SS = 1 * MiB;
constexpr size_t CTL_SSC = CTL_SS + 12 * (size_t)T * 8;
static_assert(CTL_SSC + 4 * (size_t)T * 8 <= CTL_ZERO_BYTES, "ctl");
typedef unsigned long long ssq_t;

constexpr int RING_BYTES = 131072, MISC_OFF = RING_BYTES + 320, LDS_BYTES = 147456;

__device__ __forceinline__ unsigned f2bf(float f) { unsigned u = __builtin_bit_cast(unsigned, f); return (u + 0x7fffu + ((u >> 16) & 1u)) >> 16; }
__device__ __forceinline__ unsigned pk2(float lo, float hi) { return f2bf(lo) | (f2bf(hi) << 16); }
__device__ __forceinline__ unsigned hpk2(float lo, float hi) { unsigned r; asm volatile("v_cvt_pk_bf16_f32 %0, %1, %2" : "=v"(r) : "v"(lo), "v"(hi)); return r; }
__device__ __forceinline__ float bf2f(unsigned short b) { return __builtin_bit_cast(float, (unsigned)b << 16); }
__device__ __forceinline__ float bflo(unsigned w) { return __builtin_bit_cast(float, w << 16); }
__device__ __forceinline__ float bfhi(unsigned w) { return __builtin_bit_cast(float, w & 0xffff0000u); }
__device__ __forceinline__ float wave_sum(float v) {
#pragma unroll
    for (int o = 1; o < 64; o <<= 1) v += __shfl_xor(v, o);
    return v;
}
__device__ __forceinline__ float ss_get(const ssq_t* p, int m) { return (float)p[m] * (1.0f / 16777216.0f); }
__device__ __forceinline__ void ss_add(ssq_t* p, int m, float q) { atomicAdd(p + m, (ssq_t)(q * 16777216.0f)); }
__device__ __forceinline__ void ss_set(ssq_t* p, int m, float q) { p[m] = (ssq_t)(q * 16777216.0f); }
__device__ __forceinline__ void fast_sincos(float ang, float& sn, float& cs) { float r = ang * 0.15915494309189535f; r = r - floorf(r); sn = __builtin_amdgcn_sinf(r); cs = __builtin_amdgcn_cosf(r); }
__device__ __forceinline__ int tid_now() { int t = threadIdx.x; asm volatile("" : "+v"(t)); return t; }
__device__ __forceinline__ int crow(int r, int hi) { return (r & 3) + 8 * (r >> 2) + 4 * hi; }
#define LDS_WAIT() asm volatile("s_waitcnt lgkmcnt(0)" ::: "memory")

#define XB_TMO      128
#define XB_XCNT(j)  (256  + 64 * (j))
#define XB_XSUB(j)  (1280 + 64 * (j))
#define XB_XGEN(j)  (2304 + 64 * (j))
#define XB_TOP      3328
#define XB_TOPGEN   3392
#define XCD_BAR_WORDS 3456
#define XB_SPIN_CAP (1u << 22)
__device__ __forceinline__ unsigned xb_ld(unsigned* p)              { return __hip_atomic_load(p, __ATOMIC_RELAXED, __HIP_MEMORY_SCOPE_AGENT); }
__device__ __forceinline__ unsigned xb_add(unsigned* p, unsigned v) { return __hip_atomic_fetch_add(p, v, __ATOMIC_RELAXED, __HIP_MEMORY_SCOPE_AGENT); }
__device__ __forceinline__ unsigned xb_xcc_id() { return (unsigned)__builtin_amdgcn_s_getreg((3 << 11) | 20) & 0xFu; }
#define XB_SPIN(cond, bar) do { unsigned _sp = 0; while (cond) { __builtin_amdgcn_s_sleep(1); \
    if ((++_sp & 255u) == 0u) { if (xb_ld(&(bar)[XB_TMO])) break; if (_sp > XB_SPIN_CAP) { atomicAdd(&(bar)[XB_TMO], 1u); break; } } } } while (0)
struct XcdBarrier { unsigned* bar; unsigned x; volatile LAS unsigned* st; };
__device__ __forceinline__ XcdBarrier xcd_barrier_post(unsigned* bar, volatile LAS unsigned* st) {
    XcdBarrier b; b.bar = bar; b.x = xb_xcc_id(); b.st = st;
    if (threadIdx.x == 0) (void)xb_add(&bar[XB_XCNT(b.x)], 1u);
    return b;
}
__device__ __forceinline__ void xcd_barrier_complete(unsigned* bar, unsigned x, unsigned& nloc, unsigned& nx) {
    const unsigned G = gridDim.x * gridDim.y * gridDim.z;
    unsigned sum, cnt, mine, sp = 0u;
    for (;;) {
        sum = 0u; cnt = 0u; mine = 0u;
#pragma unroll
        for (unsigned j = 0; j < 16; ++j) { const unsigned c = xb_ld(&bar[XB_XCNT(j)]); sum += c; cnt += (c > 0u) ? 1u : 0u; mine = (j == x) ? c : mine; }
        if (sum == G) break;
        __builtin_amdgcn_s_sleep(1);
        if ((++sp & 255u) == 0u) { if (xb_ld(&bar[XB_TMO])) break; if (sp > XB_SPIN_CAP) { atomicAdd(&bar[XB_TMO], 1u); break; } }
    }
    nloc = mine > 0u ? mine : 1u; nx = cnt > 0u ? cnt : 1u;
}
__device__ __forceinline__ void xcd_barrier(const XcdBarrier& b) {
    asm volatile("s_waitcnt vmcnt(0)" ::: "memory");
    __syncthreads();
    if (threadIdx.x == 0) {
        unsigned* bar = b.bar;
        __builtin_amdgcn_s_waitcnt(0);
        unsigned nloc = b.st[0], nx = b.st[1];
        if (nloc == 0u) { xcd_barrier_complete(bar, b.x, nloc, nx); b.st[0] = nloc; b.st[1] = nx; }
        const unsigned old = xb_add(&bar[XB_XSUB(b.x)], 1u);
        const unsigned gen = old / nloc;
        if (old + 1u == (gen + 1u) * nloc) {
            __builtin_amdgcn_fence(__ATOMIC_RELEASE, "agent");
            asm volatile("s_waitcnt vmcnt(0)" ::: "memory");
            const unsigned og = xb_add(&bar[XB_TOP], 1u);
            const unsigned tg = og / nx;
            if (og + 1u == (tg + 1u) * nx) xb_add(&bar[XB_TOPGEN], 1u);
            else XB_SPIN(xb_ld(&bar[XB_TOPGEN]) == tg, bar);
            __builtin_amdgcn_fence(__ATOMIC_ACQUIRE, "agent");
            xb_add(&bar[XB_XGEN(b.x)], 1u);
            asm volatile("s_waitcnt vmcnt(0)" ::: "memory");
        } else {
            XB_SPIN(xb_ld(&bar[XB_XGEN(b.x)]) == gen, bar);
            __builtin_amdgcn_fence(__ATOMIC_ACQUIRE, "agent");
            asm volatile("s_waitcnt vmcnt(0)" ::: "memory");
        }
    }
    __syncthreads();
}

struct Args { const float* in[N_IN]; float* out; unsigned char* ws; int lo, hi; };
struct Frame {
    LAS unsigned char* lds; unsigned* ctl;
    int tid, lane, wave, gw, ngw;
};

__device__ __forceinline__ const float* cvt_src(int mode, int n0, const float* W, const float* W2, int nsrc) {
    if (mode == 0) return n0 < nsrc ? W + n0 : nullptr;
    if (mode == 1) { if (n0 < 1024) return W + (n0 >> 6) * 128 + (n0 & 63); const int n = n0 - 1024; return W + (n >> 6) * 128 + 64 + (n & 63); }
    const int tile = n0 / 256, w = n0 % 256; return w < 128 ? W + tile * 128 + w : W2 + tile * 128 + (w - 128);
}
__device__ __forceinline__ void cvt_load64(f32x4 (&v)[16], const float* s0, const float* s1, int ldw, int k0, int lane) {
    const int nl = lane & 15, kq = lane >> 4;
    const float* sp = (nl >> 3) ? s1 : s0;
    if (sp) { sp += (size_t)k0 * ldw + 4 * (nl & 7);
#pragma unroll
        for (int i = 0; i < 16; ++i) v[i] = __builtin_nontemporal_load((const f32x4*)(sp + (size_t)(8 * (i >> 1) + 2 * kq + (i & 1)) * ldw)); }
    else {
#pragma unroll
        for (int i = 0; i < 16; ++i) v[i] = (f32x4){0.f, 0.f, 0.f, 0.f}; }
}
__device__ __forceinline__ void cvt_finish64(const f32x4 (&v)[16], const float* gain, bf16* WT, int ldk, int dstrow0, int k0, LAS unsigned* scr, int lane) {
    const int nl = lane & 15, kq = lane >> 4;
    float g[16];
    if (gain) {
#pragma unroll
        for (int p = 0; p < 8; ++p) { const f32x2 gg = *(const f32x2*)(gain + k0 + 8 * p + 2 * kq); g[2 * p] = gg.x; g[2 * p + 1] = gg.y; } }
    else {
#pragma unroll
        for (int p = 0; p < 16; ++p) g[p] = 1.f; }
#pragma unroll
    for (int p = 0; p < 8; ++p) {
#pragma unroll
        for (int j = 0; j < 4; ++j) scr[(4 * nl + j) * 34 + 4 * p + kq] = hpk2(v[2 * p][j] * g[2 * p], v[2 * p + 1][j] * g[2 * p + 1]); }
    LDS_WAIT(); asm volatile("" ::: "memory");
    const int c = lane & 7;
#pragma unroll
    for (int r = 0; r < 8; ++r) { const int n = (lane >> 3) + 8 * r; const u32x2 lo_ = *(const LAS u32x2*)(scr + n * 34 + 4 * c), hi_ = *(const LAS u32x2*)(scr + n * 34 + 4 * c + 2);
        *(u32x4*)(WT + (size_t)(dstrow0 + n) * ldk + k0 + 8 * c) = (u32x4){lo_.x, lo_.y, hi_.x, hi_.y}; }
    LDS_WAIT(); asm volatile("" ::: "memory");
}
__device__ __forceinline__ void cvt_item64(const float* s0, const float* s1, int ldw, const float* gain, bf16* WT, int ldk, int dstrow0, int k0, LAS unsigned* scr, int lane) {
    f32x4 v[16]; cvt_load64(v, s0, s1, ldw, k0, lane); cvt_finish64(v, gain, WT, ldk, dstrow0, k0, scr, lane);
}
struct MoeCvtItem { const float* s0; const float* s1; const float* gain; bf16* dst; int ldw, ldk, n0, k0; };
__device__ __forceinline__ MoeCvtItem moe_cvt_item(int it, const float* Wg, const float* Wu, const float* Wd, const float* gain, bf16* WM) {
    const int e = it / 2688; int r = it - e * 2688; MoeCvtItem d;
    if (r < 1792) { const int kb = r / 112, nb = r - kb * 112, n0 = nb * 64, tile = n0 >> 8, w = n0 & 255; const float* base = (w < 128 ? Wg : Wu) + (size_t)e * D * EF + tile * 128 + (w & 127);
        d.s0 = base; d.s1 = base + 32; d.gain = gain; d.dst = WM + WM_GU + (size_t)e * 7168 * 1024; d.ldw = EF; d.ldk = 1024; d.n0 = n0; d.k0 = kb * 64; }
    else { r -= 1792; const int kb = r >> 4, nb = r & 15, n0 = nb * 64; const float* base = Wd + (size_t)e * EF * D + n0;
        d.s0 = base; d.s1 = base + 32; d.gain = nullptr; d.dst = WM + WM_DN + (size_t)e * 1024 * EF; d.ldw = D; d.ldk = EF; d.n0 = n0; d.k0 = kb * 64; }
    return d;
}
__device__ __forceinline__ void moe_cvt_all(const Frame& F, const float* Wg, const float* Wu, const float* Wd, const float* gain, bf16* WM) {
    LAS unsigned* scr = (LAS unsigned*)(F.lds + F.wave * 16384);
    constexpr int NIT = NE * 2688;
    for (int it = F.gw; it < NIT; it += F.ngw) {
        const MoeCvtItem da = moe_cvt_item(it, Wg, Wu, Wd, gain, WM);
        cvt_item64(da.s0, da.s1, da.ldw, da.gain, da.dst, da.ldk, da.n0, da.k0, scr, F.lane);
    }
}
__device__ __forceinline__ void cvt_job(const Frame& F, const float* W, const float* W2, int ldw, int nsrc, const float* gain, bf16* WT, int K, int Ndst, int mode, int wofs, int ldk = 0) {
    if (ldk == 0) ldk = K;
    LAS unsigned* scr = (LAS unsigned*)(F.lds + F.wave * 16384);
    const int nblk = Ndst / 64, nitems = (K / 64) * nblk;
    int start = F.gw - (wofs % F.ngw); if (start < 0) start += F.ngw;
    for (int it = start; it < nitems; it += F.ngw) {
        const int kb = it / nblk, nb = it % nblk, n0 = nb * 64;
        cvt_item64(cvt_src(mode, n0, W, W2, nsrc), cvt_src(mode, n0 + 32, W, W2, nsrc), ldw, gain, WT, ldk, n0, kb * 64, scr, F.lane);
    }
}

template <int NSUB, class P>
__device__ __forceinline__ void ngemm(const Frame& F, const P& p) {
    const int r32 = F.lane & 31, hi = F.lane >> 5;
    const int ntn = p.ntn(), ntiles = p.ntm() * ntn;
    for (int tile = F.gw; tile < ntiles; tile += F.ngw) {
        const int tm = tile / ntn, tn = tile % ntn;
        typename P::Ctx c;
        if (!p.setup(tm * 64, c)) continue;
        const bf16* a0 = p.arow(c, tm * 64 + r32) + hi * 8;
        const bf16* a1 = p.arow(c, tm * 64 + 32 + r32) + hi * 8;
        const bf16* b[NSUB];
#pragma unroll
        for (int s = 0; s < NSUB; ++s) b[s] = p.brow(c, s, tn * 32 + r32) + hi * 8;
        f32x16 acc[2][NSUB];
#pragma unroll
        for (int i = 0; i < 2; ++i)
#pragma unroll
            for (int s = 0; s < NSUB; ++s)
#pragma unroll
                for (int r = 0; r < 16; ++r) acc[i][s][r] = 0.f;
#pragma unroll 4
        for (int k = 0; k < p.K; k += 16) {
            const bf16x8 fa0 = *(const bf16x8*)(a0 + k), fa1 = *(const bf16x8*)(a1 + k);
#pragma unroll
            for (int s = 0; s < NSUB; ++s) { const bf16x8 fb = *(const bf16x8*)(b[s] + k);
                acc[0][s] = __builtin_amdgcn_mfma_f32_32x32x16_bf16(fa0, fb, acc[0][s], 0, 0, 0);
                acc[1][s] = __builtin_amdgcn_mfma_f32_32x32x16_bf16(fa1, fb, acc[1][s], 0, 0, 0); }
        }
#pragma unroll
        for (int i = 0; i < 2; ++i)
#pragma unroll
            for (int r = 0; r < 16; ++r) p.store(c, tm * 64 + 32 * i + crow(r, hi), tn * 32 + r32, acc[i][0][r], NSUB > 1 ? acc[i][NSUB - 1][r] : 0.f);
    }
}
__device__ __forceinline__ float half_sum32(float v) {
#pragma unroll
    for (int o = 1; o < 32; o <<= 1) v += __shfl_xor(v, o);
    return v;
}
struct NoCtx {};
struct PlainP {
    typedef NoCtx Ctx;
    const bf16* A; int lda; const bf16* Bt; int M, N, K; bf16* O; int ldo; const ssq_t* rs; int rs_mode; float rs_inv_dim;
    ssq_t* st0; int st0_end; ssq_t* st1; int st1_end;
    __device__ int ntm() const { return M / 64; } __device__ int ntn() const { return N / 32; }
    __device__ bool setup(int, Ctx&) const { return true; }
    __device__ const bf16* arow(const Ctx&, int m) const { return A + (size_t)m * lda; }
    __device__ const bf16* brow(const Ctx&, int, int n) const { return Bt + (size_t)n * K; }
    __device__ void store(const Ctx&, int m, int n, float v, float) const {
        float sc = 1.f; if (rs_mode == 1) sc = 1.0f / sqrtf(ss_get(rs, m) * rs_inv_dim + EPS);
        v *= sc; O[(size_t)m * ldo + n] = (bf16)f2bf(v);
        const int n0 = n & ~31;
        if (st0 && n0 < st1_end) { const float q = half_sum32(v * v); if ((n & 31) == 0) ss_add(n0 < st0_end ? st0 : st1, m, q); }
    }
};
struct ResidP {
    typedef NoCtx Ctx;
    const bf16* A; int lda; const bf16* Bt; int M, N, K; const float* xsrc; float* out; bf16* xb; ssq_t* ss;
    __device__ int ntm() const { return M / 64; } __device__ int ntn() const { return N / 32; }
    __device__ bool setup(int, Ctx&) const { return true; }
    __device__ const bf16* arow(const Ctx&, int m) const { return A + (size_t)m * lda; }
    __device__ const bf16* brow(const Ctx&, int, int n) const { return Bt + (size_t)n * K; }
    __device__ void store(const Ctx&, int m, int n, float v, float) const {
        const size_t o = (size_t)m * D + n; const float x = xsrc[o] + v; out[o] = x; xb[o] = (bf16)f2bf(x);
        const float q = half_sum32(x * x); if ((n & 31) == 0) ss_add(ss, m, q);
    }
};
struct SwigluP {
    typedef NoCtx Ctx;
    const bf16* A; const bf16* Bt; int M, NH, K; bf16* H; const ssq_t* ss;
    __device__ int ntm() const { return M / 64; } __device__ int ntn() const { return NH / 32; }
    __device__ bool setup(int, Ctx&) const { return true; }
    __device__ const bf16* arow(const Ctx&, int m) const { return A + (size_t)m * D; }
    __device__ const bf16* brow(const Ctx&, int s, int n) const { return Bt + (size_t)((n >> 7) * 256 + (n & 127) + s * 128) * K; }
    __device__ void store(const Ctx&, int m, int n, float g, float u) const {
        const float sc = 1.0f / sqrtf(ss_get(ss, m) * (1.0f / D) + EPS); g *= sc; u *= sc;
        H[(size_t)m * NH + n] = (bf16)f2bf(g / (1.0f + __expf(-g)) * u);
    }
};
struct MoeCtx { int e, row0, cnt; };
__device__ __forceinline__ bool moe_find(const unsigned* cnt, int m0, MoeCtx& c) {
    int base = 0;
#pragma unroll
    for (int e = 0; e < NE; ++e) { const int n = (int)cnt[e * 64]; const int rows = ((n + 255) >> 8) << 8; if (m0 < base + rows) { c.e = e; c.row0 = base; c.cnt = n; return true; } base += rows; }
    return false;
}
struct MoeGuP {
    typedef MoeCtx Ctx;
    const bf16* XB; const bf16* Wgu; int K; bf16* H; const ssq_t* ss; const unsigned* cnt; const int* idx;
    __device__ int ntm() const { return MOE_ROWS / 64; } __device__ int ntn() const { return EF / 32; }
    __device__ bool setup(int m0, Ctx& c) const { return moe_find(cnt, m0, c); }
    __device__ int tok(const Ctx& c, int m) const { const int slot = m - c.row0; return slot < c.cnt ? idx[c.e * T + slot] : 0; }
    __device__ const bf16* arow(const Ctx& c, int m) const { return XB + (size_t)tok(c, m) * D; }
    __device__ const bf16* brow(const Ctx& c, int s, int n) const { return Wgu + ((size_t)c.e * 7168 + (n >> 7) * 256 + (n & 127) + s * 128) * K; }
    __device__ void store(const Ctx& c, int m, int n, float g, float u) const {
        const float sc = 1.0f / sqrtf(ss_get(ss, tok(c, m)) * (1.0f / D) + EPS); g *= sc; u *= sc;
        H[(size_t)m * EF + n] = (bf16)f2bf(g / (1.0f + __expf(-g)) * u);
    }
};
struct MoeDnP {
    typedef MoeCtx Ctx;
    const bf16* Hd; const bf16* Wdn; int K; bf16* Y; const unsigned* cnt; const float* wl;
    __device__ int ntm() const { return MOE_ROWS / 64; } __device__ int ntn() const { return D / 32; }
    __device__ bool setup(int m0, Ctx& c) const { return moe_find(cnt, m0, c); }
    __device__ const bf16* arow(const Ctx&, int m) const { return Hd + (size_t)m * EF; }
    __device__ const bf16* brow(const Ctx& c, int, int n) const { return Wdn + ((size_t)c.e * D + n) * K; }
    __device__ void store(const Ctx& c, int m, int n, float v, float) const {
        const int slot = m - c.row0; const float w = slot < c.cnt ? wl[c.e * T + slot] : 0.f;
        Y[(size_t)m * D + n] = (bf16)f2bf(v * w);
    }
};
struct PleP {
    typedef NoCtx Ctx;
    const bf16* A; const bf16* Bt; int M, N, K; const bf16* PT; float* out; bf16* xb; const ssq_t* ss; ssq_t* ssn;
    __device__ int ntm() const { return M / 64; } __device__ int ntn() const { return N / 32; }
    __device__ bool setup(int, Ctx&) const { return true; }
    __device__ const bf16* arow(const Ctx&, int m) const { return A + (size_t)m * D; }
    __device__ const bf16* brow(const Ctx&, int, int n) const { return Bt + (size_t)n * K; }
    __device__ void store(const Ctx&, int m, int n, float v, float) const {
        const size_t o = (size_t)m * D + n; const float sc = 1.0f / sqrtf(ss_get(ss, m) * (1.0f / D) + EPS);
        const float g = 1.0f / (1.0f + __expf(-v * sc)); const float x = out[o] + bf2f(PT[o]) * g; out[o] = x; xb[o] = (bf16)f2bf(x);
        if (ssn) { const float q = half_sum32(x * x); if ((n & 31) == 0) ss_add(ssn, m, q); }
    }
};


namespace pg8 {
constexpr int BM = 256, BK = 64, HALF = 128, HTB = HALF * BK * 2, STAGE_BYTES = 8 * HTB, NXCD = 8, WGM = 8;
__host__ __device__ __forceinline__ int lds_byte(int r, int c) { const int st = (r >> 4) * 2 + (c >> 5), rr = r & 15, cc = c & 31, ob = rr * 64 + cc * 2; return st * 1024 + (ob ^ (((ob >> 9) & 1) << 5)); }
__host__ __device__ __forceinline__ void stage_rc(int b, int& R, int& C) { const int st = b / 1024, sb = b % 1024, swz = sb ^ (((sb >> 9) & 1) << 5); R = (st >> 1) * 16 + swz / 64; C = (st & 1) * 32 + (swz % 64) / 2; }
__host__ __device__ __forceinline__ int perm32(int rho) { const int n = rho >> 4, i = rho & 15; return 8 * (i >> 2) + 4 * n + (i & 3); }
struct Unit { int pm, pn, e, slot0, cnt, ks, aux; };
struct Gemm { const bf16* A; const bf16* Bt; int K, lda, ldb; };

struct StaticOrder {
    static constexpr bool GATHER = false;
    int nM, nN, nwg, G, c;
    __device__ __forceinline__ void init(int M, int N, int G_, int c_) { nM = M / BM; nN = N / BM; nwg = nM * nN; G = G_; c = c_; }
    __device__ __forceinline__ bool next(int i, Unit& u) const {
        const long L = (long)i * G + c; if (L >= nwg) return false;
        int wgid = (int)L; { const int q = nwg / NXCD, r = nwg % NXCD, xcd = wgid % NXCD, off = wgid / NXCD; wgid = (xcd < r ? xcd * (q + 1) : r * (q + 1) + (xcd - r) * q) + off; }
        const int nig = WGM * nN, gid = wgid / nig, fm = gid * WGM, gsz = (nM - fm) < WGM ? (nM - fm) : WGM;
        u.pm = fm + ((wgid % nig) % gsz); u.pn = (wgid % nig) / gsz; u.e = 0; u.slot0 = 0; u.cnt = 0; return true;
    }
    __device__ __forceinline__ const char* a_base(const Gemm& g, const Unit& u) const { return (const char*)g.A + (size_t)u.pm * ((size_t)BM * g.lda * 2); }
    __device__ __forceinline__ size_t k_off(const Unit&) const { return 0; }
    __device__ __forceinline__ void a_raw(const Unit&, const int (&)[2], int (&)[2][2]) const {}
    __device__ __forceinline__ void a_fin(const Unit&, const int (&)[2], const int (&)[2], int, const int (&)[2][2], unsigned (&)[2][2]) const {}
    __device__ __forceinline__ void a_offs(const Unit&, const int (&RA)[2], const int (&CA)[2], int lda, unsigned (&v)[2][2]) const {
#pragma unroll
        for (int h = 0; h < 2; ++h)
#pragma unroll
            for (int i = 0; i < 2; ++i) v[h][i] = (unsigned)((RA[i] + HALF * h) * lda + CA[i]) * 2u;
    }
};
template <bool GATHER_> struct GroupedOrder {
    static constexpr bool GATHER = GATHER_;
    int NT, G, c, nunits, nlim; const LAS int* tab; const int* idx;
    __device__ __forceinline__ void init(const unsigned* cnt, int NT_, int G_, int c_, const int* idx_, LAS int* tab_) { NT = NT_; G = G_; c = c_; idx = idx_; tab = tab_;
        __syncthreads();
        if (threadIdx.x < 8) tab_[threadIdx.x] = (int)cnt[threadIdx.x * 64];
        __syncthreads();
        if (threadIdx.x == 0) { int t = 0; tab_[8] = 0; for (int e = 0; e < 8; ++e) { t += (tab_[e] + 255) >> 8; tab_[9 + e] = t; } }
        __syncthreads();
        nunits = __builtin_amdgcn_readfirstlane(tab_[16]) * NT; nlim = nunits; }
    __device__ __forceinline__ bool next(int i, Unit& u) const {
        const int L = i * G + c; if (L >= nlim) return false;
        int wgid = L; { const int q = nlim / NXCD, r = nlim % NXCD, xcd = wgid % NXCD, off = wgid / NXCD; wgid = (xcd < r ? xcd * (q + 1) : r * (q + 1) + (xcd - r) * q) + off; }
        decode(wgid, u); return true;
    }
    __device__ __forceinline__ void decode(int wgid, Unit& u) const {
        const int nM = nunits / NT, nig = WGM * NT, gid = wgid / nig, fm = gid * WGM, gsz = (nM - fm) < WGM ? (nM - fm) : WGM, rem = wgid - gid * nig;
        const int mt = fm + rem % gsz, pnl = rem / gsz; int e = 0;
#pragma unroll
        for (int j = 1; j < 8; ++j) if (mt >= tab[8 + j]) e = j;
        e = __builtin_amdgcn_readfirstlane(e);
        u.pm = mt; u.pn = e * NT + pnl; u.e = e; u.slot0 = (mt - __builtin_amdgcn_readfirstlane(tab[8 + e])) * 256; u.cnt = __builtin_amdgcn_readfirstlane(tab[e]);
    }
    __device__ __forceinline__ const char* a_base(const Gemm& g, const Unit& u) const { return GATHER ? (const char*)g.A : (const char*)g.A + (size_t)u.pm * ((size_t)BM * g.lda * 2); }
    __device__ __forceinline__ size_t k_off(const Unit&) const { return 0; }
    __device__ __forceinline__ void a_raw(const Unit& u, const int (&RA)[2], int (&tk)[2][2]) const {
#pragma unroll
        for (int h = 0; h < 2; ++h)
#pragma unroll
            for (int i = 0; i < 2; ++i) tk[h][i] = GATHER ? __builtin_nontemporal_load(idx + u.e * T + u.slot0 + RA[i] + HALF * h) : 0;
    }
    __device__ __forceinline__ void a_fin(const Unit& u, const int (&RA)[2], const int (&CA)[2], int lda, const int (&tk)[2][2], unsigned (&v)[2][2]) const {
#pragma unroll
        for (int h = 0; h < 2; ++h)
#pragma unroll
            for (int i = 0; i < 2; ++i) { const int slot = u.slot0 + RA[i] + HALF * h; int raw = tk[h][i]; asm volatile("" : "+v"(raw));
                const int tok = slot < u.cnt ? raw : 0; v[h][i] = (unsigned)(tok * lda + CA[i]) * 2u; }
    }
    __device__ __forceinline__ void a_offs(const Unit& u, const int (&RA)[2], const int (&CA)[2], int lda, unsigned (&v)[2][2]) const {
#pragma unroll
        for (int h = 0; h < 2; ++h)
#pragma unroll
            for (int i = 0; i < 2; ++i) {
                if (GATHER) { const int slot = u.slot0 + RA[i] + HALF * h; int tok = __builtin_nontemporal_load(idx + u.e * T + slot); tok = slot < u.cnt ? tok : 0; v[h][i] = (unsigned)(tok * lda + CA[i]) * 2u; }
                else v[h][i] = (unsigned)((RA[i] + HALF * h) * lda + CA[i]) * 2u; }
    }
};

struct SliceOrder {
    static constexpr bool GATHER = false;
    GroupedOrder<false> go; int first, ntail, nslice, kbytes, G, c;
    __device__ __forceinline__ bool next(int i, Unit& u) const {
        const int j = i * G + c; if (j >= ntail * nslice) return false;
        const int ks = j / ntail; go.decode(first + (j - ks * ntail), u); u.ks = ks; u.aux = j; return true;
    }
    __device__ __forceinline__ const char* a_base(const Gemm& g, const Unit& u) const { return (const char*)g.A + (size_t)u.pm * ((size_t)BM * g.lda * 2) + (size_t)u.ks * kbytes; }
    __device__ __forceinline__ size_t k_off(const Unit& u) const { return (size_t)u.ks * kbytes; }
    __device__ __forceinline__ void a_raw(const Unit&, const int (&)[2], int (&)[2][2]) const {}
    __device__ __forceinline__ void a_fin(const Unit&, const int (&)[2], const int (&)[2], int, const int (&)[2][2], unsigned (&)[2][2]) const {}
    __device__ __forceinline__ void a_offs(const Unit&, const int (&RA)[2], const int (&CA)[2], int lda, unsigned (&v)[2][2]) const {
#pragma unroll
        for (int h = 0; h < 2; ++h)
#pragma unroll
            for (int i = 0; i < 2; ++i) v[h][i] = (unsigned)((RA[i] + HALF * h) * lda + CA[i]) * 2u;
    }
};

__device__ __forceinline__ unsigned cvt_pk_bf16(float lo, float hi) { unsigned r; asm volatile("v_cvt_pk_bf16_f32 %0, %1, %2" : "=v"(r) : "v"(lo), "v"(hi)); return r; }
struct EpiCache { int pm; };
__device__ __forceinline__ float rstd_of(const ssq_t* p, int row, float inv_dim) { return 1.0f / sqrtf((float)p[row] * (1.0f / 16777216.0f) * inv_dim + EPS); }
__device__ __forceinline__ float sumsq4(f32x4 v) { return (v[0] * v[0] + v[1] * v[1]) + (v[2] * v[2] + v[3] * v[3]); }

template <bool STATS> struct EpiPlain {
    static constexpr bool PERM = true;
    bf16* O; int ldo, ntile; const ssq_t* rs; float rs_inv_dim; const float* wl; ssq_t* st0; ssq_t* st1;
    __device__ __forceinline__ void operator()(const f32x4 (&acc)[2][2][4][2], const Unit& u, int wr, int wc, int fr, int fq, EpiCache& ec) const {
        const int pnl = u.pn - u.e * ntile, row0 = u.pm * BM + wr * 64 + fr, col0 = pnl * BM + wc * 32 + 8 * fq;
        float sc[2][4];
#pragma unroll
        for (int ai = 0; ai < 2; ++ai)
#pragma unroll
            for (int m = 0; m < 4; ++m) { const int r = ai * HALF + m * 16;
                if (rs) sc[ai][m] = rstd_of(rs, row0 + r, rs_inv_dim);
                else if (wl) { const int slot = u.slot0 + wr * 64 + fr + r; const float w_ = __builtin_nontemporal_load(wl + u.e * T + slot); sc[ai][m] = slot < u.cnt ? w_ : 0.f; }
                else sc[ai][m] = 1.f; }
#pragma unroll
        for (int ai = 0; ai < 2; ++ai)
#pragma unroll
            for (int m = 0; m < 4; ++m) { const int row = row0 + ai * HALF + m * 16; bf16* rowp = O + (size_t)row * ldo + col0; float q = 0.f;
#pragma unroll
                for (int bj = 0; bj < 2; ++bj) { const f32x4 v0 = acc[ai][bj][m][0] * sc[ai][m], v1 = acc[ai][bj][m][1] * sc[ai][m];
                    u32x4 w; w.x = cvt_pk_bf16(v0[0], v0[1]); w.y = cvt_pk_bf16(v0[2], v0[3]); w.z = cvt_pk_bf16(v1[0], v1[1]); w.w = cvt_pk_bf16(v1[2], v1[3]);
                    *(u32x4*)(rowp + bj * HALF) = w;
                    if (STATS) { if (pnl == 0 || bj == 0) q += sumsq4(v0) + sumsq4(v1); } }
                if (STATS) { q += __shfl_xor(q, 16); q += __shfl_xor(q, 32); if (fq == 0) ss_add(pnl == 0 ? st0 : st1, row, q); } }
    }
};
struct EpiPartial {
    static constexpr bool PERM = true;
    float* P;
    __device__ __forceinline__ void operator()(const f32x4 (&acc)[2][2][4][2], const Unit& u, int wr, int wc, int fr, int fq, EpiCache& ec) const {
        float* p = P + (size_t)u.aux * 65536 + (wr * 64 + fr) * 256 + wc * 32 + 8 * fq;
#pragma unroll
        for (int ai = 0; ai < 2; ++ai)
#pragma unroll
            for (int m = 0; m < 4; ++m)
#pragma unroll
                for (int bj = 0; bj < 2; ++bj) { float* q = p + (ai * HALF + m * 16) * 256 + bj * HALF; *(f32x4*)q = acc[ai][bj][m][0]; *(f32x4*)(q + 4) = acc[ai][bj][m][1]; }
    }
};
struct EpiPlainNP {
    static constexpr bool PERM = false;
    bf16* O; int ldo;
    __device__ __forceinline__ void operator()(const f32x4 (&acc)[2][2][4][2], const Unit& u, int wr, int wc, int fr, int fq, EpiCache& ec) const {
        const int row0 = u.pm * BM + wr * 64 + fr, col0 = u.pn * BM + wc * 32 + 4 * fq;
#pragma unroll
        for (int ai = 0; ai < 2; ++ai)
#pragma unroll
            for (int m = 0; m < 4; ++m) { bf16* rowp = O + (size_t)(row0 + ai * HALF + m * 16) * ldo + col0;
#pragma unroll
                for (int bj = 0; bj < 2; ++bj)
#pragma unroll
                    for (int n = 0; n < 2; ++n) { const f32x4 x = acc[ai][bj][m][n]; *(u32x2*)(rowp + bj * HALF + n * 16) = (u32x2){cvt_pk_bf16(x[0], x[1]), cvt_pk_bf16(x[2], x[3])}; } }
    }
};
template <bool ROPE> struct EpiKN {
    static constexpr bool PERM = true;
    bf16* O; int ldo, kt_lo, kt_hi, vshift; const ssq_t* rs; float rs_inv_dim; const float* kgain; const bf16* Crope; LAS float* part;
    __device__ __forceinline__ void operator()(const f32x4 (&acc)[2][2][4][2], const Unit& u, int wr, int wc, int fr, int fq, EpiCache& ec) const {
        const int pn = u.pn; const bool kn = pn >= kt_lo && pn < kt_hi;
        int fro = fr, fqo = fq; asm volatile("" : "+v"(fro), "+v"(fqo));
        const int row0 = u.pm * BM + wr * 64 + fro, col0 = pn * BM + (pn >= kt_hi ? vshift : 0) + wc * 32 + 8 * fqo, rt0 = wr * 64 + fro;
        if (!kn) {
#pragma unroll
            for (int ai = 0; ai < 2; ++ai)
#pragma unroll
                for (int m = 0; m < 4; ++m) { const int row = row0 + ai * HALF + m * 16; bf16* rowp = O + (size_t)row * ldo + col0; const float sc = rstd_of(rs, row, rs_inv_dim);
#pragma unroll
                    for (int bj = 0; bj < 2; ++bj) { const f32x4 v0 = acc[ai][bj][m][0] * sc, v1 = acc[ai][bj][m][1] * sc;
                        *(u32x4*)(rowp + bj * HALF) = (u32x4){cvt_pk_bf16(v0[0], v0[1]), cvt_pk_bf16(v0[2], v0[3]), cvt_pk_bf16(v1[0], v1[1]), cvt_pk_bf16(v1[2], v1[3])}; }
                    if (m & 1) asm volatile("" ::: "memory"); }
            return;
        }
#pragma unroll
        for (int ai = 0; ai < 2; ++ai)
#pragma unroll
            for (int m = 0; m < 4; ++m) { const float sc = rstd_of(rs, row0 + ai * HALF + m * 16, rs_inv_dim);
#pragma unroll
                for (int bj = 0; bj < 2; ++bj) { float q = (sumsq4(acc[ai][bj][m][0]) + sumsq4(acc[ai][bj][m][1])) * (sc * sc);
                    q += __shfl_xor(q, 16); q += __shfl_xor(q, 32);
                    if (fqo == 0) part[(rt0 + ai * HALF + m * 16) * 8 + bj * 4 + wc] = q; }
                if (m & 1) asm volatile("" ::: "memory"); }
        asm volatile("s_waitcnt lgkmcnt(0)" ::: "memory"); __builtin_amdgcn_s_barrier(); asm volatile("" ::: "memory");
        constexpr float HD = ROPE ? 96.0f : 64.0f;
        const int dcol = (wc & 1) * 32 + 8 * fqo;
        const f32x4 g0 = *(const f32x4*)(kgain + dcol), g1 = *(const f32x4*)(kgain + dcol + 4);
#pragma unroll
        for (int ai = 0; ai < 2; ++ai)
#pragma unroll
            for (int m = 0; m < 4; ++m) { const int row = row0 + ai * HALF + m * 16, rt = rt0 + ai * HALF + m * 16; bf16* rowp = O + (size_t)row * ldo + col0; const float sc = rstd_of(rs, row, rs_inv_dim);
                float rq = 0.f; f32x4 ka = {0.f, 0.f, 0.f, 0.f}, kb = {0.f, 0.f, 0.f, 0.f};
                if (ROPE) { const u32x2 wa = *(const u32x2*)(Crope + (size_t)row * 512 + 384 + 4 * fqo), wb = *(const u32x2*)(Crope + (size_t)row * 512 + 400 + 4 * fqo);
                    ka = (f32x4){bflo(wa.x), bfhi(wa.x), bflo(wa.y), bfhi(wa.y)}; kb = (f32x4){bflo(wb.x), bfhi(wb.x), bflo(wb.y), bfhi(wb.y)};
                    rq = sumsq4(ka) + sumsq4(kb); rq += __shfl_xor(rq, 16); rq += __shfl_xor(rq, 32);
                    const f32x4 ga = *(const f32x4*)(kgain + 64 + 4 * fqo), gb = *(const f32x4*)(kgain + 80 + 4 * fqo); ka = ka * ga; kb = kb * gb; }
                f32x4 cs4 = {1.f, 1.f, 1.f, 1.f}, sn4 = {0.f, 0.f, 0.f, 0.f};
                if (ROPE) { const int t = row & (S - 1);
#pragma unroll
                    for (int i = 0; i < 4; ++i) { float sn, cs; fast_sincos((float)t * exp2f(-(float)(2 * (4 * fqo + i)) * (13.287712379549449f / 32.0f)), sn, cs); cs4[i] = cs; sn4[i] = sn; } }
#pragma unroll
                for (int bj = 0; bj < 2; ++bj) { const float hs = part[rt * 8 + bj * 4 + wc] + part[rt * 8 + bj * 4 + (wc ^ 1)] + rq;
                    const float rh = 1.0f / sqrtf(hs * (1.0f / HD) + EPS), s_ = sc * rh;
                    const f32x4 v0 = acc[ai][bj][m][0] * s_ * g0, v1 = acc[ai][bj][m][1] * s_ * g1;
                    *(u32x4*)(rowp + bj * HALF) = (u32x4){cvt_pk_bf16(v0[0], v0[1]), cvt_pk_bf16(v0[2], v0[3]), cvt_pk_bf16(v1[0], v1[1]), cvt_pk_bf16(v1[2], v1[3])};
                    if (ROPE) {
                        const int h = (pn - kt_lo) * 4 + bj * 2 + (wc >> 1);
                        const f32x4 o = ((wc & 1) ? ka * sn4 + kb * cs4 : ka * cs4 - kb * sn4) * rh;
                        *(u32x2*)(O + (size_t)row * ldo + 1024 + h * 32 + 16 * (wc & 1) + 4 * fqo) = (u32x2){cvt_pk_bf16(o[0], o[1]), cvt_pk_bf16(o[2], o[3])}; } }
                asm volatile("" ::: "memory"); }
    }
};
__device__ __forceinline__ void unpack8f(const u32x4 w, f32x4& lo, f32x4& hi) { lo = (f32x4){bflo(w.x), bfhi(w.x), bflo(w.y), bfhi(w.y)}; hi = (f32x4){bflo(w.z), bfhi(w.z), bflo(w.w), bfhi(w.w)}; }
struct EpiResid {
    static constexpr bool PERM = true;
    const bf16* base; bf16* xb; ssq_t* ss;
    __device__ __forceinline__ void operator()(const f32x4 (&acc)[2][2][4][2], const Unit& u, int wr, int wc, int fr, int fq, EpiCache& ec) const {
        const int row0 = u.pm * BM + wr * 64 + fr, col0 = u.pn * BM + wc * 32 + 8 * fq;
        u32x4 bv[2][4][2];
#pragma unroll
        for (int ai = 0; ai < 2; ++ai)
#pragma unroll
            for (int m = 0; m < 4; ++m)
#pragma unroll
                for (int bj = 0; bj < 2; ++bj) bv[ai][m][bj] = *(const u32x4*)(base + (size_t)(row0 + ai * HALF + m * 16) * D + col0 + bj * HALF);
#pragma unroll
        for (int ai = 0; ai < 2; ++ai)
#pragma unroll
            for (int m = 0; m < 4; ++m) { const int row = row0 + ai * HALF + m * 16; const size_t off = (size_t)row * D + col0; float q = 0.f;
#pragma unroll
                for (int bj = 0; bj < 2; ++bj) { const size_t o = off + bj * HALF; f32x4 b0, b1; unpack8f(bv[ai][m][bj], b0, b1);
                    const f32x4 x0 = b0 + acc[ai][bj][m][0], x1 = b1 + acc[ai][bj][m][1];
                    *(u32x4*)(xb + o) = (u32x4){cvt_pk_bf16(x0[0], x0[1]), cvt_pk_bf16(x0[2], x0[3]), cvt_pk_bf16(x1[0], x1[1]), cvt_pk_bf16(x1[2], x1[3])}; q += sumsq4(x0) + sumsq4(x1); }
                q += __shfl_xor(q, 16); q += __shfl_xor(q, 32); if (fq == 0) ss_add(ss, row, q); }
    }
};
__device__ __forceinline__ float silu_mul(float g, float u) { return g * __builtin_amdgcn_rcpf(1.0f + __expf(-g)) * u; }
struct EpiSwiglu {
    static constexpr bool PERM = true;
    bf16* H; int ldh, ntile; const ssq_t* ss; const float* rsl; LAS float* ctab;
    __device__ __forceinline__ void operator()(const f32x4 (&acc)[2][2][4][2], const Unit& u, int wr, int wc, int fr, int fq, EpiCache& ec) const {
        const int pnl = u.pn - u.e * ntile, row0 = u.pm * BM + wr * 64 + fr, col0 = pnl * HALF + wc * 32 + 8 * fq;
        LAS float* tabw = ctab + (wr * 4 + wc) * 128 + fr;
        if (ec.pm != u.pm) {
            ec.pm = u.pm;
            if (fq == 0) {
#pragma unroll
                for (int ai = 0; ai < 2; ++ai)
#pragma unroll
                    for (int m = 0; m < 4; ++m) { const int r = ai * HALF + m * 16; float v_;
                        if (ss) v_ = rstd_of(ss, row0 + r, 1.0f / D);
                        else { const int slot = u.slot0 + wr * 64 + fr + r; const float w_ = __builtin_nontemporal_load(rsl + u.e * T + slot); v_ = slot < u.cnt ? w_ : 0.f; }
                        tabw[(ai * 4 + m) * 16] = v_; } }
            asm volatile("s_waitcnt lgkmcnt(0)" ::: "memory");
        }
#pragma unroll
        for (int ai = 0; ai < 2; ++ai)
#pragma unroll
            for (int m = 0; m < 4; ++m) { const int row = row0 + ai * HALF + m * 16; const float s_ = tabw[(ai * 4 + m) * 16], c1 = -s_ * LOG2E, s2 = s_ * s_;
                const f32x4 g0 = acc[ai][0][m][0], g1 = acc[ai][0][m][1], u0 = acc[ai][1][m][0], u1 = acc[ai][1][m][1];
#define SGL(g, u) (((g) * (u)) * (s2 * __builtin_amdgcn_rcpf(1.0f + __builtin_amdgcn_exp2f((g) * c1))))
                u32x4 w; w.x = cvt_pk_bf16(SGL(g0[0], u0[0]), SGL(g0[1], u0[1])); w.y = cvt_pk_bf16(SGL(g0[2], u0[2]), SGL(g0[3], u0[3]));
                w.z = cvt_pk_bf16(SGL(g1[0], u1[0]), SGL(g1[1], u1[1])); w.w = cvt_pk_bf16(SGL(g1[2], u1[2]), SGL(g1[3], u1[3]));
#undef SGL
                *(u32x4*)(H + (size_t)row * ldh + col0) = w; }
    }
};
__device__ __forceinline__ float sigm(float a) { return __builtin_amdgcn_rcpf(1.0f + __expf(-a)); }
struct EpiPle {
    static constexpr bool PERM = true;
    const bf16* PT; const bf16* base; bf16* xa; float* outf; const ssq_t* ss; ssq_t* ssn;
    __device__ __forceinline__ void operator()(const f32x4 (&acc)[2][2][4][2], const Unit& u, int wr, int wc, int fr, int fq, EpiCache& ec) const {
        const int row0 = u.pm * BM + wr * 64 + fr, col0 = u.pn * BM + wc * 32 + 8 * fq;
#pragma unroll
        for (int g = 0; g < 4; ++g) {
            const int ai = g >> 1, mb = (g & 1) * 2;
            u32x4 bv[2][2], pv[2][2]; float sc[2];
#pragma unroll
            for (int mm = 0; mm < 2; ++mm) { sc[mm] = rstd_of(ss, row0 + ai * HALF + (mb + mm) * 16, 1.0f / D);
#pragma unroll
                for (int bj = 0; bj < 2; ++bj) { const size_t o = (size_t)(row0 + ai * HALF + (mb + mm) * 16) * D + col0 + bj * HALF; bv[mm][bj] = *(const u32x4*)(base + o); pv[mm][bj] = *(const u32x4*)(PT + o); } }
#pragma unroll
            for (int mm = 0; mm < 2; ++mm) { const int m = mb + mm; const int row = row0 + ai * HALF + m * 16; const size_t off = (size_t)row * D + col0; const float s_ = sc[mm]; float q = 0.f;
#pragma unroll
                for (int bj = 0; bj < 2; ++bj) { const size_t o = off + bj * HALF; f32x4 b0, b1, p0, p1; unpack8f(bv[mm][bj], b0, b1); unpack8f(pv[mm][bj], p0, p1);
                    const f32x4 a0 = acc[ai][bj][m][0] * s_, a1 = acc[ai][bj][m][1] * s_; f32x4 x0, x1;
#pragma unroll
                    for (int i = 0; i < 4; ++i) { x0[i] = b0[i] + p0[i] * sigm(a0[i]); x1[i] = b1[i] + p1[i] * sigm(a1[i]); }
                    if (outf) { __builtin_nontemporal_store(x0, (f32x4*)(outf + o)); __builtin_nontemporal_store(x1, (f32x4*)(outf + o + 4)); }
                    else *(u32x4*)(xa + o) = (u32x4){cvt_pk_bf16(x0[0], x0[1]), cvt_pk_bf16(x0[2], x0[3]), cvt_pk_bf16(x1[0], x1[1]), cvt_pk_bf16(x1[2], x1[3])};
                    q += sumsq4(x0) + sumsq4(x1); }
                if (ssn) { q += __shfl_xor(q, 16); q += __shfl_xor(q, 32); if (fq == 0) ss_add(ssn, row, q); } }
        }
    }
};

template <class Epi, class Sched>
__device__ __forceinline__ void gemm_phase(LAS unsigned char* lds, const Gemm g, const Sched& S, const Epi& E) {
    const int tid = tid_now(), wid = __builtin_amdgcn_readfirstlane(tid >> 6), lane = tid & 63, wr = wid >> 2, wc = wid & 3, fr = lane & 15, fq = lane >> 4;
    const int K = g.K, nt = K / BK, lda = g.lda, ldb = g.ldb > 0 ? g.ldb : K;
    int RA[2], CA[2]; unsigned voffB[2];
#pragma unroll
    for (int i = 0; i < 2; ++i) { int R, C; stage_rc(tid * 16 + i * 8192, R, C); const int Rb = Epi::PERM ? ((R & ~31) + perm32(R & 31)) : R; RA[i] = R; CA[i] = C; voffB[i] = (unsigned)(Rb * ldb + C) * 2u; }
    const size_t kstep = (size_t)(BK * 2);
    const size_t hstep = (size_t)HALF * ldb * 2;
    const size_t tstep = 2 * hstep;
    const unsigned ldsw = (unsigned)wid * 1024u;
    const int aoff = lds_byte(wr * 64 + fr, fq * 8), boff = lds_byte(wc * 32 + fr, fq * 8);
#define PG8_SA(b, h) (((b) * 2 + (h)) * HTB)
#define PG8_SB(b, h) ((4 + (b) * 2 + (h)) * HTB)
#define PG8_STAGE(bufoff, gbase, voff) do { _Pragma("unroll") for (int _i = 0; _i < 2; ++_i) \
        __builtin_amdgcn_global_load_lds((const unsigned*)((const char*)(gbase) + (voff)[_i]), (LAS unsigned*)(lds + (bufoff) + ldsw + _i * 8192), 16, 0, 0); } while (0)
#define PG8_LDA(dst, b, h) do { _Pragma("unroll") for (int m = 0; m < 4; ++m) _Pragma("unroll") for (int k = 0; k < 2; ++k) dst[m][k] = *(const LAS bf16x8*)(lds + PG8_SA(b, h) + aoff + m * 2048 + k * 1024); } while (0)
#define PG8_LDB(dst, b, h) do { _Pragma("unroll") for (int n = 0; n < 2; ++n) _Pragma("unroll") for (int k = 0; k < 2; ++k) dst[n][k] = *(const LAS bf16x8*)(lds + PG8_SB(b, h) + boff + n * 2048 + k * 1024); } while (0)
#define PG8_MMA(ai, bj, At, Bt) do { __builtin_amdgcn_s_setprio(1); _Pragma("unroll") for (int m = 0; m < 4; ++m) _Pragma("unroll") for (int n = 0; n < 2; ++n) _Pragma("unroll") for (int k = 0; k < 2; ++k) \
        acc[ai][bj][m][n] = __builtin_amdgcn_mfma_f32_16x16x32_bf16(Bt[n][k], At[m][k], acc[ai][bj][m][n], 0, 0, 0); __builtin_amdgcn_s_setprio(0); } while (0)
#define PG8_WAIT_V(n) asm volatile("s_waitcnt vmcnt(" #n ")" ::: "memory")
#define PG8_WAIT_L(n) asm volatile("s_waitcnt lgkmcnt(" #n ")" ::: "memory")
#define PG8_BAR __builtin_amdgcn_s_barrier()
#define PG8_SCHED __builtin_amdgcn_sched_barrier(0)
    Unit cur, nxt; int ui = 0;
    if (!S.next(0, cur)) return;
    f32x4 acc[2][2][4][2];
#pragma unroll
    for (int a = 0; a < 2; ++a)
#pragma unroll
        for (int b = 0; b < 2; ++b)
#pragma unroll
            for (int m = 0; m < 4; ++m)
#pragma unroll
                for (int n = 0; n < 2; ++n) acc[a][b][m][n] = (f32x4){0.f, 0.f, 0.f, 0.f};
    bf16x8 At[4][2], B0[2][2], B1[2][2];
    unsigned vc[2][2], vn[2][2]; EpiCache ec; ec.pm = -1;
    S.a_offs(cur, RA, CA, lda, vc);
    const char* cA = S.a_base(g, cur); const char* cB = (const char*)g.Bt + (size_t)cur.pn * tstep + S.k_off(cur);
    PG8_STAGE(PG8_SB(0, 0), cB, voffB); PG8_STAGE(PG8_SB(0, 1), cB + hstep, voffB); PG8_STAGE(PG8_SA(0, 0), cA, vc[0]); PG8_STAGE(PG8_SA(0, 1), cA, vc[1]);
    if (wr == 1) PG8_BAR;
    PG8_WAIT_V(2); PG8_BAR;
    PG8_STAGE(PG8_SB(1, 0), cB + kstep, voffB); PG8_STAGE(PG8_SA(1, 0), cA + kstep, vc[0]); PG8_STAGE(PG8_SB(1, 1), cB + hstep + kstep, voffB);
    PG8_WAIT_V(6); PG8_BAR;
    for (;;) {
        const bool has_next = S.next(ui + 1, nxt);
        const char* nA = has_next ? S.a_base(g, nxt) : cA; const char* nB = has_next ? (const char*)g.Bt + (size_t)nxt.pn * tstep + S.k_off(nxt) : cB;
        int tkr[2][2]; const bool newpanel = has_next && nxt.pm != cur.pm;
        if (Sched::GATHER && newpanel) S.a_raw(nxt, RA, tkr);
#pragma nounroll
        for (int t = 0; t < nt; t += 2) {
            const bool last = (t == nt - 2);
            const char* a1 = cA + (size_t)(t + 1) * kstep;
            const char* a2 = last ? nA : cA + (size_t)(t + 2) * kstep; const char* b2 = last ? nB : cB + (size_t)(t + 2) * kstep;
            const char* a3 = a2 + kstep; const char* b3 = b2 + kstep;
            unsigned v2[2][2];
#pragma unroll
            for (int h = 0; h < 2; ++h)
#pragma unroll
                for (int i = 0; i < 2; ++i) v2[h][i] = vc[h][i];
            if (Sched::GATHER && last) {
                if (newpanel) S.a_fin(nxt, RA, CA, lda, tkr, vn);
#pragma unroll
                for (int h = 0; h < 2; ++h)
#pragma unroll
                    for (int i = 0; i < 2; ++i) { if (!newpanel) vn[h][i] = vc[h][i]; v2[h][i] = vn[h][i]; } }
            PG8_LDB(B0, 0, 0); PG8_LDB(B1, 0, 1); PG8_SCHED; PG8_LDA(At, 0, 0); PG8_STAGE(PG8_SA(1, 1), a1, vc[1]);
            PG8_WAIT_V(8); PG8_WAIT_L(0); PG8_BAR; PG8_MMA(0, 0, At, B0); PG8_MMA(0, 1, At, B1); PG8_BAR; PG8_SCHED;
            PG8_LDA(At, 0, 1); PG8_STAGE(PG8_SB(0, 0), b2, voffB); PG8_STAGE(PG8_SB(0, 1), b2 + hstep, voffB); PG8_STAGE(PG8_SA(0, 0), a2, v2[0]);
            PG8_WAIT_V(8); PG8_WAIT_L(0); PG8_BAR; PG8_MMA(1, 0, At, B0); PG8_MMA(1, 1, At, B1); PG8_BAR; PG8_SCHED;
            PG8_LDB(B0, 1, 0); PG8_LDB(B1, 1, 1); PG8_SCHED; PG8_LDA(At, 1, 0); PG8_STAGE(PG8_SA(0, 1), a2, v2[1]);
            PG8_WAIT_V(8); PG8_WAIT_L(0); PG8_BAR; PG8_MMA(0, 0, At, B0); PG8_MMA(0, 1, At, B1); PG8_BAR; PG8_SCHED;
            PG8_LDA(At, 1, 1); PG8_STAGE(PG8_SB(1, 0), b3, voffB); PG8_STAGE(PG8_SB(1, 1), b3 + hstep, voffB); PG8_STAGE(PG8_SA(1, 0), a3, v2[0]);
            PG8_WAIT_V(8); PG8_WAIT_L(0); PG8_BAR; PG8_MMA(1, 0, At, B0); PG8_MMA(1, 1, At, B1); PG8_BAR; PG8_SCHED;
        }
        if (wr == 0) PG8_BAR;
        E(acc, cur, wr, wc, fr, fq, ec);
        if (!has_next) break;
#pragma unroll
        for (int a = 0; a < 2; ++a)
#pragma unroll
            for (int b = 0; b < 2; ++b)
#pragma unroll
                for (int m = 0; m < 4; ++m)
#pragma unroll
                    for (int n = 0; n < 2; ++n) acc[a][b][m][n] = (f32x4){0.f, 0.f, 0.f, 0.f};
        cur = nxt; cA = nA; cB = nB; ++ui;
#pragma unroll
        for (int h = 0; h < 2; ++h)
#pragma unroll
            for (int i = 0; i < 2; ++i) vc[h][i] = Sched::GATHER ? vn[h][i] : vc[h][i];
        if (wr == 1) PG8_BAR;
    }
    PG8_WAIT_V(0);
    PG8_BAR;
#undef PG8_SA
#undef PG8_SB
#undef PG8_STAGE
#undef PG8_LDA
#undef PG8_LDB
#undef PG8_MMA
#undef PG8_WAIT_V
#undef PG8_WAIT_L
#undef PG8_BAR
#undef PG8_SCHED
}
}


namespace fa {
typedef short s16x4 __attribute__((ext_vector_type(4)));
#define FA_SBAR() __builtin_amdgcn_sched_barrier(0)
constexpr float THR2 = 11.5f;
template <int DK> __device__ __forceinline__ int kswz(int row, int colB) { return DK == 64 ? row * 128 + (colB ^ (((row >> 1) & 7) << 4)) : row * 256 + (colB ^ ((row & 7) << 4)); }
template <int NCB> __device__ __forceinline__ int v_st(int k, int c) { const int kk = (k & ~0xC) | ((k & 4) << 1) | ((k & 8) >> 1); return ((kk >> 3) * NCB + (c >> 5)) * 512 + ((kk & 7) * 32 + (c & 31)) * 2; }
__device__ __forceinline__ int v_rd_base(int lane) { return ((lane & 3) << 3) | (((lane >> 2) & 3) << 6) | (((lane >> 4) & 1) << 5) | (((lane >> 5) & 1) << 8); }
template <int OFF> __device__ __forceinline__ s16x4 tr_read(int vb) { s16x4 r; asm volatile("ds_read_b64_tr_b16 %0, %1 offset:%2" : "=&v"(r) : "v"(vb), "i"(OFF) : "memory"); return r; }
__device__ __forceinline__ unsigned cvtpk(float lo, float hi) { unsigned r; asm volatile("v_cvt_pk_bf16_f32 %0, %1, %2" : "=v"(r) : "v"(lo), "v"(hi)); return r; }

constexpr float C0 = 8.0f;
__device__ __forceinline__ void partialSM(f32x16& p0) {
#pragma unroll
  for (int r = 0; r < 16; ++r) p0[r] = __builtin_amdgcn_exp2f(p0[r]);
}
__device__ __forceinline__ void finishSM(f32x16& p0, f32x16& p1, float& l_reg, bf16x8& pa0, bf16x8& pa1, bf16x8& pa2, bf16x8& pa3) {
#pragma unroll
  for (int r = 0; r < 16; ++r) p1[r] = __builtin_amdgcn_exp2f(p1[r]);
  float ps = 0;
#pragma unroll
  for (int r = 0; r < 16; ++r) ps += p0[r];
#pragma unroll
  for (int r = 0; r < 16; ++r) ps += p1[r];
  { auto rr = __builtin_amdgcn_permlane32_swap(__float_as_uint(ps), __float_as_uint(ps), false, false); ps = __uint_as_float(rr[0]) + __uint_as_float(rr[1]); }
  l_reg += ps;
#define FA_PK4(P, BASE, OUT) do { unsigned a0 = cvtpk(P[BASE + 0], P[BASE + 1]), a1 = cvtpk(P[BASE + 2], P[BASE + 3]);   \
    unsigned b0 = cvtpk(P[BASE + 4], P[BASE + 5]), b1 = cvtpk(P[BASE + 6], P[BASE + 7]);                              \
    auto r0 = __builtin_amdgcn_permlane32_swap(a0, b0, false, false); auto r1 = __builtin_amdgcn_permlane32_swap(a1, b1, false, false); \
    u32x4 w = {r0[0], r1[0], r0[1], r1[1]}; OUT = __builtin_bit_cast(bf16x8, w); } while (0)
  FA_PK4(p0, 0, pa0); FA_PK4(p0, 8, pa1); FA_PK4(p1, 0, pa2); FA_PK4(p1, 8, pa3);
#undef FA_PK4
}
__device__ __forceinline__ void swa_mask(f32x16& p0, f32x16& p1, int kt, int tq, int hi, float slope2) {
  const int kb = kt + 4 * hi - tq;
#pragma unroll
  for (int r = 0; r < 16; ++r) { int d = kb + (r & 3) + 8 * (r >> 2); int d2 = d + 32; d = d < 0 ? -d : d; d2 = d2 < 0 ? -d2 : d2;
    p0[r] = d <= 128 ? p0[r] - slope2 * (float)d : -INFINITY; p1[r] = d2 <= 128 ? p1[r] - slope2 * (float)d2 : -INFINITY; }
}
__device__ __forceinline__ void swa_maskf(f32x16& p0, f32x16& p1, int kt, int tq, int hi, float slope2) {
  const float kb = (float)(kt + 4 * hi - tq), ns = -slope2;
#pragma unroll
  for (int r = 0; r < 16; ++r) { const float x = kb + (float)((r & 3) + 8 * (r >> 2)), x2 = kb + (float)((r & 3) + 8 * (r >> 2) + 32);
    const float t0 = __builtin_fmaf(ns, __builtin_fabsf(x), p0[r]), t1 = __builtin_fmaf(ns, __builtin_fabsf(x2), p1[r]);
    p0[r] = __builtin_fabsf(x) <= 128.0f ? t0 : -INFINITY; p1[r] = __builtin_fabsf(x2) <= 128.0f ? t1 : -INFINITY; }
}
__device__ __forceinline__ void swa_bias(f32x16& p0, f32x16& p1, int kt, int tq, int hi, float slope2) {
  const float kb = (float)(kt + 4 * hi - tq), ns = -slope2;
#pragma unroll
  for (int r = 0; r < 16; ++r) { const float x = kb + (float)((r & 3) + 8 * (r >> 2)), x2 = kb + (float)((r & 3) + 8 * (r >> 2) + 32);
    p0[r] = __builtin_fmaf(ns, __builtin_fabsf(x), p0[r]); p1[r] = __builtin_fmaf(ns, __builtin_fabsf(x2), p1[r]); }
}
template <int DK> __device__ __forceinline__ void qkt(f32x16& p0, f32x16& p1, const LAS unsigned char* Ks, const bf16x8* qr, int r32, int hi) {
#pragma unroll
  for (int r = 0; r < 16; ++r) { p0[r] = -C0; p1[r] = -C0; }
#pragma unroll
  for (int d0 = 0; d0 < DK / 16; ++d0) { const int cb = (d0 * 16 + hi * 8) * 2;
    const bf16x8 b0 = *(const LAS bf16x8*)(Ks + kswz<DK>(r32, cb));
    const bf16x8 b1 = *(const LAS bf16x8*)(Ks + kswz<DK>(32 + r32, cb));
    p0 = __builtin_amdgcn_mfma_f32_32x32x16_bf16(b0, qr[d0], p0, 0, 0, 0);
    p1 = __builtin_amdgcn_mfma_f32_32x32x16_bf16(b1, qr[d0], p1, 0, 0, 0); }
}
template <int DK> __device__ __forceinline__ void qkt4(f32x16& p0, f32x16& p1, const LAS unsigned char* const (&ka)[4], int boff, const bf16x8* qr) {
  constexpr int RSK_ = (DK == 64) ? 128 : 256;
#pragma unroll
  for (int r = 0; r < 16; ++r) { p0[r] = -C0; p1[r] = -C0; }
#pragma unroll
  for (int d0 = 0; d0 < DK / 16; ++d0) { const LAS unsigned char* a_ = ka[d0 & 3] + boff + (d0 >> 2) * 128;
    const bf16x8 b0 = *(const LAS bf16x8*)(a_);
    const bf16x8 b1 = *(const LAS bf16x8*)(a_ + 32 * RSK_);
    p0 = __builtin_amdgcn_mfma_f32_32x32x16_bf16(b0, qr[d0], p0, 0, 0, 0);
    p1 = __builtin_amdgcn_mfma_f32_32x32x16_bf16(b1, qr[d0], p1, 0, 0, 0); }
}
template <int NCB, int D0> __device__ __forceinline__ void pv_one(f32x16& od, int vb, bf16x8 pa0, bf16x8 pa1, bf16x8 pa2, bf16x8 pa3) {
  constexpr int KS = 2 * NCB * 512, HF = NCB * 512;
  const s16x4 l0 = tr_read<D0 * 512 + 0 * KS>(vb), h0 = tr_read<D0 * 512 + 0 * KS + HF>(vb), l1 = tr_read<D0 * 512 + 1 * KS>(vb), h1 = tr_read<D0 * 512 + 1 * KS + HF>(vb);
  const s16x4 l2 = tr_read<D0 * 512 + 2 * KS>(vb), h2 = tr_read<D0 * 512 + 2 * KS + HF>(vb), l3 = tr_read<D0 * 512 + 3 * KS>(vb), h3 = tr_read<D0 * 512 + 3 * KS + HF>(vb);
  asm volatile("s_waitcnt lgkmcnt(0)" ::: "memory"); FA_SBAR();
#define FA_PK(L, H) (bf16x8){L[0], L[1], L[2], L[3], H[0], H[1], H[2], H[3]}
  od = __builtin_amdgcn_mfma_f32_32x32x16_bf16(pa0, FA_PK(l0, h0), od, 0, 0, 0);
  od = __builtin_amdgcn_mfma_f32_32x32x16_bf16(pa1, FA_PK(l1, h1), od, 0, 0, 0);
  od = __builtin_amdgcn_mfma_f32_32x32x16_bf16(pa2, FA_PK(l2, h2), od, 0, 0, 0);
  od = __builtin_amdgcn_mfma_f32_32x32x16_bf16(pa3, FA_PK(l3, h3), od, 0, 0, 0);
#undef FA_PK
}
template <int NCB> __device__ __forceinline__ void pv_d0(f32x16* o, int vb, bf16x8 pa0, bf16x8 pa1, bf16x8 pa2, bf16x8 pa3) {
  pv_one<NCB, 0>(o[0], vb, pa0, pa1, pa2, pa3); pv_one<NCB, 1>(o[1], vb, pa0, pa1, pa2, pa3);
  if constexpr (NCB == 4) { pv_one<NCB, 2>(o[2], vb, pa0, pa1, pa2, pa3); pv_one<NCB, 3>(o[3], vb, pa0, pa1, pa2, pa3); }
}

template <int DK, int DV, int MODE, int QMODE, int LDQ, int LDK, int LDV, int LDO, int SD>
__device__ __forceinline__ void attn_unit(const bf16* __restrict__ Qb, const bf16* __restrict__ Kh, const bf16* __restrict__ Vh, bf16* __restrict__ Ob, int NT, int tq0, int klo, float slope2, float sink2, const float* __restrict__ qgain, int krope_off, LAS unsigned char* lds) {
  constexpr int NCB = DV / 32, NQ = DK / 16, RSK = (DK == 64) ? 128 : 256, SHM_K = 64 * RSK, SHM_V = 64 * DV * 2, KVBLK = 64;
  constexpr int KPR = DK / 8, VPR = DV / 8, NKP = (64 * KPR + 511) / 512, NVP = (64 * VPR) / 512, NLD = NKP + NVP;
  constexpr bool DMA = (DK == 96 && MODE == 0), DMAX = (DK == 128 && MODE == 0);
  constexpr int NBUF = (DMA || DMAX) ? 4 : 2;
  const int tid = tid_now(), wid = tid >> 6, lane = tid & 63, r32 = lane & 31, hi = lane >> 5;
  LAS unsigned char* const V_lds = lds; LAS unsigned char* const K_lds = lds + NBUF * SHM_V;
  LAS float* wsf = (LAS float*)(lds + (NBUF * (SHM_V + SHM_K) >= RING_BYTES ? RING_BYTES + 4096 : NBUF * (SHM_V + SHM_K))) + wid * 64; LAS float* li_l = wsf; LAS float* al_l = wsf + 32;
  bf16x8 qr[NQ];
  const bf16* Qw = Qb + (size_t)(wid * 32 + r32) * LDQ + hi * 8;
#pragma unroll
  for (int d0 = 0; d0 < NQ; ++d0) qr[d0] = *(const bf16x8*)(Qw + d0 * 16);
  const int tq = tq0 + wid * 32 + r32;
  {
    float qf[NQ][8]; float ssq = 0.f;
#pragma unroll
    for (int d0 = 0; d0 < NQ; ++d0)
#pragma unroll
      for (int j = 0; j < 8; ++j) { qf[d0][j] = bf2f((unsigned short)qr[d0][j]); ssq += qf[d0][j] * qf[d0][j]; }
    { auto rr = __builtin_amdgcn_permlane32_swap(__float_as_uint(ssq), __float_as_uint(ssq), false, false); ssq = __uint_as_float(rr[0]) + __uint_as_float(rr[1]); }
    const float sc = (1.0f / sqrtf(ssq * (1.0f / DK) + EPS)) * (DK == 96 ? 0.10206207261596575f : (DK == 64 ? 0.125f : 0.08838834764831845f)) * LOG2E;
#pragma unroll
    for (int d0 = 0; d0 < NQ; ++d0) { const f32x4 g0 = *(const f32x4*)(qgain + d0 * 16 + hi * 8), g1 = *(const f32x4*)(qgain + d0 * 16 + hi * 8 + 4);
#pragma unroll
      for (int j = 0; j < 4; ++j) { qf[d0][j] *= sc * g0[j]; qf[d0][4 + j] *= sc * g1[j]; } }
    if constexpr (QMODE == 0) {
#pragma unroll
      for (int j = 0; j < 8; ++j) { float sn, cs; fast_sincos((float)tq * exp2f(-(float)(2 * (hi * 8 + j)) * (13.287712379549449f / 32.0f)), sn, cs);
        const float x1 = qf[4][j], x2 = qf[5][j]; qf[4][j] = x1 * cs - x2 * sn; qf[5][j] = x1 * sn + x2 * cs; }
    } else if constexpr (QMODE == 2) {
      const int prow = tq >> 6, pcol = tq & 63;
#pragma unroll
      for (int d = 0; d < 2; ++d)
#pragma unroll
        for (int j = 0; j < 8; ++j) { const float inv = exp2f(-(float)(2 * (d * 16 + hi * 8 + j)) * (13.287712379549449f / 64.0f)); float sn, cs;
          fast_sincos((float)prow * inv, sn, cs); float x1 = qf[d][j], x2 = qf[d + 2][j]; qf[d][j] = x1 * cs - x2 * sn; qf[d + 2][j] = x1 * sn + x2 * cs;
          fast_sincos((float)pcol * inv, sn, cs); x1 = qf[4 + d][j]; x2 = qf[6 + d][j]; qf[4 + d][j] = x1 * cs - x2 * sn; qf[6 + d][j] = x1 * sn + x2 * cs; }
    }
#pragma unroll
    for (int d0 = 0; d0 < NQ; ++d0) { const u32x4 w = {cvtpk(qf[d0][0], qf[d0][1]), cvtpk(qf[d0][2], qf[d0][3]), cvtpk(qf[d0][4], qf[d0][5]), cvtpk(qf[d0][6], qf[d0][7])}; qr[d0] = __builtin_bit_cast(bf16x8, w); }
  }
  asm volatile("" ::: "memory");
  float l_reg = MODE ? __builtin_amdgcn_exp2f(sink2 - C0) : 0.f; f32x16 o[NCB];
#pragma unroll
  for (int d = 0; d < NCB; ++d)
#pragma unroll
    for (int r = 0; r < 16; ++r) o[d][r] = 0.f;
  if constexpr (DMA) {
    const int widu = __builtin_amdgcn_readfirstlane(wid);
    int kgo[2], vgo;
#pragma unroll
    for (int i = 0; i < 2; ++i) { const int row = 4 * (wid * 2 + i) + (lane >> 4), cp_ = lane & 15; int c8 = (cp_ & 8) | ((cp_ & 7) ^ (row & 7)); if (c8 >= 12) c8 -= 4;
      kgo[i] = row * LDK + (c8 < 8 ? c8 * 8 : krope_off + (c8 - 8) * 8); }
    { const int kk = wid * 8 + ((lane & 31) >> 2), c = (lane >> 5) * 32 + (lane & 3) * 8, k_ = (kk & ~0xC) | ((kk & 4) << 1) | ((kk & 8) >> 1); vgo = k_ * LDV + c; }
    const int vb0 = (int)(unsigned)(uintptr_t)V_lds + v_rd_base(lane);
#define FA_DMA(t, b) do { const int t_ = (t) < NT ? (t) : NT - 1; const bf16* kp_ = Kh + (size_t)t_ * KVBLK * LDK; const bf16* vp_ = Vh + (size_t)t_ * KVBLK * LDV; \
      __builtin_amdgcn_global_load_lds((const unsigned*)(kp_ + kgo[0]), (LAS unsigned*)(K_lds + (b) * SHM_K + (widu * 2 + 0) * 1024), 16, 0, 0); \
      __builtin_amdgcn_global_load_lds((const unsigned*)(kp_ + kgo[1]), (LAS unsigned*)(K_lds + (b) * SHM_K + (widu * 2 + 1) * 1024), 16, 0, 0); \
      __builtin_amdgcn_global_load_lds((const unsigned*)(vp_ + vgo), (LAS unsigned*)(V_lds + (b) * SHM_V + widu * 1024), 16, 0, 0); } while (0)
#define FA_LAND(n) do { asm volatile("s_waitcnt vmcnt(" #n ")" ::: "memory"); __builtin_amdgcn_s_barrier(); asm volatile("" ::: "memory"); } while (0)
    f32x16 pA0, pA1, pB0, pB1; bf16x8 pa0, pa1, pa2, pa3;
    asm volatile("s_waitcnt vmcnt(0)" ::: "memory");
    __syncthreads();
    if (__builtin_amdgcn_readfirstlane(tid) >= 256) __builtin_amdgcn_s_setprio(1);
    FA_DMA(0, 0); FA_DMA(1, 1); FA_DMA(2, 2);
    FA_LAND(6);
    qkt<DK>(pA0, pA1, K_lds, qr, r32, hi); partialSM(pA0);
    FA_LAND(3);
    for (int j = 1; j + 1 < NT; j += 2) {
      FA_DMA(j + 2, (j + 2) & 3);
      FA_SBAR(); qkt<DK>(pB0, pB1, K_lds + (j & 3) * SHM_K, qr, r32, hi);
      finishSM(pA0, pA1, l_reg, pa0, pa1, pa2, pa3); FA_SBAR();
      pv_d0<NCB>(o, vb0 + ((j - 1) & 3) * SHM_V, pa0, pa1, pa2, pa3); partialSM(pB0);
      FA_LAND(3);
      FA_DMA(j + 3, (j + 3) & 3);
      FA_SBAR(); qkt<DK>(pA0, pA1, K_lds + ((j + 1) & 3) * SHM_K, qr, r32, hi);
      finishSM(pB0, pB1, l_reg, pa0, pa1, pa2, pa3); FA_SBAR();
      pv_d0<NCB>(o, vb0 + (j & 3) * SHM_V, pa0, pa1, pa2, pa3); partialSM(pA0);
      FA_LAND(3);
    }
    FA_SBAR(); qkt<DK>(pB0, pB1, K_lds + ((NT - 1) & 3) * SHM_K, qr, r32, hi);
    finishSM(pA0, pA1, l_reg, pa0, pa1, pa2, pa3); FA_SBAR();
    pv_d0<NCB>(o, vb0 + ((NT - 2) & 3) * SHM_V, pa0, pa1, pa2, pa3); partialSM(pB0);
    finishSM(pB0, pB1, l_reg, pa0, pa1, pa2, pa3); FA_SBAR();
    pv_d0<NCB>(o, vb0 + ((NT - 1) & 3) * SHM_V, pa0, pa1, pa2, pa3);
    asm volatile("s_waitcnt vmcnt(0)" ::: "memory");
#undef FA_DMA
#undef FA_LAND
  } else if constexpr (DMAX) {
    const int widu = __builtin_amdgcn_readfirstlane(wid);
    constexpr int NVB = SHM_V / 8192;
    const LAS unsigned char* ka[4];
#pragma unroll
    for (int m = 0; m < 4; ++m) ka[m] = K_lds + r32 * RSK + (((m * 32) | (hi * 16)) ^ ((r32 & 7) << 4));
    const int vb0 = (int)(unsigned)(uintptr_t)V_lds + v_rd_base(lane);
#define FA_DMA(t, b) do { const int t_ = (t) < NT ? (t) : NT - 1; const bf16* kp_ = Kh + (size_t)t_ * KVBLK * LDK; const bf16* vp_ = Vh + (size_t)t_ * KVBLK * LDV; \
      int ln_ = lane; asm volatile("" : "+v"(ln_)); \
      _Pragma("unroll") for (int i_ = 0; i_ < 2; ++i_) { const int row_ = 4 * (widu * 2 + i_) + (ln_ >> 4), cp_ = ln_ & 15; const int c8_ = (cp_ & 8) | ((cp_ & 7) ^ (row_ & 7)); \
        __builtin_amdgcn_global_load_lds((const unsigned*)(kp_ + (row_ * LDK + c8_ * 8)), (LAS unsigned*)(K_lds + (b) * SHM_K + (widu * 2 + i_) * 1024), 16, 0, 0); } \
      _Pragma("unroll") for (int i_ = 0; i_ < NVB; ++i_) { const int st_ = 2 * (widu * NVB + i_) + (ln_ >> 5), kk_ = (st_ / NCB) * 8 + ((ln_ & 31) >> 2), c_ = (st_ % NCB) * 32 + (ln_ & 3) * 8, k_ = (kk_ & ~0xC) | ((kk_ & 4) << 1) | ((kk_ & 8) >> 1); \
        __builtin_amdgcn_global_load_lds((const unsigned*)(vp_ + (k_ * LDV + c_)), (LAS unsigned*)(V_lds + (b) * SHM_V + (widu * NVB + i_) * 1024), 16, 0, 0); } } while (0)
#define FA_LAND(n) do { asm volatile("s_waitcnt vmcnt(%0)" :: "n"((n) * (2 + NVB)) : "memory"); __builtin_amdgcn_s_barrier(); asm volatile("" ::: "memory"); } while (0)
    f32x16 pA0, pA1, pB0, pB1; bf16x8 pa0, pa1, pa2, pa3;
    asm volatile("s_waitcnt vmcnt(0)" ::: "memory");
    __syncthreads();
    if (__builtin_amdgcn_readfirstlane(tid) >= 256) __builtin_amdgcn_s_setprio(1);
    FA_DMA(0, 0); FA_DMA(1, 1);
    FA_LAND(1);
    qkt4<DK>(pA0, pA1, ka, 0, qr); FA_DMA(2, 2); partialSM(pA0);
    FA_LAND(1);
#define FA_HALF(PN0, PN1, PP0, PP1, jt, bn, bp) do { \
      FA_SBAR(); qkt4<DK>(PN0, PN1, ka, (bn) * SHM_K, qr); \
      finishSM(PP0, PP1, l_reg, pa0, pa1, pa2, pa3); FA_SBAR(); \
      FA_DMA((jt) + 2, ((bn) + 2) & 3); FA_SBAR(); \
      pv_d0<NCB>(o, vb0 + (bp) * SHM_V, pa0, pa1, pa2, pa3); partialSM(PN0); \
      FA_LAND(1); } while (0)
    for (int j = 1; j + 4 < NT; j += 4) {
      FA_HALF(pB0, pB1, pA0, pA1, j, 1, 0); FA_HALF(pA0, pA1, pB0, pB1, j + 1, 2, 1); FA_HALF(pB0, pB1, pA0, pA1, j + 2, 3, 2); FA_HALF(pA0, pA1, pB0, pB1, j + 3, 0, 3);
    }
    FA_HALF(pB0, pB1, pA0, pA1, NT - 3, 1, 0); FA_HALF(pA0, pA1, pB0, pB1, NT - 2, 2, 1);
    FA_SBAR(); qkt4<DK>(pB0, pB1, ka, 3 * SHM_K, qr);
    finishSM(pA0, pA1, l_reg, pa0, pa1, pa2, pa3); FA_SBAR();
    pv_d0<NCB>(o, vb0 + 2 * SHM_V, pa0, pa1, pa2, pa3); partialSM(pB0);
    finishSM(pB0, pB1, l_reg, pa0, pa1, pa2, pa3); FA_SBAR();
    pv_d0<NCB>(o, vb0 + 3 * SHM_V, pa0, pa1, pa2, pa3);
    asm volatile("s_waitcnt vmcnt(0)" ::: "memory");
#undef FA_HALF
#undef FA_DMA
#undef FA_LAND
  } else {
  int kg[NKP], kl[NKP]; bool kok[NKP]; int vg[NVP], vl[NVP];
#pragma unroll
  for (int i = 0; i < NKP; ++i) { int p = tid + 512 * i; kok[i] = p < 64 * KPR; if (!kok[i]) p = tid; const int row = p / KPR, c8 = p % KPR; kg[i] = row * LDK + ((DK == 96 && c8 >= 8) ? krope_off + (c8 - 8) * 8 : c8 * 8); kl[i] = kswz<DK>(row, c8 * 16); }
#pragma unroll
  for (int i = 0; i < NVP; ++i) { const int p = tid + 512 * i; const int row = p / VPR, c8 = p % VPR; vg[i] = row * LDV + c8 * 8; vl[i] = v_st<NCB>(row, c8 * 8); }
  const int vb0 = (int)(unsigned)(uintptr_t)V_lds + v_rd_base(lane);
  bf16x8 skS[SD][NKP], svS[SD][NVP]; constexpr int SE = 0, SO = SD - 1;
#define FA_SLOAD(SK, SV, k0) do { _Pragma("unroll") for (int _j = 0; _j < NVP; ++_j) SV[_j] = *(const bf16x8*)(Vh + (size_t)(k0) * LDV + vg[_j]); \
    _Pragma("unroll") for (int _j = 0; _j < NKP; ++_j) SK[_j] = *(const bf16x8*)(Kh + (size_t)(k0) * LDK + kg[_j]); } while (0)
#define FA_SWRITE(b, SK, SV) do { _Pragma("unroll") for (int _j = 0; _j < NVP; ++_j) *(LAS bf16x8*)(V_lds + (b) * SHM_V + vl[_j]) = SV[_j]; \
    _Pragma("unroll") for (int _j = 0; _j < NKP; ++_j) if (kok[_j]) *(LAS bf16x8*)(K_lds + (b) * SHM_K + kl[_j]) = SK[_j]; } while (0)
#define FA_SWAIT() asm volatile("s_waitcnt vmcnt(%0)" :: "n"(SD == 2 ? NLD : 0) : "memory")
  f32x16 pA0, pA1, pB0, pB1; bf16x8 pa0, pa1, pa2, pa3;
  const int tqw = MODE ? __builtin_amdgcn_readfirstlane(tq0 + wid * 32) : 0;
#define FA_CLS(i) (!MODE ? 2 : ((klo + (i) * KVBLK + 63 < tqw - 128 || klo + (i) * KVBLK > tqw + 159) ? 0 : ((klo + (i) * KVBLK >= tqw - 97 && klo + (i) * KVBLK + 63 <= tqw + 128) ? 2 : 1)))
#define FA_QK(P0, P1, b, c) do { if (c) qkt<DK>(P0, P1, K_lds + (b) * SHM_K, qr, r32, hi); } while (0)
#define FA_MSK(P0, P1, i, c) do { if (c) { if (MODE) { if ((c) == 1) swa_maskf(P0, P1, klo + (i) * KVBLK, tq, hi, slope2); else swa_bias(P0, P1, klo + (i) * KVBLK, tq, hi, slope2); } partialSM(P0); } } while (0)
#define FA_FIN(P0, P1, c) do { if (c) finishSM(P0, P1, l_reg, pa0, pa1, pa2, pa3); } while (0)
#define FA_PV(vb, c) do { if (c) pv_d0<NCB>(o, vb, pa0, pa1, pa2, pa3); } while (0)
  __syncthreads();
  if (__builtin_amdgcn_readfirstlane(tid) >= 256) __builtin_amdgcn_s_setprio(1);
  int cA = FA_CLS(0), cB;
  FA_SLOAD(skS[SE], svS[SE], 0); asm volatile("s_waitcnt vmcnt(0)" ::: "memory"); FA_SWRITE(0, skS[SE], svS[SE]); __syncthreads();
  FA_QK(pA0, pA1, 0, cA); FA_MSK(pA0, pA1, 0, cA);
  FA_SLOAD(skS[SO], svS[SO], KVBLK); if (SD == 2) FA_SLOAD(skS[SE], svS[SE], 2 * KVBLK);
  FA_SWAIT(); FA_SWRITE(1, skS[SO], svS[SO]); __syncthreads();
  for (int j = 1; j + 1 < NT; j += 2) {
    cB = FA_CLS(j);
    FA_SBAR(); FA_QK(pB0, pB1, 1, cB);
    FA_FIN(pA0, pA1, cA); FA_SBAR();
    FA_SLOAD(skS[SO], svS[SO], (j + SD) * KVBLK); FA_SBAR();
    FA_PV(vb0, cA); FA_MSK(pB0, pB1, j, cB);
    __syncthreads(); FA_SWAIT(); FA_SWRITE(0, skS[SE], svS[SE]);
    __syncthreads();
    cA = FA_CLS(j + 1);
    FA_SBAR(); FA_QK(pA0, pA1, 0, cA);
    FA_FIN(pB0, pB1, cB); FA_SBAR();
    { const int tn_ = j + 1 + SD < NT ? j + 1 + SD : NT - 1; FA_SLOAD(skS[SE], svS[SE], tn_ * KVBLK); } FA_SBAR();
    FA_PV(vb0 + SHM_V, cB); FA_MSK(pA0, pA1, j + 1, cA);
    __syncthreads(); FA_SWAIT(); FA_SWRITE(1, skS[SO], svS[SO]);
    __syncthreads();
  }
  cB = FA_CLS(NT - 1);
  FA_SBAR(); FA_QK(pB0, pB1, 1, cB);
  FA_FIN(pA0, pA1, cA); FA_SBAR();
  FA_PV(vb0, cA); FA_MSK(pB0, pB1, NT - 1, cB);
  __syncthreads();
  FA_FIN(pB0, pB1, cB); FA_SBAR();
  FA_PV(vb0 + SHM_V, cB);
#undef FA_CLS
#undef FA_QK
#undef FA_MSK
#undef FA_FIN
#undef FA_PV
  }
  __builtin_amdgcn_s_setprio(0);
  if (hi == 0) li_l[r32] = l_reg; asm volatile("s_waitcnt lgkmcnt(0)" ::: "memory");
  float rli[16];
#pragma unroll
  for (int r = 0; r < 16; ++r) rli[r] = __builtin_amdgcn_rcpf(li_l[crow(r, hi)]);
  bf16* Ow = Ob + (size_t)(wid * 32) * LDO; const bool odd = lane & 1;
#pragma unroll
  for (int d0 = 0; d0 < NCB; ++d0)
#pragma unroll
    for (int r = 0; r < 16; r += 2) {
      const float a = o[d0][r] * rli[r], b = o[d0][r + 1] * rli[r + 1];
      const float x = odd ? a : b;
      const float y = __uint_as_float((unsigned)__builtin_amdgcn_update_dpp(0, (int)__float_as_uint(x), 0xB1, 0xF, 0xF, false));
      const unsigned w = odd ? cvtpk(y, b) : cvtpk(a, y);
      const int orow = crow(odd ? r + 1 : r, hi);
      *(unsigned*)(Ow + (size_t)orow * LDO + d0 * 32 + (r32 & ~1)) = w; }
#undef FA_SLOAD
#undef FA_SWRITE
#undef FA_SWAIT
}
}

__device__ __forceinline__ void xb_rows(const Frame& F, const float* x, bf16* xb, ssq_t* ss) {
    for (int m0 = F.gw * 4; m0 < T; m0 += F.ngw * 4) {
        f32x4 v[4][4];
#pragma unroll
        for (int r = 0; r < 4; ++r)
#pragma unroll
            for (int j = 0; j < 4; ++j) v[r][j] = __builtin_nontemporal_load((const f32x4*)(x + (size_t)(m0 + r) * D) + F.lane + 64 * j);
#pragma unroll
        for (int r = 0; r < 4; ++r) { u32x2* o8 = (u32x2*)(xb + (size_t)(m0 + r) * D) + F.lane; float s = 0.f;
#pragma unroll
            for (int j = 0; j < 4; ++j) { const f32x4 w = v[r][j]; s += (w.x * w.x + w.y * w.y) + (w.z * w.z + w.w * w.w); o8[64 * j] = (u32x2){hpk2(w.x, w.y), hpk2(w.z, w.w)}; }
            s = wave_sum(s); if (F.lane == 0) ss_set(ss, m0 + r, s); }
    }
}
__device__ __forceinline__ void cvt_flat(const Frame& F, const float* src, bf16* dst, size_t n8) {
    const size_t stride = (size_t)F.ngw * 64;
    for (size_t i = (size_t)F.gw * 64 + F.lane; i < n8; i += 4 * stride) {
        f32x4 a[4], b[4];
#pragma unroll
        for (int u = 0; u < 4; ++u) if (i + u * stride < n8) { a[u] = __builtin_nontemporal_load((const f32x4*)src + 2 * (i + u * stride)); b[u] = __builtin_nontemporal_load((const f32x4*)src + 2 * (i + u * stride) + 1); }
#pragma unroll
        for (int u = 0; u < 4; ++u) if (i + u * stride < n8) ((u32x4*)dst)[i + u * stride] = (u32x4){hpk2(a[u].x, a[u].y), hpk2(a[u].z, a[u].w), hpk2(b[u].x, b[u].y), hpk2(b[u].z, b[u].w)};
    }
}
__device__ __forceinline__ float quad_sum(float v, int lpv) { for (int o = 1; o < lpv; o <<= 1) v += __shfl_xor(v, o); return v; }
__device__ __forceinline__ void unpack8(const u32x4 a, float* v) { v[0] = bflo(a.x); v[1] = bfhi(a.x); v[2] = bflo(a.y); v[3] = bfhi(a.y); v[4] = bflo(a.z); v[5] = bfhi(a.z); v[6] = bflo(a.w); v[7] = bfhi(a.w); }
__device__ __forceinline__ void mla_kprep(const Frame& F, bf16* KV, const bf16* C, const float* kg) {
    const int h = F.lane >> 2, s = F.lane & 3; constexpr int R = 4;
    float gk[24], inv[4];
#pragma unroll
    for (int i = 0; i < 16; ++i) gk[i] = kg[16 * s + i];
#pragma unroll
    for (int i = 0; i < 4; ++i) { gk[16 + i] = kg[64 + 4 * s + i]; gk[20 + i] = kg[80 + 4 * s + i]; inv[i] = exp2f(-(float)(2 * (4 * s + i)) * (1.0f / 32.0f) * 13.287712379549449f); }
    for (int m0 = F.gw * R; m0 < T; m0 += F.ngw * R) {
        u32x4 a[R], b[R]; u32x2 r1[R], r2[R];
#pragma unroll
        for (int r = 0; r < R; ++r) { const bf16* nope = KV + (size_t)(m0 + r) * 2560 + h * 64 + 16 * s; const bf16* rs = C + (size_t)(m0 + r) * 512 + 384 + 4 * s;
            a[r] = *(const u32x4*)nope; b[r] = *(const u32x4*)(nope + 8); r1[r] = *(const u32x2*)rs; r2[r] = *(const u32x2*)(rs + 16); }
#pragma unroll
        for (int r = 0; r < R; ++r) { const int t = (m0 + r) & (S - 1); float v[24];
            unpack8(a[r], v); unpack8(b[r], v + 8);
            v[16] = bflo(r1[r].x); v[17] = bfhi(r1[r].x); v[18] = bflo(r1[r].y); v[19] = bfhi(r1[r].y); v[20] = bflo(r2[r].x); v[21] = bfhi(r2[r].x); v[22] = bflo(r2[r].y); v[23] = bfhi(r2[r].y);
            float q = 0.f;
#pragma unroll
            for (int i = 0; i < 24; ++i) q += v[i] * v[i];
            q = quad_sum(q, 4);
            const float sc = 1.0f / sqrtf(q * (1.0f / 96.0f) + EPS);
#pragma unroll
            for (int i = 0; i < 24; ++i) v[i] *= sc * gk[i];
#pragma unroll
            for (int i = 0; i < 4; ++i) { float sn, cs; sincosf((float)t * inv[i], &sn, &cs); const float x1 = v[16 + i], x2 = v[20 + i]; v[16 + i] = x1 * cs - x2 * sn; v[20 + i] = x1 * sn + x2 * cs; }
            bf16* nope = KV + (size_t)(m0 + r) * 2560 + h * 64 + 16 * s;
            *(u32x4*)nope = (u32x4){hpk2(v[0], v[1]), hpk2(v[2], v[3]), hpk2(v[4], v[5]), hpk2(v[6], v[7])};
            *(u32x4*)(nope + 8) = (u32x4){hpk2(v[8], v[9]), hpk2(v[10], v[11]), hpk2(v[12], v[13]), hpk2(v[14], v[15])};
            bf16* rd = KV + (size_t)(m0 + r) * 2560 + 1024 + h * 32 + 4 * s;
            *(u32x2*)rd = (u32x2){hpk2(v[16], v[17]), hpk2(v[18], v[19])}; *(u32x2*)(rd + 16) = (u32x2){hpk2(v[20], v[21]), hpk2(v[22], v[23])}; }
    }
}
__device__ __forceinline__ void swa_kprep(const Frame& F, bf16* QKV, const float* kg) {
    const int tk = F.lane >> 4, hv = (F.lane >> 2) & 3, s = F.lane & 3; constexpr int R = 2;
    float gk[16];
#pragma unroll
    for (int i = 0; i < 16; ++i) gk[i] = kg[16 * s + i];
    for (int m0 = F.gw * 4 * R; m0 < T; m0 += F.ngw * 4 * R) {
        u32x4 a[R], b[R];
#pragma unroll
        for (int r = 0; r < R; ++r) { const bf16* p = QKV + (size_t)(m0 + 4 * r + tk) * 1536 + 1024 + hv * 64 + 16 * s; a[r] = *(const u32x4*)p; b[r] = *(const u32x4*)(p + 8); }
#pragma unroll
        for (int r = 0; r < R; ++r) { float v[16]; unpack8(a[r], v); unpack8(b[r], v + 8); float q = 0.f;
#pragma unroll
            for (int i = 0; i < 16; ++i) q += v[i] * v[i];
            q = quad_sum(q, 4); const float sc = 1.0f / sqrtf(q * (1.0f / 64.0f) + EPS);
#pragma unroll
            for (int i = 0; i < 16; ++i) v[i] *= sc * gk[i];
            bf16* p = QKV + (size_t)(m0 + 4 * r + tk) * 1536 + 1024 + hv * 64 + 16 * s;
            *(u32x4*)p = (u32x4){hpk2(v[0], v[1]), hpk2(v[2], v[3]), hpk2(v[4], v[5]), hpk2(v[6], v[7])};
            *(u32x4*)(p + 8) = (u32x4){hpk2(v[8], v[9]), hpk2(v[10], v[11]), hpk2(v[12], v[13]), hpk2(v[14], v[15])}; }
    }
}
__device__ __forceinline__ void ax_kprep(const Frame& F, bf16* QKV, const float* kg) {
    const int tk = F.lane >> 5, hv = (F.lane >> 3) & 3, s = F.lane & 7; constexpr int R = 2;
    float gk[16], inv[4];
#pragma unroll
    for (int c = 0; c < 4; ++c)
#pragma unroll
        for (int i = 0; i < 4; ++i) gk[4 * c + i] = kg[32 * c + 4 * s + i];
#pragma unroll
    for (int i = 0; i < 4; ++i) inv[i] = exp2f(-(float)(2 * (4 * s + i)) * (1.0f / 64.0f) * 13.287712379549449f);
    for (int m0 = F.gw * 2 * R; m0 < T; m0 += F.ngw * 2 * R) {
        u32x2 w[R][4];
#pragma unroll
        for (int r = 0; r < R; ++r) { const bf16* p = QKV + (size_t)(m0 + 2 * r + tk) * 2048 + 1024 + hv * 128 + 4 * s;
#pragma unroll
            for (int c = 0; c < 4; ++c) w[r][c] = *(const u32x2*)(p + 32 * c); }
#pragma unroll
        for (int r = 0; r < R; ++r) { const int t = (m0 + 2 * r + tk) & (S - 1), prow = t >> 6, pcol = t & 63; float v[16];
#pragma unroll
            for (int c = 0; c < 4; ++c) { v[4 * c] = bflo(w[r][c].x); v[4 * c + 1] = bfhi(w[r][c].x); v[4 * c + 2] = bflo(w[r][c].y); v[4 * c + 3] = bfhi(w[r][c].y); }
            float q = 0.f;
#pragma unroll
            for (int i = 0; i < 16; ++i) q += v[i] * v[i];
            q = quad_sum(q, 8); const float sc = 1.0f / sqrtf(q * (1.0f / 128.0f) + EPS);
#pragma unroll
            for (int i = 0; i < 16; ++i) v[i] *= sc * gk[i];
#pragma unroll
            for (int i = 0; i < 4; ++i) { float sn, cs; fast_sincos((float)prow * inv[i], sn, cs); float x1 = v[i], x2 = v[4 + i];     v[i] = x1 * cs - x2 * sn; v[4 + i] = x1 * sn + x2 * cs;
                fast_sincos((float)pcol * inv[i], sn, cs); x1 = v[8 + i]; x2 = v[12 + i]; v[8 + i] = x1 * cs - x2 * sn; v[12 + i] = x1 * sn + x2 * cs; }
            bf16* p = QKV + (size_t)(m0 + 2 * r + tk) * 2048 + 1024 + hv * 128 + 4 * s;
#pragma unroll
            for (int c = 0; c < 4; ++c) *(u32x2*)(p + 32 * c) = (u32x2){hpk2(v[4 * c], v[4 * c + 1]), hpk2(v[4 * c + 2], v[4 * c + 3])}; }
    }
}

template <int DK, int DV, int MODE>
__device__ __forceinline__ void nattn_unit(const Frame& F, const bf16* Q, int ldq, const bf16* Kp, int ldk, const bf16* Vp, int ldv, bf16* O, int ldo, int q0, float slope2, float sink2) {
    constexpr int HK = DK / 2, HV = DV / 2;
    LAS bf16* Ks = (LAS bf16*)F.lds; LAS bf16* Vs = Ks + 64 * DK;
    const int qi = F.tid >> 1, half = F.tid & 1, t = q0 + qi;
    float q[HK], o[HV];
    { const bf16* qp = Q + (size_t)t * ldq + half * HK;
#pragma unroll
      for (int c = 0; c < HK / 8; ++c) { const u32x4 w = *(const u32x4*)(qp + 8 * c); q[8 * c] = bflo(w.x); q[8 * c + 1] = bfhi(w.x); q[8 * c + 2] = bflo(w.y); q[8 * c + 3] = bfhi(w.y);
          q[8 * c + 4] = bflo(w.z); q[8 * c + 5] = bfhi(w.z); q[8 * c + 6] = bflo(w.w); q[8 * c + 7] = bfhi(w.w); } }
#pragma unroll
    for (int i = 0; i < HV; ++i) o[i] = 0.f;
    float mx = MODE ? sink2 : -1e30f, l = MODE ? 1.f : 0.f;
    const int klo = MODE ? (q0 - 128 < 0 ? 0 : q0 - 128) : 0, khi = MODE ? (q0 + 384 > S ? S : q0 + 384) : S;
    for (int kt = klo; kt < khi; kt += 64) {
        __syncthreads();
        for (int p = F.tid; p < 64 * DK / 8; p += NTHREADS) { const int row = p / (DK / 8), c8 = p % (DK / 8); *(LAS u32x4*)(Ks + row * DK + c8 * 8) = *(const u32x4*)(Kp + (size_t)(kt + row) * ldk + c8 * 8); }
        for (int p = F.tid; p < 64 * DV / 8; p += NTHREADS) { const int row = p / (DV / 8), c8 = p % (DV / 8); *(LAS u32x4*)(Vs + row * DV + c8 * 8) = *(const u32x4*)(Vp + (size_t)(kt + row) * ldv + c8 * 8); }
        __syncthreads();
        for (int j = 0; j < 64; ++j) {
            const LAS u32x4* kr = (const LAS u32x4*)(Ks + j * DK + half * HK); float s = 0.f;
#pragma unroll
            for (int c = 0; c < HK / 8; ++c) { const u32x4 w = kr[c]; s += q[8 * c] * bflo(w.x) + q[8 * c + 1] * bfhi(w.x) + q[8 * c + 2] * bflo(w.y) + q[8 * c + 3] * bfhi(w.y)
                + q[8 * c + 4] * bflo(w.z) + q[8 * c + 5] * bfhi(w.z) + q[8 * c + 6] * bflo(w.w) + q[8 * c + 7] * bfhi(w.w); }
            s += __shfl_xor(s, 1);
            if (MODE) { int dist = t - (kt + j); dist = dist < 0 ? -dist : dist; if (dist > 128) continue; s -= slope2 * (float)dist; }
            if (s > mx) { const float corr = __builtin_amdgcn_exp2f(mx - s); l *= corr;
#pragma unroll
                for (int i = 0; i < HV; ++i) o[i] *= corr;
                mx = s; }
            const float p = __builtin_amdgcn_exp2f(s - mx); l += p;
            const LAS u32x4* vr = (const LAS u32x4*)(Vs + j * DV + half * HV);
#pragma unroll
            for (int c = 0; c < HV / 8; ++c) { const u32x4 w = vr[c]; o[8 * c] += p * bflo(w.x); o[8 * c + 1] += p * bfhi(w.x); o[8 * c + 2] += p * bflo(w.y); o[8 * c + 3] += p * bfhi(w.y);
                o[8 * c + 4] += p * bflo(w.z); o[8 * c + 5] += p * bfhi(w.z); o[8 * c + 6] += p * bflo(w.w); o[8 * c + 7] += p * bfhi(w.w); }
        }
    }
    const float rl = 1.0f / l; bf16* op = O + (size_t)t * ldo + half * HV;
#pragma unroll
    for (int c = 0; c < HV / 8; ++c) *(u32x4*)(op + 8 * c) = (u32x4){pk2(o[8 * c] * rl, o[8 * c + 1] * rl), pk2(o[8 * c + 2] * rl, o[8 * c + 3] * rl), pk2(o[8 * c + 4] * rl, o[8 * c + 5] * rl), pk2(o[8 * c + 6] * rl, o[8 * c + 7] * rl)};
}

__device__ __forceinline__ void moe_route(const Frame& F, const bf16* x, const float* gain, const float* Wr, const float* br, unsigned* cnt, unsigned* pub, int* idx, float* wl, float* rsl, int* tpos) {
    LAS int* lw = (LAS int*)(F.lds + 65536);
    float wr[16][8];
#pragma unroll
    for (int j = 0; j < 2; ++j)
#pragma unroll
        for (int i = 0; i < 8; ++i) { const int k = 512 * j + 8 * F.lane + i; const float g = gain[k]; const f32x4 a = *(const f32x4*)(Wr + k * 8), b = *(const f32x4*)(Wr + k * 8 + 4);
            wr[8 * j + i][0] = a.x * g; wr[8 * j + i][1] = a.y * g; wr[8 * j + i][2] = a.z * g; wr[8 * j + i][3] = a.w * g; wr[8 * j + i][4] = b.x * g; wr[8 * j + i][5] = b.y * g; wr[8 * j + i][6] = b.z * g; wr[8 * j + i][7] = b.w * g; }
    float bias[8];
#pragma unroll
    for (int e = 0; e < 8; ++e) bias[e] = br[e];
    for (int chunk = blockIdx.x; chunk < T / 128; chunk += gridDim.x) {
        int me0 = -1, me1 = -1; float mw0 = 0.f, mw1 = 0.f, mrs = 0.f;
        for (int r = 0; r < 16; ++r) {
            const int m = chunk * 128 + F.wave * 16 + r; const u32x4* xr = (const u32x4*)(x + (size_t)m * D) + F.lane;
            float lg[8], ssq = 0.f;
#pragma unroll
            for (int e = 0; e < 8; ++e) lg[e] = 0.f;
#pragma unroll
            for (int j = 0; j < 2; ++j) { f32x4 v, w; pg8::unpack8f(xr[64 * j], v, w); ssq += pg8::sumsq4(v) + pg8::sumsq4(w);
#pragma unroll
                for (int e = 0; e < 8; ++e) lg[e] += (v[0] * wr[8 * j][e] + v[1] * wr[8 * j + 1][e] + v[2] * wr[8 * j + 2][e] + v[3] * wr[8 * j + 3][e]) + (w[0] * wr[8 * j + 4][e] + w[1] * wr[8 * j + 5][e] + w[2] * wr[8 * j + 6][e] + w[3] * wr[8 * j + 7][e]); }
            ssq = wave_sum(ssq); const float rstd = 1.0f / sqrtf(ssq * (1.0f / D) + EPS);
            {
                const bool b5 = F.lane & 32, b4 = F.lane & 16, b3 = F.lane & 8; float t4[4], t2[2], t1;
#pragma unroll
                for (int k_ = 0; k_ < 4; ++k_) { const float snd = b5 ? lg[k_] : lg[4 + k_], kp = b5 ? lg[4 + k_] : lg[k_]; t4[k_] = kp + __shfl_xor(snd, 32); }
#pragma unroll
                for (int k_ = 0; k_ < 2; ++k_) { const float snd = b4 ? t4[k_] : t4[2 + k_], kp = b4 ? t4[2 + k_] : t4[k_]; t2[k_] = kp + __shfl_xor(snd, 16); }
                { const float snd = b3 ? t2[0] : t2[1], kp = b3 ? t2[1] : t2[0]; t1 = kp + __shfl_xor(snd, 8); }
                t1 += __shfl_xor(t1, 4); t1 += __shfl_xor(t1, 2); t1 += __shfl_xor(t1, 1);
#pragma unroll
                for (int e = 0; e < 8; ++e) lg[e] = __builtin_bit_cast(float, __builtin_amdgcn_readlane(__builtin_bit_cast(int, t1), 8 * e)) * rstd + bias[e];
            }
            int e0 = 0; float l0 = lg[0];
#pragma unroll
            for (int e = 1; e < 8; ++e) if (lg[e] > l0) { l0 = lg[e]; e0 = e; }
            int e1 = -1; float l1 = -3.0e38f;
#pragma unroll
            for (int e = 0; e < 8; ++e) if (e != e0 && lg[e] > l1) { l1 = lg[e]; e1 = e; }
            const float w1 = 1.0f / (1.0f + __expf(l0 - l1)), w0 = 1.0f - w1;
            if (F.lane == r) { me0 = e0; me1 = e1; mw0 = w0; mw1 = w1; mrs = rstd; }
        }
        unsigned long long m0[8], m1[8]; int nw[8];
#pragma unroll
        for (int e = 0; e < 8; ++e) { m0[e] = __ballot(me0 == e); m1[e] = __ballot(me1 == e); nw[e] = __popcll(m0[e]) + __popcll(m1[e]); }
        __syncthreads();
        if (F.lane < 8) { int v = 0;
#pragma unroll
            for (int e = 0; e < 8; ++e) if (F.lane == e) v = nw[e];
            lw[F.wave * 8 + F.lane] = v; }
        __syncthreads();
        if (F.wave == 0 && F.lane < 8) { int tot = 0; for (int w = 0; w < 8; ++w) tot += lw[w * 8 + F.lane]; lw[72 + F.lane] = tot;
            (void)xb_add(pub + chunk * 8 + F.lane, (unsigned)tot + 1u); }
        { int part = 0; const int e_ = F.lane & 7;
            for (int c2 = F.tid >> 3; c2 < chunk; c2 += NTHREADS / 8) { unsigned v, sp = 0u;
                while ((v = xb_ld(pub + c2 * 8 + e_)) == 0u) { __builtin_amdgcn_s_sleep(1); if (++sp > XB_SPIN_CAP) break; }
                part += (int)v - 1; }
            part += __shfl_xor(part, 8); part += __shfl_xor(part, 16); part += __shfl_xor(part, 32);
            if (F.lane < 8) lw[80 + F.wave * 8 + F.lane] = part; }
        __syncthreads();
        if (F.wave == 0 && F.lane < 8) { int base = 0; for (int w = 0; w < 8; ++w) base += lw[80 + w * 8 + F.lane]; lw[64 + F.lane] = base;
            if (chunk == T / 128 - 1) cnt[F.lane * 64] = (unsigned)(base + lw[72 + F.lane]); }
        __syncthreads();
        if (F.lane < 16) {
            const int m = chunk * 128 + F.wave * 16 + F.lane; const unsigned long long lt = (1ull << F.lane) - 1ull;
            int s0 = 0, s1 = 0;
#pragma unroll
            for (int e = 0; e < 8; ++e) { int base = lw[64 + e]; for (int w = 0; w < F.wave; ++w) base += lw[w * 8 + e];
                if (me0 == e) s0 = base + __popcll(m0[e] & lt); if (me1 == e) s1 = base + __popcll(m0[e]) + __popcll(m1[e] & lt); }
            idx[me0 * T + s0] = m; wl[me0 * T + s0] = mw0; rsl[me0 * T + s0] = mrs; idx[me1 * T + s1] = m; wl[me1 * T + s1] = mw1; rsl[me1 * T + s1] = mrs;
            tpos[2 * m] = me0 * T + s0; tpos[2 * m + 1] = me1 * T + s1;
        }
    }
}
__device__ __forceinline__ void moe_combine(const Frame& F, bf16* xb, ssq_t* ss, const bf16* Y, const unsigned* cnt, const int* tpos) {
    int tb[8]; { int base = 0;
#pragma unroll
        for (int e = 0; e < 8; ++e) { tb[e] = base; base += (((int)cnt[e * 64] + 255) >> 8) << 8; } }
    constexpr int R = 4;
    for (int m0 = F.gw * R; m0 < T; m0 += F.ngw * R) {
        int ra[R], rb[R];
#pragma unroll
        for (int r = 0; r < R; ++r) { const int p0 = tpos[2 * (m0 + r)], p1 = tpos[2 * (m0 + r) + 1]; ra[r] = 0; rb[r] = 0;
#pragma unroll
            for (int e = 0; e < 8; ++e) { if ((p0 / T) == e) ra[r] = tb[e] + (p0 % T); if ((p1 / T) == e) rb[r] = tb[e] + (p1 % T); } }
        u32x4 xv[R][2], ya[R][2], yb[R][2];
#pragma unroll
        for (int r = 0; r < R; ++r)
#pragma unroll
            for (int j = 0; j < 2; ++j) { xv[r][j] = ((const u32x4*)(xb + (size_t)(m0 + r) * D) + F.lane)[64 * j]; ya[r][j] = ((const u32x4*)(Y + (size_t)ra[r] * D) + F.lane)[64 * j]; yb[r][j] = ((const u32x4*)(Y + (size_t)rb[r] * D) + F.lane)[64 * j]; }
#pragma unroll
        for (int r = 0; r < R; ++r) { float sq = 0.f;
#pragma unroll
            for (int j = 0; j < 2; ++j) { f32x4 x0, x1, a0, a1, b0, b1; pg8::unpack8f(xv[r][j], x0, x1); pg8::unpack8f(ya[r][j], a0, a1); pg8::unpack8f(yb[r][j], b0, b1);
                x0 = x0 + a0 + b0; x1 = x1 + a1 + b1; sq += pg8::sumsq4(x0) + pg8::sumsq4(x1);
                ((u32x4*)(xb + (size_t)(m0 + r) * D) + F.lane)[64 * j] = (u32x4){hpk2(x0[0], x0[1]), hpk2(x0[2], x0[3]), hpk2(x1[0], x1[1]), hpk2(x1[2], x1[3])}; }
            sq = wave_sum(sq); if (F.lane == 0) ss_set(ss, m0 + r, sq); }
    }
}

__device__ __forceinline__ void tail_reduce(const Frame& F, const pg8::GroupedOrder<false>& So, int first, int ntail, int nsl, const float* P, bf16* Y, const float* wl) {
    for (int rw = F.gw; rw < ntail * 256; rw += F.ngw) { const int tu = rw >> 8, rr = rw & 255; pg8::Unit u; So.decode(first + tu, u);
        f32x4 s = {0.f, 0.f, 0.f, 0.f};
        for (int ks = 0; ks < nsl; ++ks) s += *(const f32x4*)(P + ((size_t)(ks * ntail + tu) * 65536 + rr * 256 + 4 * F.lane));
        const int slot = u.slot0 + rr; const float w_ = __builtin_nontemporal_load(wl + u.e * T + slot); const float w = slot < u.cnt ? w_ : 0.f;
        uint2 o; o.x = hpk2(s[0] * w, s[1] * w); o.y = hpk2(s[2] * w, s[3] * w);
        *(uint2*)(Y + (size_t)(u.pm * 256 + rr) * D + (u.pn - u.e * 4) * 256 + 4 * F.lane) = o; }
}

constexpr int N_STEPS = 32;
constexpr int PTR_TAB_OFF = RING_BYTES + 2048;
__device__ __forceinline__ const float* inp_ptr(LAS unsigned char* lds, int i) {
    const LAS unsigned* t = (const LAS unsigned*)(lds + PTR_TAB_OFF) + 2 * i;
    const unsigned lo_ = __builtin_amdgcn_readfirstlane(t[0]), hi_ = __builtin_amdgcn_readfirstlane(t[1]);
    return (const float*)(const GAS float*)(((unsigned long long)hi_ << 32) | lo_);
}
#ifndef PROBE_STEP
#define PROBE_STEP (-1)
#endif
#ifndef PROBE_REPS
#define PROBE_REPS 2
#endif
__device__ __forceinline__ void zero_fill16(const Frame& F, bf16* base, int nrows, int ld, int c0, int ncols) {
    const int per = ncols / 8;
    for (int i = F.gw * 64 + F.lane; i < nrows * per; i += F.ngw * 64) { const int r = i / per, c = i % per; *(u32x4*)(base + (size_t)r * ld + c0 + 8 * c) = (u32x4){0u, 0u, 0u, 0u}; }
}
__global__ void __launch_bounds__(NTHREADS, 2) mega(Args args) {
    extern __shared__ __attribute__((aligned(16))) unsigned char lds_raw[];
    Frame F; F.lds = (LAS unsigned char*)lds_raw; F.ctl = (unsigned*)(args.ws + WS_CTL);
    F.tid = threadIdx.x; F.lane = F.tid & 63; F.wave = __builtin_amdgcn_readfirstlane(F.tid >> 6);
    F.gw = blockIdx.x * NWAVES + F.wave; F.ngw = gridDim.x * NWAVES;
    volatile LAS unsigned* MISC = (volatile LAS unsigned*)(F.lds + MISC_OFF);
    for (int u = F.tid; u < (LDS_BYTES - RING_BYTES) / 4; u += NTHREADS) ((LAS unsigned*)(F.lds + RING_BYTES))[u] = 0u;
    __syncthreads();
    if (F.tid < N_IN) ((LAS unsigned long long*)(F.lds + PTR_TAB_OFF))[F.tid] = (unsigned long long)args.in[F.tid];
    if (F.tid == N_IN) ((LAS unsigned long long*)(F.lds + PTR_TAB_OFF))[N_IN] = (unsigned long long)args.ws;
    if (F.tid == N_IN + 1) ((LAS unsigned long long*)(F.lds + PTR_TAB_OFF))[N_IN + 1] = (unsigned long long)args.out;
    __syncthreads();
    XcdBarrier bar; bar.bar = F.ctl + CW_BAR; bar.x = 0; bar.st = nullptr;
    if (MK_N_LAUNCHES == 1) bar = xcd_barrier_post(F.ctl + CW_BAR, MISC + 8);
    const int lo = args.lo, hi = args.hi;
#define ws  ((unsigned char*)inp_ptr(F.lds, N_IN))
#define out ((float*)inp_ptr(F.lds, N_IN + 1))
#define act (ws + WS_ACT)
#define WT ((bf16*)(ws + WS_WT))
#define WM ((bf16*)(ws + WS_WMOE))
#define XB ((bf16*)(ws + WS_XB))
#define PB ((bf16*)(ws + WS_PB))
#define PT ((bf16*)(ws + WS_PT))
#define XA ((bf16*)(act + A_XA))
#define SS ((ssq_t*)(ws + CTL_SS))
#define SSC ((ssq_t*)(ws + CTL_SSC))
#define m_idx ((int*)(ws + WS_MOEL))
#define m_wl ((float*)(ws + WS_MOEL + 1 * MiB))
#define m_tpos ((int*)(ws + WS_MOEL + 2 * MiB))
#define m_rs ((float*)(ws + WS_MOEL + 3 * MiB))
    const int G = gridDim.x, cid = blockIdx.x;
    const int vcu = (G % 8 == 0) ? (cid % 8) * (G / 8) + cid / 8 : cid;
#define IN_(k) (lo <= (k) && (k) < hi)
#if PROBE_STEP >= 0
#define REPS(k) ((k) == PROBE_STEP ? PROBE_REPS : 1)
#define REP_LOOP(k) for (int rep_ = 0; rep_ < REPS(k); ++rep_)
#define SEAM(k) do { if (MK_N_LAUNCHES == 1 && ((k) + 1 < hi || rep_ + 1 < REPS(k))) xcd_barrier(bar); } while (0)
#else
#define REP_LOOP(k)
#define SEAM(k) do { if (MK_N_LAUNCHES == 1 && (k) + 1 < hi) xcd_barrier(bar); } while (0)
#endif
#define INP(i) inp_ptr(F.lds, (i))
#define REFRESH() do { F.tid = tid_now(); F.lane = F.tid & 63; F.wave = __builtin_amdgcn_readfirstlane(F.tid >> 6); F.gw = blockIdx.x * NWAVES + F.wave; } while (0)

    if (IN_(0)) REP_LOOP(0) { REFRESH();
        int wofs = 0;
        { constexpr int j = 0;
            cvt_job(F, INP(I_MLA_W_DOWN) + (size_t)j * D * 416, nullptr, 416, 416, INP(I_ATTN_NORM) + 3 * j * D, WT + WT_DOWN + (size_t)j * 512 * 1024, 1024, 512, 0, wofs); wofs += 16 * 16;
            cvt_job(F, INP(I_MLA_W_UQ) + (size_t)j * 256 * 1536, nullptr, 1536, 1536, INP(I_MLA_Q_NORM) + j * 256, WT + WT_UQ + (size_t)j * 1536 * 256, 256, 1536, 0, wofs); wofs += 4 * 48;
            cvt_job(F, INP(I_MLA_W_UKV) + (size_t)j * 128 * 2048, nullptr, 2048, 2048, INP(I_MLA_KV_NORM) + j * 128, WT + WT_UKV + (size_t)j * 2560 * 256, 128, 2048, 1, wofs); wofs += 2 * 64;
            cvt_job(F, INP(I_MLA_W_O) + (size_t)j * D * D, nullptr, D, D, nullptr, WT + WT_WO + (size_t)(3 * j) * D * D, 1024, 1024, 0, wofs); wofs += 16 * 32;
        }
        xb_rows(F, INP(I_X), XA, SS + 0 * T);
        SEAM(0);
    }

#define LATE_WEIGHTS() do { int wofs = 0; \
        for (int j = 0; j < 2; ++j) { \
            if (j == 1) { \
                cvt_job(F, INP(I_MLA_W_DOWN) + (size_t)j * D * 416, nullptr, 416, 416, INP(I_ATTN_NORM) + 3 * j * D, WT + WT_DOWN + (size_t)j * 512 * 1024, 1024, 512, 0, wofs); wofs += 16 * 16; \
                cvt_job(F, INP(I_MLA_W_UQ) + (size_t)j * 256 * 1536, nullptr, 1536, 1536, INP(I_MLA_Q_NORM) + j * 256, WT + WT_UQ + (size_t)j * 1536 * 256, 256, 1536, 0, wofs); wofs += 4 * 48; \
                cvt_job(F, INP(I_MLA_W_UKV) + (size_t)j * 128 * 2048, nullptr, 2048, 2048, INP(I_MLA_KV_NORM) + j * 128, WT + WT_UKV + (size_t)j * 2560 * 256, 128, 2048, 1, wofs); wofs += 2 * 64; \
                cvt_job(F, INP(I_MLA_W_O) + (size_t)j * D * D, nullptr, D, D, nullptr, WT + WT_WO + (size_t)(3 * j) * D * D, 1024, 1024, 0, wofs); wofs += 16 * 32; } \
            cvt_job(F, INP(I_FFN_W_GATE) + (size_t)j * D * FF, INP(I_FFN_W_UP) + (size_t)j * D * FF, FF, FF, INP(I_FFN_NORM) + 2 * j * D, WT + WT_FGU + (size_t)j * 5632 * 1024, 1024, 5632, 2, wofs); wofs += 16 * 88; \
            cvt_job(F, INP(I_FFN_W_DOWN) + (size_t)j * FF * D, nullptr, D, D, nullptr, WT + WT_FDN + (size_t)j * 1024 * FF, FF, 1024, 0, wofs); wofs += 44 * 16; \
        } \
        cvt_job(F, INP(I_SWA_W_QKV), nullptr, 1536, 1536, INP(I_ATTN_NORM) + 1 * D, WT + WT_SQKV, 1024, 1536, 0, wofs); wofs += 16 * 24; \
        cvt_job(F, INP(I_SWA_W_O), nullptr, D, D, nullptr, WT + WT_WO + (size_t)1 * D * D, 1024, 1024, 0, wofs); wofs += 16 * 16; \
        cvt_job(F, INP(I_AX_W_QKV), nullptr, 2048, 2048, INP(I_ATTN_NORM) + 2 * D, WT + WT_AQKV, 1024, 2048, 0, wofs); wofs += 16 * 32; \
        cvt_job(F, INP(I_AX_W_O), nullptr, D, D, nullptr, WT + WT_WO + (size_t)2 * D * D, 1024, 1024, 0, wofs); wofs += 16 * 16; \
        for (int l2 = 0; l2 < 4; ++l2) { \
            cvt_job(F, INP(I_PLE_W_IN) + (size_t)l2 * PLE * D, nullptr, D, D, nullptr, WT + WT_PIN + (size_t)l2 * 1024 * 256, 256, 1024, 0, wofs); wofs += 4 * 16; \
            cvt_job(F, INP(I_PLE_W_GATE) + (size_t)l2 * D * D, nullptr, D, D, INP(I_PLE_NORM) + l2 * D, WT + WT_PG + (size_t)l2 * D * D, 1024, 1024, 0, wofs); wofs += 16 * 16; } \
    } while (0)
    int k = 1;
    { constexpr int l = 0;
        const int kind = l % 3, jm = l / 3, f = l >> 1;
        const ssq_t* ss_attn = SS + (size_t)(3 * l) * T; ssq_t* ss_ffn = SS + (size_t)(3 * l + 1) * T; ssq_t* ss_ple = SS + (size_t)(3 * l + 2) * T; ssq_t* ss_next = l < 3 ? SS + (size_t)(3 * l + 3) * T : nullptr;
        if (kind == 0) {
            if (IN_(k)) REP_LOOP(k) { REFRESH(); pg8::Gemm g{XA, WT + WT_DOWN + (size_t)jm * 512 * 1024, 1024, 1024}; pg8::StaticOrder So; So.init(T, 512, G, cid);
                pg8::EpiPlain<true> E{(bf16*)(act + A_C), 512, 2, ss_attn, 1.0f / D, nullptr, SSC + (size_t)jm * T, SSC + (size_t)(2 + jm) * T};
                pg8::gemm_phase(F.lds, g, So, E); SEAM(k); } ++k;
            if (IN_(k)) REP_LOOP(k) { REFRESH(); { pg8::Gemm g{(const bf16*)(act + A_C), WT + WT_UQ + (size_t)jm * 1536 * 256, 256, 512}; pg8::StaticOrder So; So.init(T, 1536, G, cid);
                  pg8::EpiPlain<false> E{(bf16*)(act + A_QR), 1536, 6, SSC + (size_t)jm * T, 1.0f / 256, nullptr, nullptr, nullptr}; pg8::gemm_phase(F.lds, g, So, E); }
                { int k128_ = 128; asm volatile("" : "+s"(k128_));     pg8::Gemm g{(const bf16*)(act + A_C) + 256, WT + WT_UKV + (size_t)jm * 2560 * 256, k128_, 512}; pg8::StaticOrder So; So.init(T, 2048, G, cid);
                  pg8::EpiKN<true> E{(bf16*)(act + A_KV), 2560, 0, 4, 512, SSC + (size_t)(2 + jm) * T, 1.0f / 128, INP(I_MLA_K_GAIN) + jm * 96, (const bf16*)(act + A_C), (LAS float*)(F.lds + RING_BYTES + 4096)}; pg8::gemm_phase(F.lds, g, So, E); }
                SEAM(k); } ++k;
            if (IN_(k)) REP_LOOP(k) { REFRESH(); int it_ = 0; const int nit_ = (NB * 16 * 8 - vcu + G - 1) / G; const int stag_ = ((cid >> 3) & 7) % (nit_ > 0 ? nit_ : 1); constexpr int fc_ = l == 0 ? 0 : 1, lc_ = l == 0 ? 1 : 3;
                for (int u = vcu; u < NB * 16 * 8; u += G, ++it_) { const int qb = u & 7, h = (u >> 3) & 15, b = u >> 7;
                    if (it_ == stag_) {
                        __syncthreads();
                        REFRESH();
                        moe_cvt_all(F, INP(I_MOE_W_GATE) + (size_t)fc_ * NE * D * EF, INP(I_MOE_W_UP) + (size_t)fc_ * NE * D * EF, INP(I_MOE_W_DOWN) + (size_t)fc_ * NE * EF * D, INP(I_FFN_NORM) + lc_ * D, WM);
                        if (l == 0) { LATE_WEIGHTS(); cvt_flat(F, INP(I_P), PB, (size_t)4 * T * PLE / 8); }
                        __syncthreads(); }
                    fa::attn_unit<96, 64, 0, 0, 1536, 2560, 2560, D, 2>((const bf16*)(act + A_QR) + (size_t)(b * S + qb * 256) * 1536 + h * 96, (const bf16*)(act + A_KV) + (size_t)b * S * 2560 + h * 64,
                                          (const bf16*)(act + A_KV) + (size_t)b * S * 2560 + 1536 + h * 64, (bf16*)(act + A_O) + (size_t)(b * S + qb * 256) * D + h * 64, S / 64, qb * 256, 0, 0.f, 0.f, INP(I_MLA_Q_GAIN) + jm * 96, 1024 - 32 * h, F.lds); } SEAM(k); } ++k;
        } else if (kind == 1) {
            if (IN_(k)) REP_LOOP(k) { REFRESH(); pg8::Gemm g{XA, WT + WT_SQKV, 1024, 1024}; pg8::StaticOrder So; So.init(T, 1536, G, cid);
                pg8::EpiKN<false> E{(bf16*)(act + 0), 1536, 4, 5, 0, ss_attn, 1.0f / D, INP(I_SWA_K_GAIN), nullptr, (LAS float*)(F.lds + RING_BYTES + 4096)}; pg8::gemm_phase(F.lds, g, So, E); SEAM(k); } ++k;
            if (IN_(k)) REP_LOOP(k) { REFRESH(); for (int u = vcu; u < NB * 16 * 8; u += G) { const int qb = u & 7, h = (u >> 3) & 15, b = u >> 7; const int gq = h >> 2;
                    const float slope2 = exp2f(-8.0f * (float)(h + 1) / 16.0f) * LOG2E, sink2 = INP(I_SWA_SINK)[h] * LOG2E;
                    const int q0 = qb * 256, klo = q0 - 128 < 0 ? 0 : q0 - 128, khi = q0 + 384 > S ? S : q0 + 384;
                    fa::attn_unit<64, 64, 1, 1, 1536, 1536, 1536, D, 2>((const bf16*)(act + 0) + (size_t)(b * S + q0) * 1536 + h * 64, (const bf16*)(act + 0) + (size_t)(b * S + klo) * 1536 + 1024 + gq * 64,
                                          (const bf16*)(act + 0) + (size_t)(b * S + klo) * 1536 + 1280 + gq * 64, (bf16*)(act + A_O) + (size_t)(b * S + q0) * D + h * 64, (khi - klo) / 64, q0, klo, slope2, sink2, INP(I_SWA_Q_GAIN), 0, F.lds); } SEAM(k); } ++k;
        } else {
            if (IN_(k)) REP_LOOP(k) { REFRESH(); pg8::Gemm g{XA, WT + WT_AQKV, 1024, 1024}; pg8::StaticOrder So; So.init(T, 2048, G, cid);
                pg8::EpiPlain<false> E{(bf16*)(act + 0), 2048, 8, ss_attn, 1.0f / D, nullptr, nullptr, nullptr}; pg8::gemm_phase(F.lds, g, So, E); SEAM(k); } ++k;
            if (IN_(k)) REP_LOOP(k) { REFRESH(); ax_kprep(F, (bf16*)(act + 0), INP(I_AX_K_GAIN)); SEAM(k); } ++k;
            if (IN_(k)) REP_LOOP(k) { REFRESH(); for (int u = vcu; u < NB * 8 * 8; u += G) { const int qb = u & 7, h = (u >> 3) & 7, b = u >> 6; const int gq = h >> 1;
                    fa::attn_unit<128, 128, 0, 2, 2048, 2048, 2048, D, 1>((const bf16*)(act + 0) + (size_t)(b * S + qb * 256) * 2048 + h * 128, (const bf16*)(act + 0) + (size_t)b * S * 2048 + 1024 + gq * 128,
                                            (const bf16*)(act + 0) + (size_t)b * S * 2048 + 1536 + gq * 128, (bf16*)(act + A_O) + (size_t)(b * S + qb * 256) * D + h * 128, S / 64, qb * 256, 0, 0.f, 0.f, INP(I_AX_Q_GAIN), 0, F.lds); } SEAM(k); } ++k;
        }
        if (IN_(k)) REP_LOOP(k) { REFRESH(); __syncthreads(); pg8::Gemm g{(const bf16*)(act + A_O), WT + WT_WO + (size_t)l * D * D, 1024, 1024}; pg8::StaticOrder So; So.init(T, D, G, cid);
            pg8::EpiResid E{XA, XB, ss_ffn}; pg8::gemm_phase(F.lds, g, So, E); SEAM(k); } ++k;
        if ((l & 1) == 0) {
            if (IN_(k)) REP_LOOP(k) { REFRESH(); pg8::Gemm g{XB, WT + WT_FGU + (size_t)f * 5632 * 1024, 1024, 1024}; pg8::StaticOrder So; So.init(T, 5632, G, cid);
                pg8::EpiSwiglu E{(bf16*)(act + A_HID), FF, 22, ss_ffn, nullptr, (LAS float*)(F.lds + RING_BYTES + 4096)}; pg8::gemm_phase(F.lds, g, So, E); SEAM(k); } ++k;
            if (IN_(k)) REP_LOOP(k) { REFRESH(); pg8::Gemm g{(const bf16*)(act + A_HID), WT + WT_FDN + (size_t)f * 1024 * FF, FF, FF}; pg8::StaticOrder So; So.init(T, D, G, cid);
                pg8::EpiResid E{XB, XB, ss_ple}; pg8::gemm_phase(F.lds, g, So, E); SEAM(k); } ++k;
        } else {
            unsigned* cnt = F.ctl + CW_MOECNT + f * 1024;
            if (IN_(k)) REP_LOOP(k) { REFRESH();
                moe_route(F, XB, INP(I_FFN_NORM) + l * D, INP(I_MOE_W_ROUTER) + (size_t)f * D * NE, INP(I_MOE_B_ROUTER) + f * NE, cnt, F.ctl + CW_ROUTEPUB + f * 4096, m_idx, m_wl, m_rs, m_tpos); SEAM(k); } ++k;
            if (IN_(k)) REP_LOOP(k) { REFRESH(); __syncthreads(); pg8::Gemm g{XB, WM + WM_GU, 1024, 1024}; pg8::GroupedOrder<true> So; So.init(cnt, 28, G, cid, m_idx, (LAS int*)(F.lds + RING_BYTES + 1024));
                pg8::EpiSwiglu E{(bf16*)(act + A_HID), EF, 28, nullptr, m_rs, (LAS float*)(F.lds + RING_BYTES + 4096)}; pg8::gemm_phase(F.lds, g, So, E); SEAM(k); } ++k;
            if (IN_(k)) REP_LOOP(k) { REFRESH(); pg8::Gemm g{(const bf16*)(act + A_HID), WM + WM_DN, EF, EF}; pg8::GroupedOrder<false> So; So.init(cnt, 4, G, cid, nullptr, (LAS int*)(F.lds + RING_BYTES + 1024));
                const int ntail = So.nunits % G; int nsl = 0;
                if (ntail > 0 && So.nunits > G) nsl = ntail * 14 <= G ? 14 : ntail * 7 <= G ? 7 : ntail * 4 <= G ? 4 : ntail * 2 <= G ? 2 : 0;
                if (ntail * nsl > 256) nsl = 0;
                nsl = __builtin_amdgcn_readfirstlane(nsl);
                if (nsl) { So.nlim = So.nunits - ntail;
                    { const int ksl = EF / nsl; pg8::Gemm gs{(const bf16*)(act + A_HID), WM + WM_DN, ksl, EF, EF}; pg8::SliceOrder Ss{So, So.nlim, ntail, nsl, ksl * 2, G, cid};
                      pg8::EpiPartial Ep{(float*)(ws + WS_PT)}; pg8::gemm_phase(F.lds, gs, Ss, Ep); }
                    asm volatile("s_waitcnt vmcnt(0)" ::: "memory"); __syncthreads();
                    if (threadIdx.x == 0) { __builtin_amdgcn_fence(__ATOMIC_RELEASE, "agent"); asm volatile("s_waitcnt vmcnt(0)" ::: "memory"); xb_add(cnt + 768, 1u); } }
                pg8::EpiPlain<false> E{(bf16*)(act + A_Y), D, 4, nullptr, 0.f, m_wl, nullptr, nullptr}; pg8::gemm_phase(F.lds, g, So, E);
                if (nsl) { REFRESH();
                    if (threadIdx.x == 0) { XB_SPIN(xb_ld(cnt + 768) < (unsigned)G, F.ctl + CW_BAR); __builtin_amdgcn_fence(__ATOMIC_ACQUIRE, "agent"); asm volatile("s_waitcnt vmcnt(0)" ::: "memory"); }
                    __syncthreads();
                    tail_reduce(F, So, So.nlim, ntail, nsl, (const float*)(ws + WS_PT), (bf16*)(act + A_Y), m_wl); }
                SEAM(k); } ++k;
            if (IN_(k)) REP_LOOP(k) { REFRESH(); moe_combine(F, XB, ss_ple, (const bf16*)(act + A_Y), cnt, m_tpos); SEAM(k); } ++k;
        }
        if (IN_(k)) REP_LOOP(k) { REFRESH(); { pg8::Gemm g{PB + (size_t)l * T * PLE, WT + WT_PIN + (size_t)l * 1024 * 256, 256, 256}; pg8::StaticOrder So; So.init(T, D, G, cid);
              pg8::EpiPlain<false> E{PT, D, 4, nullptr, 0.f, nullptr, nullptr, nullptr}; pg8::gemm_phase(F.lds, g, So, E); }
            { pg8::Gemm g{XB, WT + WT_PG + (size_t)l * D * D, 1024, 1024}; pg8::StaticOrder So; So.init(T, D, G, cid);
              pg8::EpiPle E{PT, XB, XA, l == DEPTH - 1 ? out : nullptr, ss_ple, ss_next}; pg8::gemm_phase(F.lds, g, So, E); } SEAM(k); } ++k;
    }
    { constexpr int l = 1;
        const int kind = l % 3, jm = l / 3, f = l >> 1;
        const ssq_t* ss_attn = SS + (size_t)(3 * l) * T; ssq_t* ss_ffn = SS + (size_t)(3 * l + 1) * T; ssq_t* ss_ple = SS + (size_t)(3 * l + 2) * T; ssq_t* ss_next = l < 3 ? SS + (size_t)(3 * l + 3) * T : nullptr;
        if (kind == 0) {
            if (IN_(k)) REP_LOOP(k) { REFRESH(); pg8::Gemm g{XA, WT + WT_DOWN + (size_t)jm * 512 * 1024, 1024, 1024}; pg8::StaticOrder So; So.init(T, 512, G, cid);
                pg8::EpiPlain<true> E{(bf16*)(act + A_C), 512, 2, ss_attn, 1.0f / D, nullptr, SSC + (size_t)jm * T, SSC + (size_t)(2 + jm) * T};
                pg8::gemm_phase(F.lds, g, So, E); SEAM(k); } ++k;
            if (IN_(k)) REP_LOOP(k) { REFRESH(); { pg8::Gemm g{(const bf16*)(act + A_C), WT + WT_UQ + (size_t)jm * 1536 * 256, 256, 512}; pg8::StaticOrder So; So.init(T, 1536, G, cid);
                  pg8::EpiPlain<false> E{(bf16*)(act + A_QR), 1536, 6, SSC + (size_t)jm * T, 1.0f / 256, nullptr, nullptr, nullptr}; pg8::gemm_phase(F.lds, g, So, E); }
                { int k128_ = 128; asm volatile("" : "+s"(k128_));     pg8::Gemm g{(const bf16*)(act + A_C) + 256, WT + WT_UKV + (size_t)jm * 2560 * 256, k128_, 512}; pg8::StaticOrder So; So.init(T, 2048, G, cid);
                  pg8::EpiKN<true> E{(bf16*)(act + A_KV), 2560, 0, 4, 512, SSC + (size_t)(2 + jm) * T, 1.0f / 128, INP(I_MLA_K_GAIN) + jm * 96, (const bf16*)(act + A_C), (LAS float*)(F.lds + RING_BYTES + 4096)}; pg8::gemm_phase(F.lds, g, So, E); }
                SEAM(k); } ++k;
            if (IN_(k)) REP_LOOP(k) { REFRESH(); int it_ = 0; const int nit_ = (NB * 16 * 8 - vcu + G - 1) / G; const int stag_ = ((cid >> 3) & 7) % (nit_ > 0 ? nit_ : 1); constexpr int fc_ = l == 0 ? 0 : 1, lc_ = l == 0 ? 1 : 3;
                for (int u = vcu; u < NB * 16 * 8; u += G, ++it_) { const int qb = u & 7, h = (u >> 3) & 15, b = u >> 7;
                    if (it_ == stag_) {
                        __syncthreads();
                        REFRESH();
                        moe_cvt_all(F, INP(I_MOE_W_GATE) + (size_t)fc_ * NE * D * EF, INP(I_MOE_W_UP) + (size_t)fc_ * NE * D * EF, INP(I_MOE_W_DOWN) + (size_t)fc_ * NE * EF * D, INP(I_FFN_NORM) + lc_ * D, WM);
                        if (l == 0) { LATE_WEIGHTS(); cvt_flat(F, INP(I_P), PB, (size_t)4 * T * PLE / 8); }
                        __syncthreads(); }
                    fa::attn_unit<96, 64, 0, 0, 1536, 2560, 2560, D, 2>((const bf16*)(act + A_QR) + (size_t)(b * S + qb * 256) * 1536 + h * 96, (const bf16*)(act + A_KV) + (size_t)b * S * 2560 + h * 64,
                                          (const bf16*)(act + A_KV) + (size_t)b * S * 2560 + 1536 + h * 64, (bf16*)(act + A_O) + (size_t)(b * S + qb * 256) * D + h * 64, S / 64, qb * 256, 0, 0.f, 0.f, INP(I_MLA_Q_GAIN) + jm * 96, 1024 - 32 * h, F.lds); } SEAM(k); } ++k;
        } else if (kind == 1) {
            if (IN_(k)) REP_LOOP(k) { REFRESH(); pg8::Gemm g{XA, WT + WT_SQKV, 1024, 1024}; pg8::StaticOrder So; So.init(T, 1536, G, cid);
                pg8::EpiKN<false> E{(bf16*)(act + 0), 1536, 4, 5, 0, ss_attn, 1.0f / D, INP(I_SWA_K_GAIN), nullptr, (LAS float*)(F.lds + RING_BYTES + 4096)}; pg8::gemm_phase(F.lds, g, So, E); SEAM(k); } ++k;
            if (IN_(k)) REP_LOOP(k) { REFRESH(); for (int u = vcu; u < NB * 16 * 8; u += G) { const int qb = u & 7, h = (u >> 3) & 15, b = u >> 7; const int gq = h >> 2;
                    const float slope2 = exp2f(-8.0f * (float)(h + 1) / 16.0f) * LOG2E, sink2 = INP(I_SWA_SINK)[h] * LOG2E;
                    const int q0 = qb * 256, klo = q0 - 128 < 0 ? 0 : q0 - 128, khi = q0 + 384 > S ? S : q0 + 384;
                    fa::attn_unit<64, 64, 1, 1, 1536, 1536, 1536, D, 2>((const bf16*)(act + 0) + (size_t)(b * S + q0) * 1536 + h * 64, (const bf16*)(act + 0) + (size_t)(b * S + klo) * 1536 + 1024 + gq * 64,
                                          (const bf16*)(act + 0) + (size_t)(b * S + klo) * 1536 + 1280 + gq * 64, (bf16*)(act + A_O) + (size_t)(b * S + q0) * D + h * 64, (khi - klo) / 64, q0, klo, slope2, sink2, INP(I_SWA_Q_GAIN), 0, F.lds); } SEAM(k); } ++k;
        } else {
            if (IN_(k)) REP_LOOP(k) { REFRESH(); pg8::Gemm g{XA, WT + WT_AQKV, 1024, 1024}; pg8::StaticOrder So; So.init(T, 2048, G, cid);
                pg8::EpiPlain<false> E{(bf16*)(act + 0), 2048, 8, ss_attn, 1.0f / D, nullptr, nullptr, nullptr}; pg8::gemm_phase(F.lds, g, So, E); SEAM(k); } ++k;
            if (IN_(k)) REP_LOOP(k) { REFRESH(); ax_kprep(F, (bf16*)(act + 0), INP(I_AX_K_GAIN)); SEAM(k); } ++k;
            if (IN_(k)) REP_LOOP(k) { REFRESH(); for (int u = vcu; u < NB * 8 * 8; u += G) { const int qb = u & 7, h = (u >> 3) & 7, b = u >> 6; const int gq = h >> 1;
                    fa::attn_unit<128, 128, 0, 2, 2048, 2048, 2048, D, 1>((const bf16*)(act + 0) + (size_t)(b * S + qb * 256) * 2048 + h * 128, (const bf16*)(act + 0) + (size_t)b * S * 2048 + 1024 + gq * 128,
                                            (const bf16*)(act + 0) + (size_t)b * S * 2048 + 1536 + gq * 128, (bf16*)(act + A_O) + (size_t)(b * S + qb * 256) * D + h * 128, S / 64, qb * 256, 0, 0.f, 0.f, INP(I_AX_Q_GAIN), 0, F.lds); } SEAM(k); } ++k;
        }
        if (IN_(k)) REP_LOOP(k) { REFRESH(); __syncthreads(); pg8::Gemm g{(const bf16*)(act + A_O), WT + WT_WO + (size_t)l * D * D, 1024, 1024}; pg8::StaticOrder So; So.init(T, D, G, cid);
            pg8::EpiResid E{XA, XB, ss_ffn}; pg8::gemm_phase(F.lds, g, So, E); SEAM(k); } ++k;
        if ((l & 1) == 0) {
            if (IN_(k)) REP_LOOP(k) { REFRESH(); pg8::Gemm g{XB, WT + WT_FGU + (size_t)f * 5632 * 1024, 1024, 1024}; pg8::StaticOrder So; So.init(T, 5632, G, cid);
                pg8::EpiSwiglu E{(bf16*)(act + A_HID), FF, 22, ss_ffn, nullptr, (LAS float*)(F.lds + RING_BYTES + 4096)}; pg8::gemm_phase(F.lds, g, So, E); SEAM(k); } ++k;
            if (IN_(k)) REP_LOOP(k) { REFRESH(); pg8::Gemm g{(const bf16*)(act + A_HID), WT + WT_FDN + (size_t)f * 1024 * FF, FF, FF}; pg8::StaticOrder So; So.init(T, D, G, cid);
                pg8::EpiResid E{XB, XB, ss_ple}; pg8::gemm_phase(F.lds, g, So, E); SEAM(k); } ++k;
        } else {
            unsigned* cnt = F.ctl + CW_MOECNT + f * 1024;
            if (IN_(k)) REP_LOOP(k) { REFRESH();
                moe_route(F, XB, INP(I_FFN_NORM) + l * D, INP(I_MOE_W_ROUTER) + (size_t)f * D * NE, INP(I_MOE_B_ROUTER) + f * NE, cnt, F.ctl + CW_ROUTEPUB + f * 4096, m_idx, m_wl, m_rs, m_tpos); SEAM(k); } ++k;
            if (IN_(k)) REP_LOOP(k) { REFRESH(); __syncthreads(); pg8::Gemm g{XB, WM + WM_GU, 1024, 1024}; pg8::GroupedOrder<true> So; So.init(cnt, 28, G, cid, m_idx, (LAS int*)(F.lds + RING_BYTES + 1024));
                pg8::EpiSwiglu E{(bf16*)(act + A_HID), EF, 28, nullptr, m_rs, (LAS float*)(F.lds + RING_BYTES + 4096)}; pg8::gemm_phase(F.lds, g, So, E); SEAM(k); } ++k;
            if (IN_(k)) REP_LOOP(k) { REFRESH(); pg8::Gemm g{(const bf16*)(act + A_HID), WM + WM_DN, EF, EF}; pg8::GroupedOrder<false> So; So.init(cnt, 4, G, cid, nullptr, (LAS int*)(F.lds + RING_BYTES + 1024));
                const int ntail = So.nunits % G; int nsl = 0;
                if (ntail > 0 && So.nunits > G) nsl = ntail * 14 <= G ? 14 : ntail * 7 <= G ? 7 : ntail * 4 <= G ? 4 : ntail * 2 <= G ? 2 : 0;
                if (ntail * nsl > 256) nsl = 0;
                nsl = __builtin_amdgcn_readfirstlane(nsl);
                if (nsl) { So.nlim = So.nunits - ntail;
                    { const int ksl = EF / nsl; pg8::Gemm gs{(const bf16*)(act + A_HID), WM + WM_DN, ksl, EF, EF}; pg8::SliceOrder Ss{So, So.nlim, ntail, nsl, ksl * 2, G, cid};
                      pg8::EpiPartial Ep{(float*)(ws + WS_PT)}; pg8::gemm_phase(F.lds, gs, Ss, Ep); }
                    asm volatile("s_waitcnt vmcnt(0)" ::: "memory"); __syncthreads();
                    if (threadIdx.x == 0) { __builtin_amdgcn_fence(__ATOMIC_RELEASE, "agent"); asm volatile("s_waitcnt vmcnt(0)" ::: "memory"); xb_add(cnt + 768, 1u); } }
                pg8::EpiPlain<false> E{(bf16*)(act + A_Y), D, 4, nullptr, 0.f, m_wl, nullptr, nullptr}; pg8::gemm_phase(F.lds, g, So, E);
                if (nsl) { REFRESH();
                    if (threadIdx.x == 0) { XB_SPIN(xb_ld(cnt + 768) < (unsigned)G, F.ctl + CW_BAR); __builtin_amdgcn_fence(__ATOMIC_ACQUIRE, "agent"); asm volatile("s_waitcnt vmcnt(0)" ::: "memory"); }
                    __syncthreads();
                    tail_reduce(F, So, So.nlim, ntail, nsl, (const float*)(ws + WS_PT), (bf16*)(act + A_Y), m_wl); }
                SEAM(k); } ++k;
            if (IN_(k)) REP_LOOP(k) { REFRESH(); moe_combine(F, XB, ss_ple, (const bf16*)(act + A_Y), cnt, m_tpos); SEAM(k); } ++k;
        }
        if (IN_(k)) REP_LOOP(k) { REFRESH(); { pg8::Gemm g{PB + (size_t)l * T * PLE, WT + WT_PIN + (size_t)l * 1024 * 256, 256, 256}; pg8::StaticOrder So; So.init(T, D, G, cid);
              pg8::EpiPlain<false> E{PT, D, 4, nullptr, 0.f, nullptr, nullptr, nullptr}; pg8::gemm_phase(F.lds, g, So, E); }
            { pg8::Gemm g{XB, WT + WT_PG + (size_t)l * D * D, 1024, 1024}; pg8::StaticOrder So; So.init(T, D, G, cid);
              pg8::EpiPle E{PT, XB, XA, l == DEPTH - 1 ? out : nullptr, ss_ple, ss_next}; pg8::gemm_phase(F.lds, g, So, E); } SEAM(k); } ++k;
    }
    { constexpr int l = 2;
        const int kind = l % 3, jm = l / 3, f = l >> 1;
        const ssq_t* ss_attn = SS + (size_t)(3 * l) * T; ssq_t* ss_ffn = SS + (size_t)(3 * l + 1) * T; ssq_t* ss_ple = SS + (size_t)(3 * l + 2) * T; ssq_t* ss_next = l < 3 ? SS + (size_t)(3 * l + 3) * T : nullptr;
        if (kind == 0) {
            if (IN_(k)) REP_LOOP(k) { REFRESH(); pg8::Gemm g{XA, WT + WT_DOWN + (size_t)jm * 512 * 1024, 1024, 1024}; pg8::StaticOrder So; So.init(T, 512, G, cid);
                pg8::EpiPlain<true> E{(bf16*)(act + A_C), 512, 2, ss_attn, 1.0f / D, nullptr, SSC + (size_t)jm * T, SSC + (size_t)(2 + jm) * T};
                pg8::gemm_phase(F.lds, g, So, E); SEAM(k); } ++k;
            if (IN_(k)) REP_LOOP(k) { REFRESH(); { pg8::Gemm g{(const bf16*)(act + A_C), WT + WT_UQ + (size_t)jm * 1536 * 256, 256, 512}; pg8::StaticOrder So; So.init(T, 1536, G, cid);
                  pg8::EpiPlain<false> E{(bf16*)(act + A_QR), 1536, 6, SSC + (size_t)jm * T, 1.0f / 256, nullptr, nullptr, nullptr}; pg8::gemm_phase(F.lds, g, So, E); }
                { int k128_ = 128; asm volatile("" : "+s"(k128_));     pg8::Gemm g{(const bf16*)(act + A_C) + 256, WT + WT_UKV + (size_t)jm * 2560 * 256, k128_, 512}; pg8::StaticOrder So; So.init(T, 2048, G, cid);
                  pg8::EpiKN<true> E{(bf16*)(act + A_KV), 2560, 0, 4, 512, SSC + (size_t)(2 + jm) * T, 1.0f / 128, INP(I_MLA_K_GAIN) + jm * 96, (const bf16*)(act + A_C), (LAS float*)(F.lds + RING_BYTES + 4096)}; pg8::gemm_phase(F.lds, g, So, E); }
                SEAM(k); } ++k;
            if (IN_(k)) REP_LOOP(k) { REFRESH(); int it_ = 0; const int nit_ = (NB * 16 * 8 - vcu + G - 1) / G; const int stag_ = ((cid >> 3) & 7) % (nit_ > 0 ? nit_ : 1); constexpr int fc_ = l == 0 ? 0 : 1, lc_ = l == 0 ? 1 : 3;
                for (int u = vcu; u < NB * 16 * 8; u += G, ++it_) { const int qb = u & 7, h = (u >> 3) & 15, b = u >> 7;
                    if (it_ == stag_) {
                        __syncthreads();
                        REFRESH();
                        moe_cvt_all(F, INP(I_MOE_W_GATE) + (size_t)fc_ * NE * D * EF, INP(I_MOE_W_UP) + (size_t)fc_ * NE * D * EF, INP(I_MOE_W_DOWN) + (size_t)fc_ * NE * EF * D, INP(I_FFN_NORM) + lc_ * D, WM);
                        if (l == 0) { LATE_WEIGHTS(); cvt_flat(F, INP(I_P), PB, (size_t)4 * T * PLE / 8); }
                        __syncthreads(); }
                    fa::attn_unit<96, 64, 0, 0, 1536, 2560, 2560, D, 2>((const bf16*)(act + A_QR) + (size_t)(b * S + qb * 256) * 1536 + h * 96, (const bf16*)(act + A_KV) + (size_t)b * S * 2560 + h * 64,
                                          (const bf16*)(act + A_KV) + (size_t)b * S * 2560 + 1536 + h * 64, (bf16*)(act + A_O) + (size_t)(b * S + qb * 256) * D + h * 64, S / 64, qb * 256, 0, 0.f, 0.f, INP(I_MLA_Q_GAIN) + jm * 96, 1024 - 32 * h, F.lds); } SEAM(k); } ++k;
        } else if (kind == 1) {
            if (IN_(k)) REP_LOOP(k) { REFRESH(); pg8::Gemm g{XA, WT + WT_SQKV, 1024, 1024}; pg8::StaticOrder So; So.init(T, 1536, G, cid);
                pg8::EpiKN<false> E{(bf16*)(act + 0), 1536, 4, 5, 0, ss_attn, 1.0f / D, INP(I_SWA_K_GAIN), nullptr, (LAS float*)(F.lds + RING_BYTES + 4096)}; pg8::gemm_phase(F.lds, g, So, E); SEAM(k); } ++k;
            if (IN_(k)) REP_LOOP(k) { REFRESH(); for (int u = vcu; u < NB * 16 * 8; u += G) { const int qb = u & 7, h = (u >> 3) & 15, b = u >> 7; const int gq = h >> 2;
                    const float slope2 = exp2f(-8.0f * (float)(h + 1) / 16.0f) * LOG2E, sink2 = INP(I_SWA_SINK)[h] * LOG2E;
                    const int q0 = qb * 256, klo = q0 - 128 < 0 ? 0 : q0 - 128, khi = q0 + 384 > S ? S : q0 + 384;
                    fa::attn_unit<64, 64, 1, 1, 1536, 1536, 1536, D, 2>((const bf16*)(act + 0) + (size_t)(b * S + q0) * 1536 + h * 64, (const bf16*)(act + 0) + (size_t)(b * S + klo) * 1536 + 1024 + gq * 64,
                                          (const bf16*)(act + 0) + (size_t)(b * S + klo) * 1536 + 1280 + gq * 64, (bf16*)(act + A_O) + (size_t)(b * S + q0) * D + h * 64, (khi - klo) / 64, q0, klo, slope2, sink2, INP(I_SWA_Q_GAIN), 0, F.lds); } SEAM(k); } ++k;
        } else {
            if (IN_(k)) REP_LOOP(k) { REFRESH(); pg8::Gemm g{XA, WT + WT_AQKV, 1024, 1024}; pg8::StaticOrder So; So.init(T, 2048, G, cid);
                pg8::EpiPlain<false> E{(bf16*)(act + 0), 2048, 8, ss_attn, 1.0f / D, nullptr, nullptr, nullptr}; pg8::gemm_phase(F.lds, g, So, E); SEAM(k); } ++k;
            if (IN_(k)) REP_LOOP(k) { REFRESH(); ax_kprep(F, (bf16*)(act + 0), INP(I_AX_K_GAIN)); SEAM(k); } ++k;
            if (IN_(k)) REP_LOOP(k) { REFRESH(); for (int u = vcu; u < NB * 8 * 8; u += G) { const int qb = u & 7, h = (u >> 3) & 7, b = u >> 6; const int gq = h >> 1;
                    fa::attn_unit<128, 128, 0, 2, 2048, 2048, 2048, D, 1>((const bf16*)(act + 0) + (size_t)(b * S + qb * 256) * 2048 + h * 128, (const bf16*)(act + 0) + (size_t)b * S * 2048 + 1024 + gq * 128,
                                            (const bf16*)(act + 0) + (size_t)b * S * 2048 + 1536 + gq * 128, (bf16*)(act + A_O) + (size_t)(b * S + qb * 256) * D + h * 128, S / 64, qb * 256, 0, 0.f, 0.f, INP(I_AX_Q_GAIN), 0, F.lds); } SEAM(k); } ++k;
        }
        if (IN_(k)) REP_LOOP(k) { REFRESH(); __syncthreads(); pg8::Gemm g{(const bf16*)(act + A_O), WT + WT_WO + (size_t)l * D * D, 1024, 1024}; pg8::StaticOrder So; So.init(T, D, G, cid);
            pg8::EpiResid E{XA, XB, ss_ffn}; pg8::gemm_phase(F.lds, g, So, E); SEAM(k); } ++k;
        if ((l & 1) == 0) {
            if (IN_(k)) REP_LOOP(k) { REFRESH(); pg8::Gemm g{XB, WT + WT_FGU + (size_t)f * 5632 * 1024, 1024, 1024}; pg8::StaticOrder So; So.init(T, 5632, G, cid);
                pg8::EpiSwiglu E{(bf16*)(act + A_HID), FF, 22, ss_ffn, nullptr, (LAS float*)(F.lds + RING_BYTES + 4096)}; pg8::gemm_phase(F.lds, g, So, E); SEAM(k); } ++k;
            if (IN_(k)) REP_LOOP(k) { REFRESH(); pg8::Gemm g{(const bf16*)(act + A_HID), WT + WT_FDN + (size_t)f * 1024 * FF, FF, FF}; pg8::StaticOrder So; So.init(T, D, G, cid);
                pg8::EpiResid E{XB, XB, ss_ple}; pg8::gemm_phase(F.lds, g, So, E); SEAM(k); } ++k;
        } else {
            unsigned* cnt = F.ctl + CW_MOECNT + f * 1024;
            if (IN_(k)) REP_LOOP(k) { REFRESH();
                moe_route(F, XB, INP(I_FFN_NORM) + l * D, INP(I_MOE_W_ROUTER) + (size_t)f * D * NE, INP(I_MOE_B_ROUTER) + f * NE, cnt, F.ctl + CW_ROUTEPUB + f * 4096, m_idx, m_wl, m_rs, m_tpos); SEAM(k); } ++k;
            if (IN_(k)) REP_LOOP(k) { REFRESH(); __syncthreads(); pg8::Gemm g{XB, WM + WM_GU, 1024, 1024}; pg8::GroupedOrder<true> So; So.init(cnt, 28, G, cid, m_idx, (LAS int*)(F.lds + RING_BYTES + 1024));
                pg8::EpiSwiglu E{(bf16*)(act + A_HID), EF, 28, nullptr, m_rs, (LAS float*)(F.lds + RING_BYTES + 4096)}; pg8::gemm_phase(F.lds, g, So, E); SEAM(k); } ++k;
            if (IN_(k)) REP_LOOP(k) { REFRESH(); pg8::Gemm g{(const bf16*)(act + A_HID), WM + WM_DN, EF, EF}; pg8::GroupedOrder<false> So; So.init(cnt, 4, G, cid, nullptr, (LAS int*)(F.lds + RING_BYTES + 1024));
                const int ntail = So.nunits % G; int nsl = 0;
                if (ntail > 0 && So.nunits > G) nsl = ntail * 14 <= G ? 14 : ntail * 7 <= G ? 7 : ntail * 4 <= G ? 4 : ntail * 2 <= G ? 2 : 0;
                if (ntail * nsl > 256) nsl = 0;
                nsl = __builtin_amdgcn_readfirstlane(nsl);
                if (nsl) { So.nlim = So.nunits - ntail;
                    { const int ksl = EF / nsl; pg8::Gemm gs{(const bf16*)(act + A_HID), WM + WM_DN, ksl, EF, EF}; pg8::SliceOrder Ss{So, So.nlim, ntail, nsl, ksl * 2, G, cid};
                      pg8::EpiPartial Ep{(float*)(ws + WS_PT)}; pg8::gemm_phase(F.lds, gs, Ss, Ep); }
                    asm volatile("s_waitcnt vmcnt(0)" ::: "memory"); __syncthreads();
                    if (threadIdx.x == 0) { __builtin_amdgcn_fence(__ATOMIC_RELEASE, "agent"); asm volatile("s_waitcnt vmcnt(0)" ::: "memory"); xb_add(cnt + 768, 1u); } }
                pg8::EpiPlain<false> E{(bf16*)(act + A_Y), D, 4, nullptr, 0.f, m_wl, nullptr, nullptr}; pg8::gemm_phase(F.lds, g, So, E);
                if (nsl) { REFRESH();
                    if (threadIdx.x == 0) { XB_SPIN(xb_ld(cnt + 768) < (unsigned)G, F.ctl + CW_BAR); __builtin_amdgcn_fence(__ATOMIC_ACQUIRE, "agent"); asm volatile("s_waitcnt vmcnt(0)" ::: "memory"); }
                    __syncthreads();
                    tail_reduce(F, So, So.nlim, ntail, nsl, (const float*)(ws + WS_PT), (bf16*)(act + A_Y), m_wl); }
                SEAM(k); } ++k;
            if (IN_(k)) REP_LOOP(k) { REFRESH(); moe_combine(F, XB, ss_ple, (const bf16*)(act + A_Y), cnt, m_tpos); SEAM(k); } ++k;
        }
        if (IN_(k)) REP_LOOP(k) { REFRESH(); { pg8::Gemm g{PB + (size_t)l * T * PLE, WT + WT_PIN + (size_t)l * 1024 * 256, 256, 256}; pg8::StaticOrder So; So.init(T, D, G, cid);
              pg8::EpiPlain<false> E{PT, D, 4, nullptr, 0.f, nullptr, nullptr, nullptr}; pg8::gemm_phase(F.lds, g, So, E); }
            { pg8::Gemm g{XB, WT + WT_PG + (size_t)l * D * D, 1024, 1024}; pg8::StaticOrder So; So.init(T, D, G, cid);
              pg8::EpiPle E{PT, XB, XA, l == DEPTH - 1 ? out : nullptr, ss_ple, ss_next}; pg8::gemm_phase(F.lds, g, So, E); } SEAM(k); } ++k;
    }
    { constexpr int l = 3;
        const int kind = l % 3, jm = l / 3, f = l >> 1;
        const ssq_t* ss_attn = SS + (size_t)(3 * l) * T; ssq_t* ss_ffn = SS + (size_t)(3 * l + 1) * T; ssq_t* ss_ple = SS + (size_t)(3 * l + 2) * T; ssq_t* ss_next = l < 3 ? SS + (size_t)(3 * l + 3) * T : nullptr;
        if (kind == 0) {
            if (IN_(k)) REP_LOOP(k) { REFRESH(); pg8::Gemm g{XA, WT + WT_DOWN + (size_t)jm * 512 * 1024, 1024, 1024}; pg8::StaticOrder So; So.init(T, 512, G, cid);
                pg8::EpiPlain<true> E{(bf16*)(act + A_C), 512, 2, ss_attn, 1.0f / D, nullptr, SSC + (size_t)jm * T, SSC + (size_t)(2 + jm) * T};
                pg8::gemm_phase(F.lds, g, So, E); SEAM(k); } ++k;
            if (IN_(k)) REP_LOOP(k) { REFRESH(); { pg8::Gemm g{(const bf16*)(act + A_C), WT + WT_UQ + (size_t)jm * 1536 * 256, 256, 512}; pg8::StaticOrder So; So.init(T, 1536, G, cid);
                  pg8::EpiPlain<false> E{(bf16*)(act + A_QR), 1536, 6, SSC + (size_t)jm * T, 1.0f / 256, nullptr, nullptr, nullptr}; pg8::gemm_phase(F.lds, g, So, E); }
                { int k128_ = 128; asm volatile("" : "+s"(k128_));     pg8::Gemm g{(const bf16*)(act + A_C) + 256, WT + WT_UKV + (size_t)jm * 2560 * 256, k128_, 512}; pg8::StaticOrder So; So.init(T, 2048, G, cid);
                  pg8::EpiKN<true> E{(bf16*)(act + A_KV), 2560, 0, 4, 512, SSC + (size_t)(2 + jm) * T, 1.0f / 128, INP(I_MLA_K_GAIN) + jm * 96, (const bf16*)(act + A_C), (LAS float*)(F.lds + RING_BYTES + 4096)}; pg8::gemm_phase(F.lds, g, So, E); }
                SEAM(k); } ++k;
            if (IN_(k)) REP_LOOP(k) { REFRESH(); int it_ = 0; const int nit_ = (NB * 16 * 8 - vcu + G - 1) / G; const int stag_ = ((cid >> 3) & 7) % (nit_ > 0 ? nit_ : 1); constexpr int fc_ = l == 0 ? 0 : 1, lc_ = l == 0 ? 1 : 3;
                for (int u = vcu; u < NB * 16 * 8; u += G, ++it_) { const int qb = u & 7, h = (u >> 3) & 15, b = u >> 7;
                    if (it_ == stag_) {
                        __syncthreads();
                        REFRESH();
                        moe_cvt_all(F, INP(I_MOE_W_GATE) + (size_t)fc_ * NE * D * EF, INP(I_MOE_W_UP) + (size_t)fc_ * NE * D * EF, INP(I_MOE_W_DOWN) + (size_t)fc_ * NE * EF * D, INP(I_FFN_NORM) + lc_ * D, WM);
                        if (l == 0) { LATE_WEIGHTS(); cvt_flat(F, INP(I_P), PB, (size_t)4 * T * PLE / 8); }
                        __syncthreads(); }
                    fa::attn_unit<96, 64, 0, 0, 1536, 2560, 2560, D, 2>((const bf16*)(act + A_QR) + (size_t)(b * S + qb * 256) * 1536 + h * 96, (const bf16*)(act + A_KV) + (size_t)b * S * 2560 + h * 64,
                                          (const bf16*)(act + A_KV) + (size_t)b * S * 2560 + 1536 + h * 64, (bf16*)(act + A_O) + (size_t)(b * S + qb * 256) * D + h * 64, S / 64, qb * 256, 0, 0.f, 0.f, INP(I_MLA_Q_GAIN) + jm * 96, 1024 - 32 * h, F.lds); } SEAM(k); } ++k;
        } else if (kind == 1) {
            if (IN_(k)) REP_LOOP(k) { REFRESH(); pg8::Gemm g{XA, WT + WT_SQKV, 1024, 1024}; pg8::StaticOrder So; So.init(T, 1536, G, cid);
                pg8::EpiKN<false> E{(bf16*)(act + 0), 1536, 4, 5, 0, ss_attn, 1.0f / D, INP(I_SWA_K_GAIN), nullptr, (LAS float*)(F.lds + RING_BYTES + 4096)}; pg8::gemm_phase(F.lds, g, So, E); SEAM(k); } ++k;
            if (IN_(k)) REP_LOOP(k) { REFRESH(); for (int u = vcu; u < NB * 16 * 8; u += G) { const int qb = u & 7, h = (u >> 3) & 15, b = u >> 7; const int gq = h >> 2;
                    const float slope2 = exp2f(-8.0f * (float)(h + 1) / 16.0f) * LOG2E, sink2 = INP(I_SWA_SINK)[h] * LOG2E;
                    const int q0 = qb * 256, klo = q0 - 128 < 0 ? 0 : q0 - 128, khi = q0 + 384 > S ? S : q0 + 384;
                    fa::attn_unit<64, 64, 1, 1, 1536, 1536, 1536, D, 2>((const bf16*)(act + 0) + (size_t)(b * S + q0) * 1536 + h * 64, (const bf16*)(act + 0) + (size_t)(b * S + klo) * 1536 + 1024 + gq * 64,
                                          (const bf16*)(act + 0) + (size_t)(b * S + klo) * 1536 + 1280 + gq * 64, (bf16*)(act + A_O) + (size_t)(b * S + q0) * D + h * 64, (khi - klo) / 64, q0, klo, slope2, sink2, INP(I_SWA_Q_GAIN), 0, F.lds); } SEAM(k); } ++k;
        } else {
            if (IN_(k)) REP_LOOP(k) { REFRESH(); pg8::Gemm g{XA, WT + WT_AQKV, 1024, 1024}; pg8::StaticOrder So; So.init(T, 2048, G, cid);
                pg8::EpiPlain<false> E{(bf16*)(act + 0), 2048, 8, ss_attn, 1.0f / D, nullptr, nullptr, nullptr}; pg8::gemm_phase(F.lds, g, So, E); SEAM(k); } ++k;
            if (IN_(k)) REP_LOOP(k) { REFRESH(); ax_kprep(F, (bf16*)(act + 0), INP(I_AX_K_GAIN)); SEAM(k); } ++k;
            if (IN_(k)) REP_LOOP(k) { REFRESH(); for (int u = vcu; u < NB * 8 * 8; u += G) { const int qb = u & 7, h = (u >> 3) & 7, b = u >> 6; const int gq = h >> 1;
                    fa::attn_unit<128, 128, 0, 2, 2048, 2048, 2048, D, 1>((const bf16*)(act + 0) + (size_t)(b * S + qb * 256) * 2048 + h * 128, (const bf16*)(act + 0) + (size_t)b * S * 2048 + 1024 + gq * 128,
                                            (const bf16*)(act + 0) + (size_t)b * S * 2048 + 1536 + gq * 128, (bf16*)(act + A_O) + (size_t)(b * S + qb * 256) * D + h * 128, S / 64, qb * 256, 0, 0.f, 0.f, INP(I_AX_Q_GAIN), 0, F.lds); } SEAM(k); } ++k;
        }
        if (IN_(k)) REP_LOOP(k) { REFRESH(); __syncthreads(); pg8::Gemm g{(const bf16*)(act + A_O), WT + WT_WO + (size_t)l * D * D, 1024, 1024}; pg8::StaticOrder So; So.init(T, D, G, cid);
            pg8::EpiResid E{XA, XB, ss_ffn}; pg8::gemm_phase(F.lds, g, So, E); SEAM(k); } ++k;
        if ((l & 1) == 0) {
            if (IN_(k)) REP_LOOP(k) { REFRESH(); pg8::Gemm g{XB, WT + WT_FGU + (size_t)f * 5632 * 1024, 1024, 1024}; pg8::StaticOrder So; So.init(T, 5632, G, cid);
                pg8::EpiSwiglu E{(bf16*)(act + A_HID), FF, 22, ss_ffn, nullptr, (LAS float*)(F.lds + RING_BYTES + 4096)}; pg8::gemm_phase(F.lds, g, So, E); SEAM(k); } ++k;
            if (IN_(k)) REP_LOOP(k) { REFRESH(); pg8::Gemm g{(const bf16*)(act + A_HID), WT + WT_FDN + (size_t)f * 1024 * FF, FF, FF}; pg8::StaticOrder So; So.init(T, D, G, cid);
                pg8::EpiResid E{XB, XB, ss_ple}; pg8::gemm_phase(F.lds, g, So, E); SEAM(k); } ++k;
        } else {
            unsigned* cnt = F.ctl + CW_MOECNT + f * 1024;
            if (IN_(k)) REP_LOOP(k) { REFRESH();
                moe_route(F, XB, INP(I_FFN_NORM) + l * D, INP(I_MOE_W_ROUTER) + (size_t)f * D * NE, INP(I_MOE_B_ROUTER) + f * NE, cnt, F.ctl + CW_ROUTEPUB + f * 4096, m_idx, m_wl, m_rs, m_tpos); SEAM(k); } ++k;
            if (IN_(k)) REP_LOOP(k) { REFRESH(); __syncthreads(); pg8::Gemm g{XB, WM + WM_GU, 1024, 1024}; pg8::GroupedOrder<true> So; So.init(cnt, 28, G, cid, m_idx, (LAS int*)(F.lds + RING_BYTES + 1024));
                pg8::EpiSwiglu E{(bf16*)(act + A_HID), EF, 28, nullptr, m_rs, (LAS float*)(F.lds + RING_BYTES + 4096)}; pg8::gemm_phase(F.lds, g, So, E); SEAM(k); } ++k;
            if (IN_(k)) REP_LOOP(k) { REFRESH(); pg8::Gemm g{(const bf16*)(act + A_HID), WM + WM_DN, EF, EF}; pg8::GroupedOrder<false> So; So.init(cnt, 4, G, cid, nullptr, (LAS int*)(F.lds + RING_BYTES + 1024));
                const int ntail = So.nunits % G; int nsl = 0;
                if (ntail > 0 && So.nunits > G) nsl = ntail * 14 <= G ? 14 : ntail * 7 <= G ? 7 : ntail * 4 <= G ? 4 : ntail * 2 <= G ? 2 : 0;
                if (ntail * nsl > 256) nsl = 0;
                nsl = __builtin_amdgcn_readfirstlane(nsl);
                if (nsl) { So.nlim = So.nunits - ntail;
                    { const int ksl = EF / nsl; pg8::Gemm gs{(const bf16*)(act + A_HID), WM + WM_DN, ksl, EF, EF}; pg8::SliceOrder Ss{So, So.nlim, ntail, nsl, ksl * 2, G, cid};
                      pg8::EpiPartial Ep{(float*)(ws + WS_PT)}; pg8::gemm_phase(F.lds, gs, Ss, Ep); }
                    asm volatile("s_waitcnt vmcnt(0)" ::: "memory"); __syncthreads();
                    if (threadIdx.x == 0) { __builtin_amdgcn_fence(__ATOMIC_RELEASE, "agent"); asm volatile("s_waitcnt vmcnt(0)" ::: "memory"); xb_add(cnt + 768, 1u); } }
                pg8::EpiPlain<false> E{(bf16*)(act + A_Y), D, 4, nullptr, 0.f, m_wl, nullptr, nullptr}; pg8::gemm_phase(F.lds, g, So, E);
                if (nsl) { REFRESH();
                    if (threadIdx.x == 0) { XB_SPIN(xb_ld(cnt + 768) < (unsigned)G, F.ctl + CW_BAR); __builtin_amdgcn_fence(__ATOMIC_ACQUIRE, "agent"); asm volatile("s_waitcnt vmcnt(0)" ::: "memory"); }
                    __syncthreads();
                    tail_reduce(F, So, So.nlim, ntail, nsl, (const float*)(ws + WS_PT), (bf16*)(act + A_Y), m_wl); }
                SEAM(k); } ++k;
            if (IN_(k)) REP_LOOP(k) { REFRESH(); moe_combine(F, XB, ss_ple, (const bf16*)(act + A_Y), cnt, m_tpos); SEAM(k); } ++k;
        }
        if (IN_(k)) REP_LOOP(k) { REFRESH(); { pg8::Gemm g{PB + (size_t)l * T * PLE, WT + WT_PIN + (size_t)l * 1024 * 256, 256, 256}; pg8::StaticOrder So; So.init(T, D, G, cid);
              pg8::EpiPlain<false> E{PT, D, 4, nullptr, 0.f, nullptr, nullptr, nullptr}; pg8::gemm_phase(F.lds, g, So, E); }
            { pg8::Gemm g{XB, WT + WT_PG + (size_t)l * D * D, 1024, 1024}; pg8::StaticOrder So; So.init(T, D, G, cid);
              pg8::EpiPle E{PT, XB, XA, l == DEPTH - 1 ? out : nullptr, ss_ple, ss_next}; pg8::gemm_phase(F.lds, g, So, E); } SEAM(k); } ++k;
    }
}

#undef ws
#undef out
#undef act
#undef WT
#undef WM
#undef XB
#undef PB
#undef PT
#undef XA
#undef SS
#undef SSC
#undef m_idx
#undef m_wl
#undef m_tpos
#undef m_rs
extern "C" void kernel_launch(void* const* d_in, const int* in_sizes, int n_in, void* d_out, int out_size, void* d_ws, size_t ws_size, hipStream_t stream) {
    static int grid = 0;
    if (grid == 0) {
        if (n_in != N_IN || in_sizes[0] != T * D || out_size != T * D || ws_size < WS_END) { fprintf(stderr, "kernel_launch: shape mismatch n_in %d in0 %d out %d ws %zu (need %zu)\n", n_in, n_in > 0 ? in_sizes[0] : -1, out_size, ws_size, (size_t)WS_END); grid = -1; return; }
        int dev = 0, cus = 0;
        if (hipGetDevice(&dev) != hipSuccess || hipDeviceGetAttribute(&cus, hipDeviceAttributeMultiprocessorCount, dev) != hipSuccess) { grid = -1; return; }
        if (hipFuncSetAttribute((const void*)mega, hipFuncAttributeMaxDynamicSharedMemorySize, LDS_BYTES) != hipSuccess) { fprintf(stderr, "kernel_launch: hipFuncSetAttribute failed\n"); grid = -1; return; }
        int per_cu = 0;
        if (hipOccupancyMaxActiveBlocksPerMultiprocessor(&per_cu, (const void*)mega, NTHREADS, LDS_BYTES) != hipSuccess || per_cu < 1) fprintf(stderr, "kernel_launch: occupancy query says %d\n", per_cu);
        (void)hipGetLastError();
        grid = cus;
    }
    if (grid < 0) return;
    if (hipMemsetAsync((char*)d_ws + WS_CTL, 0, CTL_ZERO_BYTES, stream) != hipSuccess) { fprintf(stderr, "kernel_launch: memset failed\n"); return; }
    Args a{};
    for (int i = 0; i < N_IN; ++i) a.in[i] = (const float*)d_in[i];
    a.out = (float*)d_out; a.ws = (unsigned char*)d_ws;
    if (MK_N_LAUNCHES == 1) { a.lo = 0; a.hi = N_STEPS; hipLaunchKernelGGL(mega, dim3(grid), dim3(NTHREADS), LDS_BYTES, stream, a); }
    else for (int s = 0; s < N_STEPS; ++s) { a.lo = s; a.hi = s + 1; hipLaunchKernelGGL(mega, dim3(grid), dim3(NTHREADS), LDS_BYTES, stream, a); }
    const hipError_t le = hipPeekAtLastError();
    if (le != hipSuccess) fprintf(stderr, "kernel_launch: launch failed: %s\n", hipGetErrorName(le));
}
```

```cpp
#include <hip/hip_runtime.h>
#include <cstdio>
#include <cstdint>

#ifndef MK_N_LAUNCHES
#define MK_N_LAUNCHES 1
#endif

#define GAS __attribute__((address_space(1)))
#define LAS __attribute__((address_space(3)))
typedef unsigned short bf16;
typedef short bf16x8 __attribute__((ext_vector_type(8)));
typedef float f32x4 __attribute__((ext_vector_type(4)));
typedef float f32x16 __attribute__((ext_vector_type(16)));
typedef unsigned u32x4 __attribute__((ext_vector_type(4)));
typedef unsigned u32x2 __attribute__((ext_vector_type(2)));
typedef float f32x2 __attribute__((ext_vector_type(2)));

constexpr int NB = 16, S = 2048, T = NB * S, D = 1024, DEPTH = 4;
constexpr int FF = 2816, EF = 3584, NE = 8, PLE = 256;
constexpr float EPS = 1e-6f, LOG2E = 1.4426950408889634f;
constexpr int NWAVES = 8, NTHREADS = 512;
constexpr int MOE_ROWS = 2 * T + NE * 256;

enum { I_X = 0, I_P, I_ATTN_NORM, I_FFN_NORM, I_PLE_NORM, I_PLE_W_IN, I_PLE_W_GATE, I_MLA_W_DOWN, I_MLA_Q_NORM, I_MLA_W_UQ, I_MLA_KV_NORM, I_MLA_W_UKV,
       I_MLA_Q_GAIN, I_MLA_K_GAIN, I_MLA_W_O, I_SWA_W_QKV, I_SWA_Q_GAIN, I_SWA_K_GAIN, I_SWA_SINK, I_SWA_W_O, I_AX_W_QKV, I_AX_Q_GAIN, I_AX_K_GAIN, I_AX_W_O,
       I_FFN_W_GATE, I_FFN_W_UP, I_FFN_W_DOWN, I_MOE_W_ROUTER, I_MOE_B_ROUTER, I_MOE_W_GATE, I_MOE_W_UP, I_MOE_W_DOWN, N_IN };

constexpr size_t MiB = 1u << 20;
constexpr size_t WS_CTL = 0, CTL_ZERO_BYTES = 8 * MiB;
constexpr size_t WS_WT = 8 * MiB;
constexpr size_t WS_WMOE = 72 * MiB;
constexpr size_t WS_XB = 240 * MiB;
constexpr size_t WS_PB = 304 * MiB;
constexpr size_t WS_MOEL = 368 * MiB;
constexpr size_t WS_ACT = 372 * MiB;
constexpr size_t WS_PT = 966 * MiB;
constexpr size_t WS_END = 1030 * MiB;
constexpr size_t A_C = 0, A_QR = 32 * MiB, A_KV = 128 * MiB, A_O = 288 * MiB;
constexpr size_t A_XA = 352 * MiB;
constexpr size_t A_HID = 0;
constexpr size_t A_Y = 462 * MiB;
static_assert((size_t)MOE_ROWS * EF * 2 <= A_Y && A_Y + (size_t)MOE_ROWS * D * 2 <= 594 * MiB, "act map");
constexpr size_t WT_DOWN = 0, WT_UQ = 1048576, WT_UKV = 1835008, WT_WO = 3145728, WT_SQKV = 7340032, WT_AQKV = 8912896, WT_FGU = 11010048, WT_FDN = 22544384,
                 WT_PIN = 28311552, WT_PG = 29360128, WT_TOTAL = 33554432;
static_assert(WT_TOTAL * 2 <= 64 * MiB, "weights");
constexpr size_t WM_GU = 0, WM_DN = (size_t)NE * 7168 * 1024;
constexpr int CW_BAR = 4096;
constexpr int CW_MOECNT = 16384;
constexpr int CW_ROUTEPUB = 32768;
constexpr size_t CTL_SS = 1 * MiB;
constexpr size_t CTL_SSC = CTL_SS + 12 * (size_t)T * 8;
static_assert(CTL_SSC + 4 * (size_t)T * 8 <= CTL_ZERO_BYTES, "ctl");
typedef unsigned long long ssq_t;

constexpr int RING_BYTES = 131072, MISC_OFF = RING_BYTES + 320, LDS_BYTES = 147456;

__device__ __forceinline__ unsigned f2bf(float f) { unsigned u = __builtin_bit_cast(unsigned, f); return (u + 0x7fffu + ((u >> 16) & 1u)) >> 16; }
__device__ __forceinline__ unsigned pk2(float lo, float hi) { return f2bf(lo) | (f2bf(hi) << 16); }
__device__ __forceinline__ unsigned hpk2(float lo, float hi) { unsigned r; asm volatile("v_cvt_pk_bf16_f32 %0, %1, %2" : "=v"(r) : "v"(lo), "v"(hi)); return r; }
__device__ __forceinline__ float bf2f(unsigned short b) { return __builtin_bit_cast(float, (unsigned)b << 16); }
__device__ __forceinline__ float bflo(unsigned w) { return __builtin_bit_cast(float, w << 16); }
__device__ __forceinline__ float bfhi(unsigned w) { return __builtin_bit_cast(float, w & 0xffff0000u); }
__device__ __forceinline__ float wave_sum(float v) {
#pragma unroll
    for (int o = 1; o < 64; o <<= 1) v += __shfl_xor(v, o);
    return v;
}
__device__ __forceinline__ float ss_get(const ssq_t* p, int m) { return (float)p[m] * (1.0f / 16777216.0f); }
__device__ __forceinline__ void ss_add(ssq_t* p, int m, float q) { atomicAdd(p + m, (ssq_t)(q * 16777216.0f)); }
__device__ __forceinline__ void ss_set(ssq_t* p, int m, float q) { p[m] = (ssq_t)(q * 16777216.0f); }
__device__ __forceinline__ void fast_sincos(float ang, float& sn, float& cs) { float r = ang * 0.15915494309189535f; r = r - floorf(r); sn = __builtin_amdgcn_sinf(r); cs = __builtin_amdgcn_cosf(r); }
__device__ __forceinline__ int tid_now() { int t = threadIdx.x; asm volatile("" : "+v"(t)); return t; }
__device__ __forceinline__ int crow(int r, int hi) { return (r & 3) + 8 * (r >> 2) + 4 * hi; }
#define LDS_WAIT() asm volatile("s_waitcnt lgkmcnt(0)" ::: "memory")

#define XB_TMO      128
#define XB_XCNT(j)  (256  + 64 * (j))
#define XB_XSUB(j)  (1280 + 64 * (j))
#define XB_XGEN(j)  (2304 + 64 * (j))
#define XB_TOP      3328
#define XB_TOPGEN   3392
#define XCD_BAR_WORDS 3456
#define XB_SPIN_CAP (1u << 22)
__device__ __forceinline__ unsigned xb_ld(unsigned* p)              { return __hip_atomic_load(p, __ATOMIC_RELAXED, __HIP_MEMORY_SCOPE_AGENT); }
__device__ __forceinline__ unsigned xb_add(unsigned* p, unsigned v) { return __hip_atomic_fetch_add(p, v, __ATOMIC_RELAXED, __HIP_MEMORY_SCOPE_AGENT); }
__device__ __forceinline__ unsigned xb_xcc_id() { return (unsigned)__builtin_amdgcn_s_getreg((3 << 11) | 20) & 0xFu; }
#define XB_SPIN(cond, bar) do { unsigned _sp = 0; while (cond) { __builtin_amdgcn_s_sleep(1); \
    if ((++_sp & 255u) == 0u) { if (xb_ld(&(bar)[XB_TMO])) break; if (_sp > XB_SPIN_CAP) { atomicAdd(&(bar)[XB_TMO], 1u); break; } } } } while (0)
struct XcdBarrier { unsigned* bar; unsigned x; volatile LAS unsigned* st; };
__device__ __forceinline__ XcdBarrier xcd_barrier_post(unsigned* bar, volatile LAS unsigned* st) {
    XcdBarrier b; b.bar = bar; b.x = xb_xcc_id(); b.st = st;
    if (threadIdx.x == 0) (void)xb_add(&bar[XB_XCNT(b.x)], 1u);
    return b;
}
__device__ __forceinline__ void xcd_barrier_complete(unsigned* bar, unsigned x, unsigned& nloc, unsigned& nx) {
    const unsigned G = gridDim.x * gridDim.y * gridDim.z;
    unsigned sum, cnt, mine, sp = 0u;
    for (;;) {
        sum = 0u; cnt = 0u; mine = 0u;
#pragma unroll
        for (unsigned j = 0; j < 16; ++j) { const unsigned c = xb_ld(&bar[XB_XCNT(j)]); sum += c; cnt += (c > 0u) ? 1u : 0u; mine = (j == x) ? c : mine; }
        if (sum == G) break;
        __builtin_amdgcn_s_sleep(1);
        if ((++sp & 255u) == 0u) { if (xb_ld(&bar[XB_TMO])) break; if (sp > XB_SPIN_CAP) { atomicAdd(&bar[XB_TMO], 1u); break; } }
    }
    nloc = mine > 0u ? mine : 1u; nx = cnt > 0u ? cnt : 1u;
}
__device__ __forceinline__ void xcd_barrier(const XcdBarrier& b) {
    asm volatile("s_waitcnt vmcnt(0)" ::: "memory");
    __syncthreads();
    if (threadIdx.x == 0) {
        unsigned* bar = b.bar;
        __builtin_amdgcn_s_waitcnt(0);
        unsigned nloc = b.st[0], nx = b.st[1];
        if (nloc == 0u) { xcd_barrier_complete(bar, b.x, nloc, nx); b.st[0] = nloc; b.st[1] = nx; }
        const unsigned old = xb_add(&bar[XB_XSUB(b.x)], 1u);
        const unsigned gen = old / nloc;
        if (old + 1u == (gen + 1u) * nloc) {
            __builtin_amdgcn_fence(__ATOMIC_RELEASE, "agent");
            asm volatile("s_waitcnt vmcnt(0)" ::: "memory");
            const unsigned og = xb_add(&bar[XB_TOP], 1u);
            const unsigned tg = og / nx;
            if (og + 1u == (tg + 1u) * nx) xb_add(&bar[XB_TOPGEN], 1u);
            else XB_SPIN(xb_ld(&bar[XB_TOPGEN]) == tg, bar);
            __builtin_amdgcn_fence(__ATOMIC_ACQUIRE, "agent");
            xb_add(&bar[XB_XGEN(b.x)], 1u);
            asm volatile("s_waitcnt vmcnt(0)" ::: "memory");
        } else {
            XB_SPIN(xb_ld(&bar[XB_XGEN(b.x)]) == gen, bar);
            __builtin_amdgcn_fence(__ATOMIC_ACQUIRE, "agent");
            asm volatile("s_waitcnt vmcnt(0)" ::: "memory");
        }
    }
    __syncthreads();
}

struct Args { const float* in[N_IN]; float* out; unsigned char* ws; int lo, hi; };
struct Frame {
    LAS unsigned char* lds; unsigned* ctl;
    int tid, lane, wave, gw, ngw;
};

__device__ __forceinline__ const float* cvt_src(int mode, int n0, const float* W, const float* W2, int nsrc) {
    if (mode == 0) return n0 < nsrc ? W + n0 : nullptr;
    if (mode == 1) { if (n0 < 1024) return W + (n0 >> 6) * 128 + (n0 & 63); const int n = n0 - 1024; return W + (n >> 6) * 128 + 64 + (n & 63); }
    const int tile = n0 / 256, w = n0 % 256; return w < 128 ? W + tile * 128 + w : W2 + tile * 128 + (w - 128);
}
__device__ __forceinline__ void cvt_load64(f32x4 (&v)[16], const float* s0, const float* s1, int ldw, int k0, int lane) {
    const int nl = lane & 15, kq = lane >> 4;
    const float* sp = (nl >> 3) ? s1 : s0;
    if (sp) { sp += (size_t)k0 * ldw + 4 * (nl & 7);
#pragma unroll
        for (int i = 0; i < 16; ++i) v[i] = __builtin_nontemporal_load((const f32x4*)(sp + (size_t)(8 * (i >> 1) + 2 * kq + (i & 1)) * ldw)); }
    else {
#pragma unroll
        for (int i = 0; i < 16; ++i) v[i] = (f32x4){0.f, 0.f, 0.f, 0.f}; }
}
__device__ __forceinline__ void cvt_finish64(const f32x4 (&v)[16], const float* gain, bf16* WT, int ldk, int dstrow0, int k0, LAS unsigned* scr, int lane) {
    const int nl = lane & 15, kq = lane >> 4;
    float g[16];
    if (gain) {
#pragma unroll
        for (int p = 0; p < 8; ++p) { const f32x2 gg = *(const f32x2*)(gain + k0 + 8 * p + 2 * kq); g[2 * p] = gg.x; g[2 * p + 1] = gg.y; } }
    else {
#pragma unroll
        for (int p = 0; p < 16; ++p) g[p] = 1.f; }
#pragma unroll
    for (int p = 0; p < 8; ++p) {
#pragma unroll
        for (int j = 0; j < 4; ++j) scr[(4 * nl + j) * 34 + 4 * p + kq] = hpk2(v[2 * p][j] * g[2 * p], v[2 * p + 1][j] * g[2 * p + 1]); }
    LDS_WAIT(); asm volatile("" ::: "memory");
    const int c = lane & 7;
#pragma unroll
    for (int r = 0; r < 8; ++r) { const int n = (lane >> 3) + 8 * r; const u32x2 lo_ = *(const LAS u32x2*)(scr + n * 34 + 4 * c), hi_ = *(const LAS u32x2*)(scr + n * 34 + 4 * c + 2);
        *(u32x4*)(WT + (size_t)(dstrow0 + n) * ldk + k0 + 8 * c) = (u32x4){lo_.x, lo_.y, hi_.x, hi_.y}; }
    LDS_WAIT(); asm volatile("" ::: "memory");
}
__device__ __forceinline__ void cvt_item64(const float* s0, const float* s1, int ldw, const float* gain, bf16* WT, int ldk, int dstrow0, int k0, LAS unsigned* scr, int lane) {
    f32x4 v[16]; cvt_load64(v, s0, s1, ldw, k0, lane); cvt_finish64(v, gain, WT, ldk, dstrow0, k0, scr, lane);
}
struct MoeCvtItem { const float* s0; const float* s1; const float* gain; bf16* dst; int ldw, ldk, n0, k0; };
__device__ __forceinline__ MoeCvtItem moe_cvt_item(int it, const float* Wg, const float* Wu, const float* Wd, const float* gain, bf16* WM) {
    const int e = it / 2688; int r = it - e * 2688; MoeCvtItem d;
    if (r < 1792) { const int kb = r / 112, nb = r - kb * 112, n0 = nb * 64, tile = n0 >> 8, w = n0 & 255; const float* base = (w < 128 ? Wg : Wu) + (size_t)e * D * EF + tile * 128 + (w & 127);
        d.s0 = base; d.s1 = base + 32; d.gain = gain; d.dst = WM + WM_GU + (size_t)e * 7168 * 1024; d.ldw = EF; d.ldk = 1024; d.n0 = n0; d.k0 = kb * 64; }
    else { r -= 1792; const int kb = r >> 4, nb = r & 15, n0 = nb * 64; const float* base = Wd + (size_t)e * EF * D + n0;
        d.s0 = base; d.s1 = base + 32; d.gain = nullptr; d.dst = WM + WM_DN + (size_t)e * 1024 * EF; d.ldw = D; d.ldk = EF; d.n0 = n0; d.k0 = kb * 64; }
    return d;
}
__device__ __forceinline__ void moe_cvt_all(const Frame& F, const float* Wg, const float* Wu, const float* Wd, const float* gain, bf16* WM) {
    LAS unsigned* scr = (LAS unsigned*)(F.lds + F.wave * 16384);
    constexpr int NIT = NE * 2688;
    for (int it = F.gw; it < NIT; it += F.ngw) {
        const MoeCvtItem da = moe_cvt_item(it, Wg, Wu, Wd, gain, WM);
        cvt_item64(da.s0, da.s1, da.ldw, da.gain, da.dst, da.ldk, da.n0, da.k0, scr, F.lane);
    }
}
__device__ __forceinline__ void cvt_job(const Frame& F, const float* W, const float* W2, int ldw, int nsrc, const float* gain, bf16* WT, int K, int Ndst, int mode, int wofs, int ldk = 0) {
    if (ldk == 0) ldk = K;
    LAS unsigned* scr = (LAS unsigned*)(F.lds + F.wave * 16384);
    const int nblk = Ndst / 64, nitems = (K / 64) * nblk;
    int start = F.gw - (wofs % F.ngw); if (start < 0) start += F.ngw;
    for (int it = start; it < nitems; it += F.ngw) {
        const int kb = it / nblk, nb = it % nblk, n0 = nb * 64;
        cvt_item64(cvt_src(mode, n0, W, W2, nsrc), cvt_src(mode, n0 + 32, W, W2, nsrc), ldw, gain, WT, ldk, n0, kb * 64, scr, F.lane);
    }
}

template <int NSUB, class P>
__device__ __forceinline__ void ngemm(const Frame& F, const P& p) {
    const int r32 = F.lane & 31, hi = F.lane >> 5;
    const int ntn = p.ntn(), ntiles = p.ntm() * ntn;
    for (int tile = F.gw; tile < ntiles; tile += F.ngw) {
        const int tm = tile / ntn, tn = tile % ntn;
        typename P::Ctx c;
        if (!p.setup(tm * 64, c)) continue;
        const bf16* a0 = p.arow(c, tm * 64 + r32) + hi * 8;
        const bf16* a1 = p.arow(c, tm * 64 + 32 + r32) + hi * 8;
        const bf16* b[NSUB];
#pragma unroll
        for (int s = 0; s < NSUB; ++s) b[s] = p.brow(c, s, tn * 32 + r32) + hi * 8;
        f32x16 acc[2][NSUB];
#pragma unroll
        for (int i = 0; i < 2; ++i)
#pragma unroll
            for (int s = 0; s < NSUB; ++s)
#pragma unroll
                for (int r = 0; r < 16; ++r) acc[i][s][r] = 0.f;
#pragma unroll 4
        for (int k = 0; k < p.K; k += 16) {
            const bf16x8 fa0 = *(const bf16x8*)(a0 + k), fa1 = *(const bf16x8*)(a1 + k);
#pragma unroll
            for (int s = 0; s < NSUB; ++s) { const bf16x8 fb = *(const bf16x8*)(b[s] + k);
                acc[0][s] = __builtin_amdgcn_mfma_f32_32x32x16_bf16(fa0, fb, acc[0][s], 0, 0, 0);
                acc[1][s] = __builtin_amdgcn_mfma_f32_32x32x16_bf16(fa1, fb, acc[1][s], 0, 0, 0); }
        }
#pragma unroll
        for (int i = 0; i < 2; ++i)
#pragma unroll
            for (int r = 0; r < 16; ++r) p.store(c, tm * 64 + 32 * i + crow(r, hi), tn * 32 + r32, acc[i][0][r], NSUB > 1 ? acc[i][NSUB - 1][r] : 0.f);
    }
}
__device__ __forceinline__ float half_sum32(float v) {
#pragma unroll
    for (int o = 1; o < 32; o <<= 1) v += __shfl_xor(v, o);
    return v;
}
struct NoCtx {};
struct PlainP {
    typedef NoCtx Ctx;
    const bf16* A; int lda; const bf16* Bt; int M, N, K; bf16* O; int ldo; const ssq_t* rs; int rs_mode; float rs_inv_dim;
    ssq_t* st0; int st0_end; ssq_t* st1; int st1_end;
    __device__ int ntm() const { return M / 64; } __device__ int ntn() const { return N / 32; }
    __device__ bool setup(int, Ctx&) const { return true; }
    __device__ const bf16* arow(const Ctx&, int m) const { return A + (size_t)m * lda; }
    __device__ const bf16* brow(const Ctx&, int, int n) const { return Bt + (size_t)n * K; }
    __device__ void store(const Ctx&, int m, int n, float v, float) const {
        float sc = 1.f; if (rs_mode == 1) sc = 1.0f / sqrtf(ss_get(rs, m) * rs_inv_dim + EPS);
        v *= sc; O[(size_t)m * ldo + n] = (bf16)f2bf(v);
        const int n0 = n & ~31;
        if (st0 && n0 < st1_end) { const float q = half_sum32(v * v); if ((n & 31) == 0) ss_add(n0 < st0_end ? st0 : st1, m, q); }
    }
};
struct ResidP {
    typedef NoCtx Ctx;
    const bf16* A; int lda; const bf16* Bt; int M, N, K; const float* xsrc; float* out; bf16* xb; ssq_t* ss;
    __device__ int ntm() const { return M / 64; } __device__ int ntn() const { return N / 32; }
    __device__ bool setup(int, Ctx&) const { return true; }
    __device__ const bf16* arow(const Ctx&, int m) const { return A + (size_t)m * lda; }
    __device__ const bf16* brow(const Ctx&, int, int n) const { return Bt + (size_t)n * K; }
    __device__ void store(const Ctx&, int m, int n, float v, float) const {
        const size_t o = (size_t)m * D + n; const float x = xsrc[o] + v; out[o] = x; xb[o] = (bf16)f2bf(x);
        const float q = half_sum32(x * x); if ((n & 31) == 0) ss_add(ss, m, q);
    }
};
struct SwigluP {
    typedef NoCtx Ctx;
    const bf16* A; const bf16* Bt; int M, NH, K; bf16* H; const ssq_t* ss;
    __device__ int ntm() const { return M / 64; } __device__ int ntn() const { return NH / 32; }
    __device__ bool setup(int, Ctx&) const { return true; }
    __device__ const bf16* arow(const Ctx&, int m) const { return A + (size_t)m * D; }
    __device__ const bf16* brow(const Ctx&, int s, int n) const { return Bt + (size_t)((n >> 7) * 256 + (n & 127) + s * 128) * K; }
    __device__ void store(const Ctx&, int m, int n, float g, float u) const {
        const float sc = 1.0f / sqrtf(ss_get(ss, m) * (1.0f / D) + EPS); g *= sc; u *= sc;
        H[(size_t)m * NH + n] = (bf16)f2bf(g / (1.0f + __expf(-g)) * u);
    }
};
struct MoeCtx { int e, row0, cnt; };
__device__ __forceinline__ bool moe_find(const unsigned* cnt, int m0, MoeCtx& c) {
    int base = 0;
#pragma unroll
    for (int e = 0; e < NE; ++e) { const int n = (int)cnt[e * 64]; const int rows = ((n + 255) >> 8) << 8; if (m0 < base + rows) { c.e = e; c.row0 = base; c.cnt = n; return true; } base += rows; }
    return false;
}
struct MoeGuP {
    typedef MoeCtx Ctx;
    const bf16* XB; const bf16* Wgu; int K; bf16* H; const ssq_t* ss; const unsigned* cnt; const int* idx;
    __device__ int ntm() const { return MOE_ROWS / 64; } __device__ int ntn() const { return EF / 32; }
    __device__ bool setup(int m0, Ctx& c) const { return moe_find(cnt, m0, c); }
    __device__ int tok(const Ctx& c, int m) const { const int slot = m - c.row0; return slot < c.cnt ? idx[c.e * T + slot] : 0; }
    __device__ const bf16* arow(const Ctx& c, int m) const { return XB + (size_t)tok(c, m) * D; }
    __device__ const bf16* brow(const Ctx& c, int s, int n) const { return Wgu + ((size_t)c.e * 7168 + (n >> 7) * 256 + (n & 127) + s * 128) * K; }
    __device__ void store(const Ctx& c, int m, int n, float g, float u) const {
        const float sc = 1.0f / sqrtf(ss_get(ss, tok(c, m)) * (1.0f / D) + EPS); g *= sc; u *= sc;
        H[(size_t)m * EF + n] = (bf16)f2bf(g / (1.0f + __expf(-g)) * u);
    }
};
struct MoeDnP {
    typedef MoeCtx Ctx;
    const bf16* Hd; const bf16* Wdn; int K; bf16* Y; const unsigned* cnt; const float* wl;
    __device__ int ntm() const { return MOE_ROWS / 64; } __device__ int ntn() const { return D / 32; }
    __device__ bool setup(int m0, Ctx& c) const { return moe_find(cnt, m0, c); }
    __device__ const bf16* arow(const Ctx&, int m) const { return Hd + (size_t)m * EF; }
    __device__ const bf16* brow(const Ctx& c, int, int n) const { return Wdn + ((size_t)c.e * D + n) * K; }
    __device__ void store(const Ctx& c, int m, int n, float v, float) const {
        const int slot = m - c.row0; const float w = slot < c.cnt ? wl[c.e * T + slot] : 0.f;
        Y[(size_t)m * D + n] = (bf16)f2bf(v * w);
    }
};
struct PleP {
    typedef NoCtx Ctx;
    const bf16* A; const bf16* Bt; int M, N, K; const bf16* PT; float* out; bf16* xb; const ssq_t* ss; ssq_t* ssn;
    __device__ int ntm() const { return M / 64; } __device__ int ntn() const { return N / 32; }
    __device__ bool setup(int, Ctx&) const { return true; }
    __device__ const bf16* arow(const Ctx&, int m) const { return A + (size_t)m * D; }
    __device__ const bf16* brow(const Ctx&, int, int n) const { return Bt + (size_t)n * K; }
    __device__ void store(const Ctx&, int m, int n, float v, float) const {
        const size_t o = (size_t)m * D + n; const float sc = 1.0f / sqrtf(ss_get(ss, m) * (1.0f / D) + EPS);
        const float g = 1.0f / (1.0f + __expf(-v * sc)); const float x = out[o] + bf2f(PT[o]) * g; out[o] = x; xb[o] = (bf16)f2bf(x);
        if (ssn) { const float q = half_sum32(x * x); if ((n & 31) == 0) ss_add(ssn, m, q); }
    }
};


namespace pg8 {
constexpr int BM = 256, BK = 64, HALF = 128, HTB = HALF * BK * 2, STAGE_BYTES = 8 * HTB, NXCD = 8, WGM = 8;
__host__ __device__ __forceinline__ int lds_byte(int r, int c) { const int st = (r >> 4) * 2 + (c >> 5), rr = r & 15, cc = c & 31, ob = rr * 64 + cc * 2; return st * 1024 + (ob ^ (((ob >> 9) & 1) << 5)); }
__host__ __device__ __forceinline__ void stage_rc(int b, int& R, int& C) { const int st = b / 1024, sb = b % 1024, swz = sb ^ (((sb >> 9) & 1) << 5); R = (st >> 1) * 16 + swz / 64; C = (st & 1) * 32 + (swz % 64) / 2; }
__host__ __device__ __forceinline__ int perm32(int rho) { const int n = rho >> 4, i = rho & 15; return 8 * (i >> 2) + 4 * n + (i & 3); }
struct Unit { int pm, pn, e, slot0, cnt, ks, aux; };
struct Gemm { const bf16* A; const bf16* Bt; int K, lda, ldb; };

struct StaticOrder {
    static constexpr bool GATHER = false;
    int nM, nN, nwg, G, c;
    __device__ __forceinline__ void init(int M, int N, int G_, int c_) { nM = M / BM; nN = N / BM; nwg = nM * nN; G = G_; c = c_; }
    __device__ __forceinline__ bool next(int i, Unit& u) const {
        const long L = (long)i * G + c; if (L >= nwg) return false;
        int wgid = (int)L; { const int q = nwg / NXCD, r = nwg % NXCD, xcd = wgid % NXCD, off = wgid / NXCD; wgid = (xcd < r ? xcd * (q + 1) : r * (q + 1) + (xcd - r) * q) + off; }
        const int nig = WGM * nN, gid = wgid / nig, fm = gid * WGM, gsz = (nM - fm) < WGM ? (nM - fm) : WGM;
        u.pm = fm + ((wgid % nig) % gsz); u.pn = (wgid % nig) / gsz; u.e = 0; u.slot0 = 0; u.cnt = 0; return true;
    }
    __device__ __forceinline__ const char* a_base(const Gemm& g, const Unit& u) const { return (const char*)g.A + (size_t)u.pm * ((size_t)BM * g.lda * 2); }
    __device__ __forceinline__ size_t k_off(const Unit&) const { return 0; }
    __device__ __forceinline__ void a_raw(const Unit&, const int (&)[2], int (&)[2][2]) const {}
    __device__ __forceinline__ void a_fin(const Unit&, const int (&)[2], const int (&)[2], int, const int (&)[2][2], unsigned (&)[2][2]) const {}
    __device__ __forceinline__ void a_offs(const Unit&, const int (&RA)[2], const int (&CA)[2], int lda, unsigned (&v)[2][2]) const {
#pragma unroll
        for (int h = 0; h < 2; ++h)
#pragma unroll
            for (int i = 0; i < 2; ++i) v[h][i] = (unsigned)((RA[i] + HALF * h) * lda + CA[i]) * 2u;
    }
};
template <bool GATHER_> struct GroupedOrder {
    static constexpr bool GATHER = GATHER_;
    int NT, G, c, nunits, nlim; const LAS int* tab; const int* idx;
    __device__ __forceinline__ void init(const unsigned* cnt, int NT_, int G_, int c_, const int* idx_, LAS int* tab_) { NT = NT_; G = G_; c = c_; idx = idx_; tab = tab_;
        __syncthreads();
        if (threadIdx.x < 8) tab_[threadIdx.x] = (int)cnt[threadIdx.x * 64];
        __syncthreads();
        if (threadIdx.x == 0) { int t = 0; tab_[8] = 0; for (int e = 0; e < 8; ++e) { t += (tab_[e] + 255) >> 8; tab_[9 + e] = t; } }
        __syncthreads();
        nunits = __builtin_amdgcn_readfirstlane(tab_[16]) * NT; nlim = nunits; }
    __device__ __forceinline__ bool next(int i, Unit& u) const {
        const int L = i * G + c; if (L >= nlim) return false;
        int wgid = L; { const int q = nlim / NXCD, r = nlim % NXCD, xcd = wgid % NXCD, off = wgid / NXCD; wgid = (xcd < r ? xcd * (q + 1) : r * (q + 1) + (xcd - r) * q) + off; }
        decode(wgid, u); return true;
    }
    __device__ __forceinline__ void decode(int wgid, Unit& u) const {
        const int nM = nunits / NT, nig = WGM * NT, gid = wgid / nig, fm = gid * WGM, gsz = (nM - fm) < WGM ? (nM - fm) : WGM, rem = wgid - gid * nig;
        const int mt = fm + rem % gsz, pnl = rem / gsz; int e = 0;
#pragma unroll
        for (int j = 1; j < 8; ++j) if (mt >= tab[8 + j]) e = j;
        e = __builtin_amdgcn_readfirstlane(e);
        u.pm = mt; u.pn = e * NT + pnl; u.e = e; u.slot0 = (mt - __builtin_amdgcn_readfirstlane(tab[8 + e])) * 256; u.cnt = __builtin_amdgcn_readfirstlane(tab[e]);
    }
    __device__ __forceinline__ const char* a_base(const Gemm& g, const Unit& u) const { return GATHER ? (const char*)g.A : (const char*)g.A + (size_t)u.pm * ((size_t)BM * g.lda * 2); }
    __device__ __forceinline__ size_t k_off(const Unit&) const { return 0; }
    __device__ __forceinline__ void a_raw(const Unit& u, const int (&RA)[2], int (&tk)[2][2]) const {
#pragma unroll
        for (int h = 0; h < 2; ++h)
#pragma unroll
            for (int i = 0; i < 2; ++i) tk[h][i] = GATHER ? __builtin_nontemporal_load(idx + u.e * T + u.slot0 + RA[i] + HALF * h) : 0;
    }
    __device__ __forceinline__ void a_fin(const Unit& u, const int (&RA)[2], const int (&CA)[2], int lda, const int (&tk)[2][2], unsigned (&v)[2][2]) const {
#pragma unroll
        for (int h = 0; h < 2; ++h)
#pragma unroll
            for (int i = 0; i < 2; ++i) { const int slot = u.slot0 + RA[i] + HALF * h; int raw = tk[h][i]; asm volatile("" : "+v"(raw));
                const int tok = slot < u.cnt ? raw : 0; v[h][i] = (unsigned)(tok * lda + CA[i]) * 2u; }
    }
    __device__ __forceinline__ void a_offs(const Unit& u, const int (&RA)[2], const int (&CA)[2], int lda, unsigned (&v)[2][2]) const {
#pragma unroll
        for (int h = 0; h < 2; ++h)
#pragma unroll
            for (int i = 0; i < 2; ++i) {
                if (GATHER) { const int slot = u.slot0 + RA[i] + HALF * h; int tok = __builtin_nontemporal_load(idx + u.e * T + slot); tok = slot < u.cnt ? tok : 0; v[h][i] = (unsigned)(tok * lda + CA[i]) * 2u; }
                else v[h][i] = (unsigned)((RA[i] + HALF * h) * lda + CA[i]) * 2u; }
    }
};

struct SliceOrder {
    static constexpr bool GATHER = false;
    GroupedOrder<false> go; int first, ntail, nslice, kbytes, G, c;
    __device__ __forceinline__ bool next(int i, Unit& u) const {
        const int j = i * G + c; if (j >= ntail * nslice) return false;
        const int ks = j / ntail; go.decode(first + (j - ks * ntail), u); u.ks = ks; u.aux = j; return true;
    }
    __device__ __forceinline__ const char* a_base(const Gemm& g, const Unit& u) const { return (const char*)g.A + (size_t)u.pm * ((size_t)BM * g.lda * 2) + (size_t)u.ks * kbytes; }
    __device__ __forceinline__ size_t k_off(const Unit& u) const { return (size_t)u.ks * kbytes; }
    __device__ __forceinline__ void a_raw(const Unit&, const int (&)[2], int (&)[2][2]) const {}
    __device__ __forceinline__ void a_fin(const Unit&, const int (&)[2], const int (&)[2], int, const int (&)[2][2], unsigned (&)[2][2]) const {}
    __device__ __forceinline__ void a_offs(const Unit&, const int (&RA)[2], const int (&CA)[2], int lda, unsigned (&v)[2][2]) const {
#pragma unroll
        for (int h = 0; h < 2; ++h)
#pragma unroll
            for (int i = 0; i < 2; ++i) v[h][i] = (unsigned)((RA[i] + HALF * h) * lda + CA[i]) * 2u;
    }
};

__device__ __forceinline__ unsigned cvt_pk_bf16(float lo, float hi) { unsigned r; asm volatile("v_cvt_pk_bf16_f32 %0, %1, %2" : "=v"(r) : "v"(lo), "v"(hi)); return r; }
struct EpiCache { int pm; };
__device__ __forceinline__ float rstd_of(const ssq_t* p, int row, float inv_dim) { return __builtin_amdgcn_rsqf((float)p[row] * (1.0f / 16777216.0f) * inv_dim + EPS); }
__device__ __forceinline__ float sumsq4(f32x4 v) { return (v[0] * v[0] + v[1] * v[1]) + (v[2] * v[2] + v[3] * v[3]); }

template <bool STATS> struct EpiPlain {
    static constexpr bool PERM = true;
    bf16* O; int ldo, ntile; const ssq_t* rs; float rs_inv_dim; const float* wl; ssq_t* st0; ssq_t* st1;
    __device__ __forceinline__ void operator()(const f32x4 (&acc)[2][2][4][2], const Unit& u, int wr, int wc, int fr, int fq, EpiCache& ec) const {
        const int pnl = u.pn - u.e * ntile, row0 = u.pm * BM + wr * 64 + fr, col0 = pnl * BM + wc * 32 + 8 * fq;
        float sc[2][4];
#pragma unroll
        for (int ai = 0; ai < 2; ++ai)
#pragma unroll
            for (int m = 0; m < 4; ++m) { const int r = ai * HALF + m * 16;
                if (rs) sc[ai][m] = rstd_of(rs, row0 + r, rs_inv_dim);
                else if (wl) { const int slot = u.slot0 + wr * 64 + fr + r; const float w_ = __builtin_nontemporal_load(wl + u.e * T + slot); sc[ai][m] = slot < u.cnt ? w_ : 0.f; }
                else sc[ai][m] = 1.f; }
#pragma unroll
        for (int ai = 0; ai < 2; ++ai)
#pragma unroll
            for (int m = 0; m < 4; ++m) { const int row = row0 + ai * HALF + m * 16; bf16* rowp = O + (size_t)row * ldo + col0; float q = 0.f;
#pragma unroll
                for (int bj = 0; bj < 2; ++bj) { const f32x4 v0 = acc[ai][bj][m][0] * sc[ai][m], v1 = acc[ai][bj][m][1] * sc[ai][m];
                    u32x4 w; w.x = cvt_pk_bf16(v0[0], v0[1]); w.y = cvt_pk_bf16(v0[2], v0[3]); w.z = cvt_pk_bf16(v1[0], v1[1]); w.w = cvt_pk_bf16(v1[2], v1[3]);
                    *(u32x4*)(rowp + bj * HALF) = w;
                    if (STATS) { if (pnl == 0 || bj == 0) q += sumsq4(v0) + sumsq4(v1); } }
                if (STATS) { q += __shfl_xor(q, 16); q += __shfl_xor(q, 32); if (fq == 0) ss_add(pnl == 0 ? st0 : st1, row, q); } }
    }
};
struct EpiPartial {
    static constexpr bool PERM = true;
    float* P;
    __device__ __forceinline__ void operator()(const f32x4 (&acc)[2][2][4][2], const Unit& u, int wr, int wc, int fr, int fq, EpiCache& ec) const {
        float* p = P + (size_t)u.aux * 65536 + (wr * 64 + fr) * 256 + wc * 32 + 8 * fq;
#pragma unroll
        for (int ai = 0; ai < 2; ++ai)
#pragma unroll
            for (int m = 0; m < 4; ++m)
#pragma unroll
                for (int bj = 0; bj < 2; ++bj) { float* q = p + (ai * HALF + m * 16) * 256 + bj * HALF; *(f32x4*)q = acc[ai][bj][m][0]; *(f32x4*)(q + 4) = acc[ai][bj][m][1]; }
    }
};
struct EpiPlainNP {
    static constexpr bool PERM = false;
    bf16* O; int ldo;
    __device__ __forceinline__ void operator()(const f32x4 (&acc)[2][2][4][2], const Unit& u, int wr, int wc, int fr, int fq, EpiCache& ec) const {
        const int row0 = u.pm * BM + wr * 64 + fr, col0 = u.pn * BM + wc * 32 + 4 * fq;
#pragma unroll
        for (int ai = 0; ai < 2; ++ai)
#pragma unroll
            for (int m = 0; m < 4; ++m) { bf16* rowp = O + (size_t)(row0 + ai * HALF + m * 16) * ldo + col0;
#pragma unroll
                for (int bj = 0; bj < 2; ++bj)
#pragma unroll
                    for (int n = 0; n < 2; ++n) { const f32x4 x = acc[ai][bj][m][n]; *(u32x2*)(rowp + bj * HALF + n * 16) = (u32x2){cvt_pk_bf16(x[0], x[1]), cvt_pk_bf16(x[2], x[3])}; } }
    }
};
template <bool ROPE> struct EpiKN {
    static constexpr bool PERM = true;
    bf16* O; int ldo, kt_lo, kt_hi, vshift; const ssq_t* rs; float rs_inv_dim; const float* kgain; const bf16* Crope; LAS float* part;
    __device__ __forceinline__ void operator()(const f32x4 (&acc)[2][2][4][2], const Unit& u, int wr, int wc, int fr, int fq, EpiCache& ec) const {
        const int pn = u.pn; const bool kn = pn >= kt_lo && pn < kt_hi;
        int fro = fr, fqo = fq; asm volatile("" : "+v"(fro), "+v"(fqo));
        const int row0 = u.pm * BM + wr * 64 + fro, col0 = pn * BM + (pn >= kt_hi ? vshift : 0) + wc * 32 + 8 * fqo, rt0 = wr * 64 + fro;
        if (!kn) {
#pragma unroll
            for (int ai = 0; ai < 2; ++ai)
#pragma unroll
                for (int m = 0; m < 4; ++m) { const int row = row0 + ai * HALF + m * 16; bf16* rowp = O + (size_t)row * ldo + col0; const float sc = rstd_of(rs, row, rs_inv_dim);
#pragma unroll
                    for (int bj = 0; bj < 2; ++bj) { const f32x4 v0 = acc[ai][bj][m][0] * sc, v1 = acc[ai][bj][m][1] * sc;
                        *(u32x4*)(rowp + bj * HALF) = (u32x4){cvt_pk_bf16(v0[0], v0[1]), cvt_pk_bf16(v0[2], v0[3]), cvt_pk_bf16(v1[0], v1[1]), cvt_pk_bf16(v1[2], v1[3])}; }
                    if (m & 1) asm volatile("" ::: "memory"); }
            return;
        }
#pragma unroll
        for (int ai = 0; ai < 2; ++ai)
#pragma unroll
            for (int m = 0; m < 4; ++m) { const float sc = rstd_of(rs, row0 + ai * HALF + m * 16, rs_inv_dim);
#pragma unroll
                for (int bj = 0; bj < 2; ++bj) { float q = (sumsq4(acc[ai][bj][m][0]) + sumsq4(acc[ai][bj][m][1])) * (sc * sc);
                    q += __shfl_xor(q, 16); q += __shfl_xor(q, 32);
                    if (fqo == 0) part[(rt0 + ai * HALF + m * 16) * 8 + bj * 4 + wc] = q; }
                if (m & 1) asm volatile("" ::: "memory"); }
        asm volatile("s_waitcnt lgkmcnt(0)" ::: "memory"); __builtin_amdgcn_s_barrier(); asm volatile("" ::: "memory");
        constexpr float HD = ROPE ? 96.0f : 64.0f;
        const int dcol = (wc & 1) * 32 + 8 * fqo;
        const f32x4 g0 = *(const f32x4*)(kgain + dcol), g1 = *(const f32x4*)(kgain + dcol + 4);
#pragma unroll
        for (int ai = 0; ai < 2; ++ai)
#pragma unroll
            for (int m = 0; m < 4; ++m) { const int row = row0 + ai * HALF + m * 16, rt = rt0 + ai * HALF + m * 16; bf16* rowp = O + (size_t)row * ldo + col0; const float sc = rstd_of(rs, row, rs_inv_dim);
                float rq = 0.f; f32x4 ka = {0.f, 0.f, 0.f, 0.f}, kb = {0.f, 0.f, 0.f, 0.f};
                if (ROPE) { const u32x2 wa = *(const u32x2*)(Crope + (size_t)row * 512 + 384 + 4 * fqo), wb = *(const u32x2*)(Crope + (size_t)row * 512 + 400 + 4 * fqo);
                    ka = (f32x4){bflo(wa.x), bfhi(wa.x), bflo(wa.y), bfhi(wa.y)}; kb = (f32x4){bflo(wb.x), bfhi(wb.x), bflo(wb.y), bfhi(wb.y)};
                    rq = sumsq4(ka) + sumsq4(kb); rq += __shfl_xor(rq, 16); rq += __shfl_xor(rq, 32);
                    const f32x4 ga = *(const f32x4*)(kgain + 64 + 4 * fqo), gb = *(const f32x4*)(kgain + 80 + 4 * fqo); ka = ka * ga; kb = kb * gb; }
                f32x4 cs4 = {1.f, 1.f, 1.f, 1.f}, sn4 = {0.f, 0.f, 0.f, 0.f};
                if (ROPE) { const int t = row & (S - 1);
#pragma unroll
                    for (int i = 0; i < 4; ++i) { float sn, cs; fast_sincos((float)t * __builtin_amdgcn_exp2f(-(float)(2 * (4 * fqo + i)) * (13.287712379549449f / 32.0f)), sn, cs); cs4[i] = cs; sn4[i] = sn; } }
#pragma unroll
                for (int bj = 0; bj < 2; ++bj) { const float hs = part[rt * 8 + bj * 4 + wc] + part[rt * 8 + bj * 4 + (wc ^ 1)] + rq;
                    const float rh = __builtin_amdgcn_rsqf(hs * (1.0f / HD) + EPS), s_ = sc * rh;
                    const f32x4 v0 = acc[ai][bj][m][0] * s_ * g0, v1 = acc[ai][bj][m][1] * s_ * g1;
                    *(u32x4*)(rowp + bj * HALF) = (u32x4){cvt_pk_bf16(v0[0], v0[1]), cvt_pk_bf16(v0[2], v0[3]), cvt_pk_bf16(v1[0], v1[1]), cvt_pk_bf16(v1[2], v1[3])};
                    if (ROPE) {
                        const int h = (pn - kt_lo) * 4 + bj * 2 + (wc >> 1);
                        const f32x4 o = ((wc & 1) ? ka * sn4 + kb * cs4 : ka * cs4 - kb * sn4) * rh;
                        *(u32x2*)(O + (size_t)row * ldo + 1024 + h * 32 + 16 * (wc & 1) + 4 * fqo) = (u32x2){cvt_pk_bf16(o[0], o[1]), cvt_pk_bf16(o[2], o[3])}; } }
                asm volatile("" ::: "memory"); }
    }
};
__device__ __forceinline__ void unpack8f(const u32x4 w, f32x4& lo, f32x4& hi) { lo = (f32x4){bflo(w.x), bfhi(w.x), bflo(w.y), bfhi(w.y)}; hi = (f32x4){bflo(w.z), bfhi(w.z), bflo(w.w), bfhi(w.w)}; }
struct EpiResid {
    static constexpr bool PERM = true;
    const bf16* base; bf16* xb; ssq_t* ss;
    __device__ __forceinline__ void operator()(const f32x4 (&acc)[2][2][4][2], const Unit& u, int wr, int wc, int fr, int fq, EpiCache& ec) const {
        const int row0 = u.pm * BM + wr * 64 + fr, col0 = u.pn * BM + wc * 32 + 8 * fq;
        u32x4 bv[2][4][2];
#pragma unroll
        for (int ai = 0; ai < 2; ++ai)
#pragma unroll
            for (int m = 0; m < 4; ++m)
#pragma unroll
                for (int bj = 0; bj < 2; ++bj) bv[ai][m][bj] = *(const u32x4*)(base + (size_t)(row0 + ai * HALF + m * 16) * D + col0 + bj * HALF);
#pragma unroll
        for (int ai = 0; ai < 2; ++ai)
#pragma unroll
            for (int m = 0; m < 4; ++m) { const int row = row0 + ai * HALF + m * 16; const size_t off = (size_t)row * D + col0; float q = 0.f;
#pragma unroll
                for (int bj = 0; bj < 2; ++bj) { const size_t o = off + bj * HALF; f32x4 b0, b1; unpack8f(bv[ai][m][bj], b0, b1);
                    const f32x4 x0 = b0 + acc[ai][bj][m][0], x1 = b1 + acc[ai][bj][m][1];
                    *(u32x4*)(xb + o) = (u32x4){cvt_pk_bf16(x0[0], x0[1]), cvt_pk_bf16(x0[2], x0[3]), cvt_pk_bf16(x1[0], x1[1]), cvt_pk_bf16(x1[2], x1[3])}; q += sumsq4(x0) + sumsq4(x1); }
                q += __shfl_xor(q, 16); q += __shfl_xor(q, 32); if (fq == 0) ss_add(ss, row, q); }
    }
};
__device__ __forceinline__ float silu_mul(float g, float u) { return g * __builtin_amdgcn_rcpf(1.0f + __expf(-g)) * u; }
struct EpiSwiglu {
    static constexpr bool PERM = true;
    bf16* H; int ldh, ntile; const ssq_t* ss; const float* rsl; LAS float* ctab;
    __device__ __forceinline__ void operator()(const f32x4 (&acc)[2][2][4][2], const Unit& u, int wr, int wc, int fr, int fq, EpiCache& ec) const {
        const int pnl = u.pn - u.e * ntile, row0 = u.pm * BM + wr * 64 + fr, col0 = pnl * HALF + wc * 32 + 8 * fq;
        LAS float* tabw = ctab + (wr * 4 + wc) * 128 + fr;
        if (ec.pm != u.pm) {
            ec.pm = u.pm;
            if (fq == 0) {
#pragma unroll
                for (int ai = 0; ai < 2; ++ai)
#pragma unroll
                    for (int m = 0; m < 4; ++m) { const int r = ai * HALF + m * 16; float v_;
                        if (ss) v_ = rstd_of(ss, row0 + r, 1.0f / D);
                        else { const int slot = u.slot0 + wr * 64 + fr + r; const float w_ = __builtin_nontemporal_load(rsl + u.e * T + slot); v_ = slot < u.cnt ? w_ : 0.f; }
                        tabw[(ai * 4 + m) * 16] = v_; } }
            asm volatile("s_waitcnt lgkmcnt(0)" ::: "memory");
        }
#pragma unroll
        for (int ai = 0; ai < 2; ++ai)
#pragma unroll
            for (int m = 0; m < 4; ++m) { const int row = row0 + ai * HALF + m * 16; const float s_ = tabw[(ai * 4 + m) * 16], c1 = -s_ * LOG2E, s2 = s_ * s_;
                const f32x4 g0 = acc[ai][0][m][0], g1 = acc[ai][0][m][1], u0 = acc[ai][1][m][0], u1 = acc[ai][1][m][1];
#define SGL(g, u) (((g) * (u)) * (s2 * __builtin_amdgcn_rcpf(1.0f + __builtin_amdgcn_exp2f((g) * c1))))
                u32x4 w; w.x = cvt_pk_bf16(SGL(g0[0], u0[0]), SGL(g0[1], u0[1])); w.y = cvt_pk_bf16(SGL(g0[2], u0[2]), SGL(g0[3], u0[3]));
                w.z = cvt_pk_bf16(SGL(g1[0], u1[0]), SGL(g1[1], u1[1])); w.w = cvt_pk_bf16(SGL(g1[2], u1[2]), SGL(g1[3], u1[3]));
#undef SGL
                *(u32x4*)(H + (size_t)row * ldh + col0) = w; }
    }
};
__device__ __forceinline__ float sigm(float a) { return __builtin_amdgcn_rcpf(1.0f + __expf(-a)); }
struct EpiPle {
    static constexpr bool PERM = true;
    const bf16* PT; const bf16* base; bf16* xa; float* outf; const ssq_t* ss; ssq_t* ssn;
    __device__ __forceinline__ void operator()(const f32x4 (&acc)[2][2][4][2], const Unit& u, int wr, int wc, int fr, int fq, EpiCache& ec) const {
        const int row0 = u.pm * BM + wr * 64 + fr, col0 = u.pn * BM + wc * 32 + 8 * fq;
#pragma unroll
        for (int g = 0; g < 4; ++g) {
            const int ai = g >> 1, mb = (g & 1) * 2;
            u32x4 bv[2][2], pv[2][2]; float sc[2];
#pragma unroll
            for (int mm = 0; mm < 2; ++mm) { sc[mm] = rstd_of(ss, row0 + ai * HALF + (mb + mm) * 16, 1.0f / D);
#pragma unroll
                for (int bj = 0; bj < 2; ++bj) { const size_t o = (size_t)(row0 + ai * HALF + (mb + mm) * 16) * D + col0 + bj * HALF; bv[mm][bj] = *(const u32x4*)(base + o); pv[mm][bj] = *(const u32x4*)(PT + o); } }
#pragma unroll
            for (int mm = 0; mm < 2; ++mm) { const int m = mb + mm; const int row = row0 + ai * HALF + m * 16; const size_t off = (size_t)row * D + col0; const float s_ = sc[mm]; float q = 0.f;
#pragma unroll
                for (int bj = 0; bj < 2; ++bj) { const size_t o = off + bj * HALF; f32x4 b0, b1, p0, p1; unpack8f(bv[mm][bj], b0, b1); unpack8f(pv[mm][bj], p0, p1);
                    const f32x4 a0 = acc[ai][bj][m][0] * s_, a1 = acc[ai][bj][m][1] * s_; f32x4 x0, x1;
#pragma unroll
                    for (int i = 0; i < 4; ++i) { x0[i] = b0[i] + p0[i] * sigm(a0[i]); x1[i] = b1[i] + p1[i] * sigm(a1[i]); }
                    if (outf) { __builtin_nontemporal_store(x0, (f32x4*)(outf + o)); __builtin_nontemporal_store(x1, (f32x4*)(outf + o + 4)); }
                    else *(u32x4*)(xa + o) = (u32x4){cvt_pk_bf16(x0[0], x0[1]), cvt_pk_bf16(x0[2], x0[3]), cvt_pk_bf16(x1[0], x1[1]), cvt_pk_bf16(x1[2], x1[3])};
                    q += sumsq4(x0) + sumsq4(x1); }
                if (ssn) { q += __shfl_xor(q, 16); q += __shfl_xor(q, 32); if (fq == 0) ss_add(ssn, row, q); } }
        }
    }
};

template <class Epi, class Sched>
__device__ __forceinline__ void gemm_phase(LAS unsigned char* lds, const Gemm g, const Sched& S, const Epi& E) {
    const int tid = tid_now(), wid = __builtin_amdgcn_readfirstlane(tid >> 6), lane = tid & 63, wr = wid >> 2, wc = wid & 3, fr = lane & 15, fq = lane >> 4;
    const int K = g.K, nt = K / BK, lda = g.lda, ldb = g.ldb > 0 ? g.ldb : K;
    int RA[2], CA[2]; unsigned voffB[2];
#pragma unroll
    for (int i = 0; i < 2; ++i) { int R, C; stage_rc(tid * 16 + i * 8192, R, C); const int Rb = Epi::PERM ? ((R & ~31) + perm32(R & 31)) : R; RA[i] = R; CA[i] = C; voffB[i] = (unsigned)(Rb * ldb + C) * 2u; }
    const size_t kstep = (size_t)(BK * 2);
    const size_t hstep = (size_t)HALF * ldb * 2;
    const size_t tstep = 2 * hstep;
    const unsigned ldsw = (unsigned)wid * 1024u;
    const int aoff = lds_byte(wr * 64 + fr, fq * 8), boff = lds_byte(wc * 32 + fr, fq * 8);
#define PG8_SA(b, h) (((b) * 2 + (h)) * HTB)
#define PG8_SB(b, h) ((4 + (b) * 2 + (h)) * HTB)
#define PG8_STAGE(bufoff, gbase, voff) do { _Pragma("unroll") for (int _i = 0; _i < 2; ++_i) \
        __builtin_amdgcn_global_load_lds((const unsigned*)((const char*)(gbase) + (voff)[_i]), (LAS unsigned*)(lds + (bufoff) + ldsw + _i * 8192), 16, 0, 0); } while (0)
#define PG8_LDA(dst, b, h) do { _Pragma("unroll") for (int m = 0; m < 4; ++m) _Pragma("unroll") for (int k = 0; k < 2; ++k) dst[m][k] = *(const LAS bf16x8*)(lds + PG8_SA(b, h) + aoff + m * 2048 + k * 1024); } while (0)
#define PG8_LDB(dst, b, h) do { _Pragma("unroll") for (int n = 0; n < 2; ++n) _Pragma("unroll") for (int k = 0; k < 2; ++k) dst[n][k] = *(const LAS bf16x8*)(lds + PG8_SB(b, h) + boff + n * 2048 + k * 1024); } while (0)
#define PG8_MMA(ai, bj, At, Bt) do { __builtin_amdgcn_s_setprio(1); _Pragma("unroll") for (int m = 0; m < 4; ++m) _Pragma("unroll") for (int n = 0; n < 2; ++n) _Pragma("unroll") for (int k = 0; k < 2; ++k) \
        acc[ai][bj][m][n] = __builtin_amdgcn_mfma_f32_16x16x32_bf16(Bt[n][k], At[m][k], acc[ai][bj][m][n], 0, 0, 0); __builtin_amdgcn_s_setprio(0); } while (0)
#define PG8_WAIT_V(n) asm volatile("s_waitcnt vmcnt(" #n ")" ::: "memory")
#define PG8_WAIT_L(n) asm volatile("s_waitcnt lgkmcnt(" #n ")" ::: "memory")
#define PG8_BAR __builtin_amdgcn_s_barrier()
#define PG8_SCHED __builtin_amdgcn_sched_barrier(0)
    Unit cur, nxt; int ui = 0;
    if (!S.next(0, cur)) return;
    f32x4 acc[2][2][4][2];
#pragma unroll
    for (int a = 0; a < 2; ++a)
#pragma unroll
        for (int b = 0; b < 2; ++b)
#pragma unroll
            for (int m = 0; m < 4; ++m)
#pragma unroll
                for (int n = 0; n < 2; ++n) acc[a][b][m][n] = (f32x4){0.f, 0.f, 0.f, 0.f};
    bf16x8 At[4][2], B0[2][2], B1[2][2];
    unsigned vc[2][2], vn[2][2]; EpiCache ec; ec.pm = -1;
    S.a_offs(cur, RA, CA, lda, vc);
    const char* cA = S.a_base(g, cur); const char* cB = (const char*)g.Bt + (size_t)cur.pn * tstep + S.k_off(cur);
    PG8_STAGE(PG8_SB(0, 0), cB, voffB); PG8_STAGE(PG8_SB(0, 1), cB + hstep, voffB); PG8_STAGE(PG8_SA(0, 0), cA, vc[0]); PG8_STAGE(PG8_SA(0, 1), cA, vc[1]);
    if (wr == 1) PG8_BAR;
    PG8_WAIT_V(2); PG8_BAR;
    PG8_STAGE(PG8_SB(1, 0), cB + kstep, voffB); PG8_STAGE(PG8_SA(1, 0), cA + kstep, vc[0]); PG8_STAGE(PG8_SB(1, 1), cB + hstep + kstep, voffB);
    PG8_WAIT_V(6); PG8_BAR;
    for (;;) {
        const bool has_next = S.next(ui + 1, nxt);
        const char* nA = has_next ? S.a_base(g, nxt) : cA; const char* nB = has_next ? (const char*)g.Bt + (size_t)nxt.pn * tstep + S.k_off(nxt) : cB;
        int tkr[2][2]; const bool newpanel = has_next && nxt.pm != cur.pm;
        if (Sched::GATHER && newpanel) S.a_raw(nxt, RA, tkr);
#pragma nounroll
        for (int t = 0; t < nt; t += 2) {
            const bool last = (t == nt - 2);
            const char* a1 = cA + (size_t)(t + 1) * kstep;
            const char* a2 = last ? nA : cA + (size_t)(t + 2) * kstep; const char* b2 = last ? nB : cB + (size_t)(t + 2) * kstep;
            const char* a3 = a2 + kstep; const char* b3 = b2 + kstep;
            unsigned v2[2][2];
#pragma unroll
            for (int h = 0; h < 2; ++h)
#pragma unroll
                for (int i = 0; i < 2; ++i) v2[h][i] = vc[h][i];
            if (Sched::GATHER && last) {
                if (newpanel) S.a_fin(nxt, RA, CA, lda, tkr, vn);
#pragma unroll
                for (int h = 0; h < 2; ++h)
#pragma unroll
                    for (int i = 0; i < 2; ++i) { if (!newpanel) vn[h][i] = vc[h][i]; v2[h][i] = vn[h][i]; } }
            PG8_LDB(B0, 0, 0); PG8_LDB(B1, 0, 1); PG8_SCHED; PG8_LDA(At, 0, 0); PG8_STAGE(PG8_SA(1, 1), a1, vc[1]);
            PG8_WAIT_V(8); PG8_WAIT_L(0); PG8_BAR; PG8_MMA(0, 0, At, B0); PG8_MMA(0, 1, At, B1); PG8_BAR; PG8_SCHED;
            PG8_LDA(At, 0, 1); PG8_STAGE(PG8_SB(0, 0), b2, voffB); PG8_STAGE(PG8_SB(0, 1), b2 + hstep, voffB); PG8_STAGE(PG8_SA(0, 0), a2, v2[0]);
            PG8_WAIT_V(8); PG8_WAIT_L(0); PG8_BAR; PG8_MMA(1, 0, At, B0); PG8_MMA(1, 1, At, B1); PG8_BAR; PG8_SCHED;
            PG8_LDB(B0, 1, 0); PG8_LDB(B1, 1, 1); PG8_SCHED; PG8_LDA(At, 1, 0); PG8_STAGE(PG8_SA(0, 1), a2, v2[1]);
            PG8_WAIT_V(8); PG8_WAIT_L(0); PG8_BAR; PG8_MMA(0, 0, At, B0); PG8_MMA(0, 1, At, B1); PG8_BAR; PG8_SCHED;
            PG8_LDA(At, 1, 1); PG8_STAGE(PG8_SB(1, 0), b3, voffB); PG8_STAGE(PG8_SB(1, 1), b3 + hstep, voffB); PG8_STAGE(PG8_SA(1, 0), a3, v2[0]);
            PG8_WAIT_V(8); PG8_WAIT_L(0); PG8_BAR; PG8_MMA(1, 0, At, B0); PG8_MMA(1, 1, At, B1); PG8_BAR; PG8_SCHED;
        }
        if (wr == 0) PG8_BAR;
        E(acc, cur, wr, wc, fr, fq, ec);
        if (!has_next) break;
#pragma unroll
        for (int a = 0; a < 2; ++a)
#pragma unroll
            for (int b = 0; b < 2; ++b)
#pragma unroll
                for (int m = 0; m < 4; ++m)
#pragma unroll
                    for (int n = 0; n < 2; ++n) acc[a][b][m][n] = (f32x4){0.f, 0.f, 0.f, 0.f};
        cur = nxt; cA = nA; cB = nB; ++ui;
#pragma unroll
        for (int h = 0; h < 2; ++h)
#pragma unroll
            for (int i = 0; i < 2; ++i) vc[h][i] = Sched::GATHER ? vn[h][i] : vc[h][i];
        if (wr == 1) PG8_BAR;
    }
    PG8_WAIT_V(0);
    PG8_BAR;
#undef PG8_SA
#undef PG8_SB
#undef PG8_STAGE
#undef PG8_LDA
#undef PG8_LDB
#undef PG8_MMA
#undef PG8_WAIT_V
#undef PG8_WAIT_L
#undef PG8_BAR
#undef PG8_SCHED
}
}


namespace fa {
typedef short s16x4 __attribute__((ext_vector_type(4)));
#define FA_SBAR() __builtin_amdgcn_sched_barrier(0)
constexpr float THR2 = 11.5f;
template <int DK> __device__ __forceinline__ int kswz(int row, int colB) { return DK == 64 ? row * 128 + (colB ^ (((row >> 1) & 7) << 4)) : row * 256 + (colB ^ ((row & 7) << 4)); }
template <int NCB> __device__ __forceinline__ int v_st(int k, int c) { const int kk = (k & ~0xC) | ((k & 4) << 1) | ((k & 8) >> 1); return ((kk >> 3) * NCB + (c >> 5)) * 512 + ((kk & 7) * 32 + (c & 31)) * 2; }
__device__ __forceinline__ int v_rd_base(int lane) { return ((lane & 3) << 3) | (((lane >> 2) & 3) << 6) | (((lane >> 4) & 1) << 5) | (((lane >> 5) & 1) << 8); }
template <int OFF> __device__ __forceinline__ s16x4 tr_read(int vb) { s16x4 r; asm volatile("ds_read_b64_tr_b16 %0, %1 offset:%2" : "=&v"(r) : "v"(vb), "i"(OFF) : "memory"); return r; }
__device__ __forceinline__ unsigned cvtpk(float lo, float hi) { unsigned r; asm volatile("v_cvt_pk_bf16_f32 %0, %1, %2" : "=v"(r) : "v"(lo), "v"(hi)); return r; }

constexpr float C0 = 8.0f;
__device__ __forceinline__ void partialSM(f32x16& p0) {
#pragma unroll
  for (int r = 0; r < 16; ++r) p0[r] = __builtin_amdgcn_exp2f(p0[r]);
}
__device__ __forceinline__ void finishSM(f32x16& p0, f32x16& p1, float& l_reg, bf16x8& pa0, bf16x8& pa1, bf16x8& pa2, bf16x8& pa3) {
#pragma unroll
  for (int r = 0; r < 16; ++r) p1[r] = __builtin_amdgcn_exp2f(p1[r]);
  float ps = 0;
#pragma unroll
  for (int r = 0; r < 16; ++r) ps += p0[r];
#pragma unroll
  for (int r = 0; r < 16; ++r) ps += p1[r];
  { auto rr = __builtin_amdgcn_permlane32_swap(__float_as_uint(ps), __float_as_uint(ps), false, false); ps = __uint_as_float(rr[0]) + __uint_as_float(rr[1]); }
  l_reg += ps;
#define FA_PK4(P, BASE, OUT) do { unsigned a0 = cvtpk(P[BASE + 0], P[BASE + 1]), a1 = cvtpk(P[BASE + 2], P[BASE + 3]);   \
    unsigned b0 = cvtpk(P[BASE + 4], P[BASE + 5]), b1 = cvtpk(P[BASE + 6], P[BASE + 7]);                              \
    auto r0 = __builtin_amdgcn_permlane32_swap(a0, b0, false, false); auto r1 = __builtin_amdgcn_permlane32_swap(a1, b1, false, false); \
    u32x4 w = {r0[0], r1[0], r0[1], r1[1]}; OUT = __builtin_bit_cast(bf16x8, w); } while (0)
  FA_PK4(p0, 0, pa0); FA_PK4(p0, 8, pa1); FA_PK4(p1, 0, pa2); FA_PK4(p1, 8, pa3);
#undef FA_PK4
}
__device__ __forceinline__ void swa_mask(f32x16& p0, f32x16& p1, int kt, int tq, int hi, float slope2) {
  const int kb = kt + 4 * hi - tq;
#pragma unroll
  for (int r = 0; r < 16; ++r) { int d = kb + (r & 3) + 8 * (r >> 2); int d2 = d + 32; d = d < 0 ? -d : d; d2 = d2 < 0 ? -d2 : d2;
    p0[r] = d <= 128 ? p0[r] - slope2 * (float)d : -INFINITY; p1[r] = d2 <= 128 ? p1[r] - slope2 * (float)d2 : -INFINITY; }
}
__device__ __forceinline__ void swa_maskf(f32x16& p0, f32x16& p1, int kt, int tq, int hi, float slope2) {
  const float kb = (float)(kt + 4 * hi - tq), ns = -slope2;
#pragma unroll
  for (int r = 0; r < 16; ++r) { const float x = kb + (float)((r & 3) + 8 * (r >> 2)), x2 = kb + (float)((r & 3) + 8 * (r >> 2) + 32);
    const float t0 = __builtin_fmaf(ns, __builtin_fabsf(x), p0[r]), t1 = __builtin_fmaf(ns, __builtin_fabsf(x2), p1[r]);
    p0[r] = __builtin_fabsf(x) <= 128.0f ? t0 : -INFINITY; p1[r] = __builtin_fabsf(x2) <= 128.0f ? t1 : -INFINITY; }
}
__device__ __forceinline__ void swa_bias(f32x16& p0, f32x16& p1, int kt, int tq, int hi, float slope2) {
  const float kb = (float)(kt + 4 * hi - tq), ns = -slope2;
#pragma unroll
  for (int r = 0; r < 16; ++r) { const float x = kb + (float)((r & 3) + 8 * (r >> 2)), x2 = kb + (float)((r & 3) + 8 * (r >> 2) + 32);
    p0[r] = __builtin_fmaf(ns, __builtin_fabsf(x), p0[r]); p1[r] = __builtin_fmaf(ns, __builtin_fabsf(x2), p1[r]); }
}
template <int DK> __device__ __forceinline__ void qkt(f32x16& p0, f32x16& p1, const LAS unsigned char* Ks, const bf16x8* qr, int r32, int hi) {
#pragma unroll
  for (int r = 0; r < 16; ++r) { p0[r] = -C0; p1[r] = -C0; }
#pragma unroll
  for (int d0 = 0; d0 < DK / 16; ++d0) { const int cb = (d0 * 16 + hi * 8) * 2;
    const bf16x8 b0 = *(const LAS bf16x8*)(Ks + kswz<DK>(r32, cb));
    const bf16x8 b1 = *(const LAS bf16x8*)(Ks + kswz<DK>(32 + r32, cb));
    p0 = __builtin_amdgcn_mfma_f32_32x32x16_bf16(b0, qr[d0], p0, 0, 0, 0);
    p1 = __builtin_amdgcn_mfma_f32_32x32x16_bf16(b1, qr[d0], p1, 0, 0, 0); }
}
template <int DK> __device__ __forceinline__ void qkt4(f32x16& p0, f32x16& p1, const LAS unsigned char* const (&ka)[4], int boff, const bf16x8* qr) {
  constexpr int RSK_ = (DK == 64) ? 128 : 256;
#pragma unroll
  for (int r = 0; r < 16; ++r) { p0[r] = -C0; p1[r] = -C0; }
#pragma unroll
  for (int d0 = 0; d0 < DK / 16; ++d0) { const LAS unsigned char* a_ = ka[d0 & 3] + boff + (d0 >> 2) * 128;
    const bf16x8 b0 = *(const LAS bf16x8*)(a_);
    const bf16x8 b1 = *(const LAS bf16x8*)(a_ + 32 * RSK_);
    p0 = __builtin_amdgcn_mfma_f32_32x32x16_bf16(b0, qr[d0], p0, 0, 0, 0);
    p1 = __builtin_amdgcn_mfma_f32_32x32x16_bf16(b1, qr[d0], p1, 0, 0, 0); }
}
template <int NCB, int D0> __device__ __forceinline__ void pv_one(f32x16& od, int vb, bf16x8 pa0, bf16x8 pa1, bf16x8 pa2, bf16x8 pa3) {
  constexpr int KS = 2 * NCB * 512, HF = NCB * 512;
  const s16x4 l0 = tr_read<D0 * 512 + 0 * KS>(vb), h0 = tr_read<D0 * 512 + 0 * KS + HF>(vb), l1 = tr_read<D0 * 512 + 1 * KS>(vb), h1 = tr_read<D0 * 512 + 1 * KS + HF>(vb);
  const s16x4 l2 = tr_read<D0 * 512 + 2 * KS>(vb), h2 = tr_read<D0 * 512 + 2 * KS + HF>(vb), l3 = tr_read<D0 * 512 + 3 * KS>(vb), h3 = tr_read<D0 * 512 + 3 * KS + HF>(vb);
  asm volatile("s_waitcnt lgkmcnt(0)" ::: "memory"); FA_SBAR();
#define FA_PK(L, H) (bf16x8){L[0], L[1], L[2], L[3], H[0], H[1], H[2], H[3]}
  od = __builtin_amdgcn_mfma_f32_32x32x16_bf16(pa0, FA_PK(l0, h0), od, 0, 0, 0);
  od = __builtin_amdgcn_mfma_f32_32x32x16_bf16(pa1, FA_PK(l1, h1), od, 0, 0, 0);
  od = __builtin_amdgcn_mfma_f32_32x32x16_bf16(pa2, FA_PK(l2, h2), od, 0, 0, 0);
  od = __builtin_amdgcn_mfma_f32_32x32x16_bf16(pa3, FA_PK(l3, h3), od, 0, 0, 0);
#undef FA_PK
}
template <int NCB> __device__ __forceinline__ void pv_d0(f32x16* o, int vb, bf16x8 pa0, bf16x8 pa1, bf16x8 pa2, bf16x8 pa3) {
  pv_one<NCB, 0>(o[0], vb, pa0, pa1, pa2, pa3); pv_one<NCB, 1>(o[1], vb, pa0, pa1, pa2, pa3);
  if constexpr (NCB == 4) { pv_one<NCB, 2>(o[2], vb, pa0, pa1, pa2, pa3); pv_one<NCB, 3>(o[3], vb, pa0, pa1, pa2, pa3); }
}

template <int DK, int DV, int MODE, int QMODE, int LDQ, int LDK, int LDV, int LDO, int SD>
__device__ __forceinline__ void attn_unit(const bf16* __restrict__ Qb, const bf16* __restrict__ Kh, const bf16* __restrict__ Vh, bf16* __restrict__ Ob, int NT, int tq0, int klo, float slope2, float sink2, const float* __restrict__ qgain, int krope_off, LAS unsigned char* lds) {
  constexpr int NCB = DV / 32, NQ = DK / 16, RSK = (DK == 64) ? 128 : 256, SHM_K = 64 * RSK, SHM_V = 64 * DV * 2, KVBLK = 64;
  constexpr int KPR = DK / 8, VPR = DV / 8, NKP = (64 * KPR + 511) / 512, NVP = (64 * VPR) / 512, NLD = NKP + NVP;
  constexpr bool DMA = (DK == 96 && MODE == 0), DMAX = (DK == 128 && MODE == 0);
  constexpr int NBUF = (DMA || DMAX) ? 4 : 2;
  const int tid = tid_now(), wid = tid >> 6, lane = tid & 63, r32 = lane & 31, hi = lane >> 5;
  LAS unsigned char* const V_lds = lds; LAS unsigned char* const K_lds = lds + NBUF * SHM_V;
  LAS float* wsf = (LAS float*)(lds + (NBUF * (SHM_V + SHM_K) >= RING_BYTES ? RING_BYTES + 4096 : NBUF * (SHM_V + SHM_K))) + wid * 64; LAS float* li_l = wsf; LAS float* al_l = wsf + 32;
  bf16x8 qr[NQ];
  const bf16* Qw = Qb + (size_t)(wid * 32 + r32) * LDQ + hi * 8;
#pragma unroll
  for (int d0 = 0; d0 < NQ; ++d0) qr[d0] = *(const bf16x8*)(Qw + d0 * 16);
  const int tq = tq0 + wid * 32 + r32;
  {
    float qf[NQ][8]; float ssq = 0.f;
#pragma unroll
    for (int d0 = 0; d0 < NQ; ++d0)
#pragma unroll
      for (int j = 0; j < 8; ++j) { qf[d0][j] = bf2f((unsigned short)qr[d0][j]); ssq += qf[d0][j] * qf[d0][j]; }
    { auto rr = __builtin_amdgcn_permlane32_swap(__float_as_uint(ssq), __float_as_uint(ssq), false, false); ssq = __uint_as_float(rr[0]) + __uint_as_float(rr[1]); }
    const float sc = __builtin_amdgcn_rsqf(ssq * (1.0f / DK) + EPS) * (DK == 96 ? 0.10206207261596575f : (DK == 64 ? 0.125f : 0.08838834764831845f)) * LOG2E;
#pragma unroll
    for (int d0 = 0; d0 < NQ; ++d0) { const f32x4 g0 = *(const f32x4*)(qgain + d0 * 16 + hi * 8), g1 = *(const f32x4*)(qgain + d0 * 16 + hi * 8 + 4);
#pragma unroll
      for (int j = 0; j < 4; ++j) { qf[d0][j] *= sc * g0[j]; qf[d0][4 + j] *= sc * g1[j]; } }
    if constexpr (QMODE == 0) {
#pragma unroll
      for (int j = 0; j < 8; ++j) { float sn, cs; fast_sincos((float)tq * __builtin_amdgcn_exp2f(-(float)(2 * (hi * 8 + j)) * (13.287712379549449f / 32.0f)), sn, cs);
        const float x1 = qf[4][j], x2 = qf[5][j]; qf[4][j] = x1 * cs - x2 * sn; qf[5][j] = x1 * sn + x2 * cs; }
    } else if constexpr (QMODE == 2) {
      const int prow = tq >> 6, pcol = tq & 63;
#pragma unroll
      for (int d = 0; d < 2; ++d)
#pragma unroll
        for (int j = 0; j < 8; ++j) { const float inv = __builtin_amdgcn_exp2f(-(float)(2 * (d * 16 + hi * 8 + j)) * (13.287712379549449f / 64.0f)); float sn, cs;
          fast_sincos((float)prow * inv, sn, cs); float x1 = qf[d][j], x2 = qf[d + 2][j]; qf[d][j] = x1 * cs - x2 * sn; qf[d + 2][j] = x1 * sn + x2 * cs;
          fast_sincos((float)pcol * inv, sn, cs); x1 = qf[4 + d][j]; x2 = qf[6 + d][j]; qf[4 + d][j] = x1 * cs - x2 * sn; qf[6 + d][j] = x1 * sn + x2 * cs; }
    }
#pragma unroll
    for (int d0 = 0; d0 < NQ; ++d0) { const u32x4 w = {cvtpk(qf[d0][0], qf[d0][1]), cvtpk(qf[d0][2], qf[d0][3]), cvtpk(qf[d0][4], qf[d0][5]), cvtpk(qf[d0][6], qf[d0][7])}; qr[d0] = __builtin_bit_cast(bf16x8, w); }
  }
  asm volatile("" ::: "memory");
  float l_reg = MODE ? __builtin_amdgcn_exp2f(sink2 - C0) : 0.f; f32x16 o[NCB];
#pragma unroll
  for (int d = 0; d < NCB; ++d)
#pragma unroll
    for (int r = 0; r < 16; ++r) o[d][r] = 0.f;
  if constexpr (DMA) {
    const int widu = __builtin_amdgcn_readfirstlane(wid);
    int kgo[2], vgo;
#pragma unroll
    for (int i = 0; i < 2; ++i) { const int row = 4 * (wid * 2 + i) + (lane >> 4), cp_ = lane & 15; int c8 = (cp_ & 8) | ((cp_ & 7) ^ (row & 7)); if (c8 >= 12) c8 -= 4;
      kgo[i] = row * LDK + (c8 < 8 ? c8 * 8 : krope_off + (c8 - 8) * 8); }
    { const int kk = wid * 8 + ((lane & 31) >> 2), c = (lane >> 5) * 32 + (lane & 3) * 8, k_ = (kk & ~0xC) | ((kk & 4) << 1) | ((kk & 8) >> 1); vgo = k_ * LDV + c; }
    const int vb0 = (int)(unsigned)(uintptr_t)V_lds + v_rd_base(lane);
#define FA_DMA(t, b) do { const int t_ = (t) < NT ? (t) : NT - 1; const bf16* kp_ = Kh + (size_t)t_ * KVBLK * LDK; const bf16* vp_ = Vh + (size_t)t_ * KVBLK * LDV; \
      __builtin_amdgcn_global_load_lds((const unsigned*)(kp_ + kgo[0]), (LAS unsigned*)(K_lds + (b) * SHM_K + (widu * 2 + 0) * 1024), 16, 0, 0); \
      __builtin_amdgcn_global_load_lds((const unsigned*)(kp_ + kgo[1]), (LAS unsigned*)(K_lds + (b) * SHM_K + (widu * 2 + 1) * 1024), 16, 0, 0); \
      __builtin_amdgcn_global_load_lds((const unsigned*)(vp_ + vgo), (LAS unsigned*)(V_lds + (b) * SHM_V + widu * 1024), 16, 0, 0); } while (0)
#define FA_LAND(n) do { asm volatile("s_waitcnt vmcnt(" #n ")" ::: "memory"); __builtin_amdgcn_s_barrier(); asm volatile("" ::: "memory"); } while (0)
    f32x16 pA0, pA1, pB0, pB1; bf16x8 pa0, pa1, pa2, pa3;
    asm volatile("s_waitcnt vmcnt(0)" ::: "memory");
    __syncthreads();
    if (__builtin_amdgcn_readfirstlane(tid) >= 256) __builtin_amdgcn_s_setprio(1);
    FA_DMA(0, 0); FA_DMA(1, 1); FA_DMA(2, 2);
    FA_LAND(6);
    qkt<DK>(pA0, pA1, K_lds, qr, r32, hi); partialSM(pA0);
    FA_LAND(3);
    for (int j = 1; j + 1 < NT; j += 2) {
      FA_DMA(j + 2, (j + 2) & 3);
      FA_SBAR(); qkt<DK>(pB0, pB1, K_lds + (j & 3) * SHM_K, qr, r32, hi);
      finishSM(pA0, pA1, l_reg, pa0, pa1, pa2, pa3); FA_SBAR();
      pv_d0<NCB>(o, vb0 + ((j - 1) & 3) * SHM_V, pa0, pa1, pa2, pa3); partialSM(pB0);
      FA_LAND(3);
      FA_DMA(j + 3, (j + 3) & 3);
      FA_SBAR(); qkt<DK>(pA0, pA1, K_lds + ((j + 1) & 3) * SHM_K, qr, r32, hi);
      finishSM(pB0, pB1, l_reg, pa0, pa1, pa2, pa3); FA_SBAR();
      pv_d0<NCB>(o, vb0 + (j & 3) * SHM_V, pa0, pa1, pa2, pa3); partialSM(pA0);
      FA_LAND(3);
    }
    FA_SBAR(); qkt<DK>(pB0, pB1, K_lds + ((NT - 1) & 3) * SHM_K, qr, r32, hi);
    finishSM(pA0, pA1, l_reg, pa0, pa1, pa2, pa3); FA_SBAR();
    pv_d0<NCB>(o, vb0 + ((NT - 2) & 3) * SHM_V, pa0, pa1, pa2, pa3); partialSM(pB0);
    finishSM(pB0, pB1, l_reg, pa0, pa1, pa2, pa3); FA_SBAR();
    pv_d0<NCB>(o, vb0 + ((NT - 1) & 3) * SHM_V, pa0, pa1, pa2, pa3);
    asm volatile("s_waitcnt vmcnt(0)" ::: "memory");
#undef FA_DMA
#undef FA_LAND
  } else if constexpr (DMAX) {
    const int widu = __builtin_amdgcn_readfirstlane(wid);
    constexpr int NVB = SHM_V / 8192;
    const LAS unsigned char* ka[4];
#pragma unroll
    for (int m = 0; m < 4; ++m) ka[m] = K_lds + r32 * RSK + (((m * 32) | (hi * 16)) ^ ((r32 & 7) << 4));
    const int vb0 = (int)(unsigned)(uintptr_t)V_lds + v_rd_base(lane);
#define FA_DMA(t, b) do { const int t_ = (t) < NT ? (t) : NT - 1; const bf16* kp_ = Kh + (size_t)t_ * KVBLK * LDK; const bf16* vp_ = Vh + (size_t)t_ * KVBLK * LDV; \
      int ln_ = lane; asm volatile("" : "+v"(ln_)); \
      _Pragma("unroll") for (int i_ = 0; i_ < 2; ++i_) { const int row_ = 4 * (widu * 2 + i_) + (ln_ >> 4), cp_ = ln_ & 15; const int c8_ = (cp_ & 8) | ((cp_ & 7) ^ (row_ & 7)); \
        __builtin_amdgcn_global_load_lds((const unsigned*)(kp_ + (row_ * LDK + c8_ * 8)), (LAS unsigned*)(K_lds + (b) * SHM_K + (widu * 2 + i_) * 1024), 16, 0, 0); } \
      _Pragma("unroll") for (int i_ = 0; i_ < NVB; ++i_) { const int st_ = 2 * (widu * NVB + i_) + (ln_ >> 5), kk_ = (st_ / NCB) * 8 + ((ln_ & 31) >> 2), c_ = (st_ % NCB) * 32 + (ln_ & 3) * 8, k_ = (kk_ & ~0xC) | ((kk_ & 4) << 1) | ((kk_ & 8) >> 1); \
        __builtin_amdgcn_global_load_lds((const unsigned*)(vp_ + (k_ * LDV + c_)), (LAS unsigned*)(V_lds + (b) * SHM_V + (widu * NVB + i_) * 1024), 16, 0, 0); } } while (0)
#define FA_LAND(n) do { asm volatile("s_waitcnt vmcnt(%0)" :: "n"((n) * (2 + NVB)) : "memory"); __builtin_amdgcn_s_barrier(); asm volatile("" ::: "memory"); } while (0)
    f32x16 pA0, pA1, pB0, pB1; bf16x8 pa0, pa1, pa2, pa3;
    asm volatile("s_waitcnt vmcnt(0)" ::: "memory");
    __syncthreads();
    if (__builtin_amdgcn_readfirstlane(tid) >= 256) __builtin_amdgcn_s_setprio(1);
    FA_DMA(0, 0); FA_DMA(1, 1);
    FA_LAND(1);
    qkt4<DK>(pA0, pA1, ka, 0, qr); FA_DMA(2, 2); partialSM(pA0);
    FA_LAND(1);
#define FA_HALF(PN0, PN1, PP0, PP1, jt, bn, bp) do { \
      FA_SBAR(); qkt4<DK>(PN0, PN1, ka, (bn) * SHM_K, qr); \
      finishSM(PP0, PP1, l_reg, pa0, pa1, pa2, pa3); FA_SBAR(); \
      FA_DMA((jt) + 2, ((bn) + 2) & 3); FA_SBAR(); \
      pv_d0<NCB>(o, vb0 + (bp) * SHM_V, pa0, pa1, pa2, pa3); partialSM(PN0); \
      FA_LAND(1); } while (0)
    for (int j = 1; j + 4 < NT; j += 4) {
      FA_HALF(pB0, pB1, pA0, pA1, j, 1, 0); FA_HALF(pA0, pA1, pB0, pB1, j + 1, 2, 1); FA_HALF(pB0, pB1, pA0, pA1, j + 2, 3, 2); FA_HALF(pA0, pA1, pB0, pB1, j + 3, 0, 3);
    }
    FA_HALF(pB0, pB1, pA0, pA1, NT - 3, 1, 0); FA_HALF(pA0, pA1, pB0, pB1, NT - 2, 2, 1);
    FA_SBAR(); qkt4<DK>(pB0, pB1, ka, 3 * SHM_K, qr);
    finishSM(pA0, pA1, l_reg, pa0, pa1, pa2, pa3); FA_SBAR();
    pv_d0<NCB>(o, vb0 + 2 * SHM_V, pa0, pa1, pa2, pa3); partialSM(pB0);
    finishSM(pB0, pB1, l_reg, pa0, pa1, pa2, pa3); FA_SBAR();
    pv_d0<NCB>(o, vb0 + 3 * SHM_V, pa0, pa1, pa2, pa3);
    asm volatile("s_waitcnt vmcnt(0)" ::: "memory");
#undef FA_HALF
#undef FA_DMA
#undef FA_LAND
  } else {
  int kg[NKP], kl[NKP]; bool kok[NKP]; int vg[NVP], vl[NVP];
#pragma unroll
  for (int i = 0; i < NKP; ++i) { int p = tid + 512 * i; kok[i] = p < 64 * KPR; if (!kok[i]) p = tid; const int row = p / KPR, c8 = p % KPR; kg[i] = row * LDK + ((DK == 96 && c8 >= 8) ? krope_off + (c8 - 8) * 8 : c8 * 8); kl[i] = kswz<DK>(row, c8 * 16); }
#pragma unroll
  for (int i = 0; i < NVP; ++i) { const int p = tid + 512 * i; const int row = p / VPR, c8 = p % VPR; vg[i] = row * LDV + c8 * 8; vl[i] = v_st<NCB>(row, c8 * 8); }
  const int vb0 = (int)(unsigned)(uintptr_t)V_lds + v_rd_base(lane);
  bf16x8 skS[SD][NKP], svS[SD][NVP]; constexpr int SE = 0, SO = SD - 1;
#define FA_SLOAD(SK, SV, k0) do { _Pragma("unroll") for (int _j = 0; _j < NVP; ++_j) SV[_j] = *(const bf16x8*)(Vh + (size_t)(k0) * LDV + vg[_j]); \
    _Pragma("unroll") for (int _j = 0; _j < NKP; ++_j) SK[_j] = *(const bf16x8*)(Kh + (size_t)(k0) * LDK + kg[_j]); } while (0)
#define FA_SWRITE(b, SK, SV) do { _Pragma("unroll") for (int _j = 0; _j < NVP; ++_j) *(LAS bf16x8*)(V_lds + (b) * SHM_V + vl[_j]) = SV[_j]; \
    _Pragma("unroll") for (int _j = 0; _j < NKP; ++_j) if (kok[_j]) *(LAS bf16x8*)(K_lds + (b) * SHM_K + kl[_j]) = SK[_j]; } while (0)
#define FA_SWAIT() asm volatile("s_waitcnt vmcnt(%0)" :: "n"(SD == 2 ? NLD : 0) : "memory")
  f32x16 pA0, pA1, pB0, pB1; bf16x8 pa0, pa1, pa2, pa3;
  const int tqw = MODE ? __builtin_amdgcn_readfirstlane(tq0 + wid * 32) : 0;
#define FA_CLS(i) (!MODE ? 2 : ((klo + (i) * KVBLK + 63 < tqw - 128 || klo + (i) * KVBLK > tqw + 159) ? 0 : ((klo + (i) * KVBLK >= tqw - 97 && klo + (i) * KVBLK + 63 <= tqw + 128) ? 2 : 1)))
#define FA_QK(P0, P1, b, c) do { if (c) qkt<DK>(P0, P1, K_lds + (b) * SHM_K, qr, r32, hi); } while (0)
#define FA_MSK(P0, P1, i, c) do { if (c) { if (MODE) { if ((c) == 1) swa_maskf(P0, P1, klo + (i) * KVBLK, tq, hi, slope2); else swa_bias(P0, P1, klo + (i) * KVBLK, tq, hi, slope2); } partialSM(P0); } } while (0)
#define FA_FIN(P0, P1, c) do { if (c) finishSM(P0, P1, l_reg, pa0, pa1, pa2, pa3); } while (0)
#define FA_PV(vb, c) do { if (c) pv_d0<NCB>(o, vb, pa0, pa1, pa2, pa3); } while (0)
  __syncthreads();
  if (__builtin_amdgcn_readfirstlane(tid) >= 256) __builtin_amdgcn_s_setprio(1);
  int cA = FA_CLS(0), cB;
  FA_SLOAD(skS[SE], svS[SE], 0); asm volatile("s_waitcnt vmcnt(0)" ::: "memory"); FA_SWRITE(0, skS[SE], svS[SE]); __syncthreads();
  FA_QK(pA0, pA1, 0, cA); FA_MSK(pA0, pA1, 0, cA);
  FA_SLOAD(skS[SO], svS[SO], KVBLK); if (SD == 2) FA_SLOAD(skS[SE], svS[SE], 2 * KVBLK);
  FA_SWAIT(); FA_SWRITE(1, skS[SO], svS[SO]); __syncthreads();
  for (int j = 1; j + 1 < NT; j += 2) {
    cB = FA_CLS(j);
    FA_SBAR(); FA_QK(pB0, pB1, 1, cB);
    FA_FIN(pA0, pA1, cA); FA_SBAR();
    FA_SLOAD(skS[SO], svS[SO], (j + SD) * KVBLK); FA_SBAR();
    FA_PV(vb0, cA); FA_MSK(pB0, pB1, j, cB);
    __syncthreads(); FA_SWAIT(); FA_SWRITE(0, skS[SE], svS[SE]);
    __syncthreads();
    cA = FA_CLS(j + 1);
    FA_SBAR(); FA_QK(pA0, pA1, 0, cA);
    FA_FIN(pB0, pB1, cB); FA_SBAR();
    { const int tn_ = j + 1 + SD < NT ? j + 1 + SD : NT - 1; FA_SLOAD(skS[SE], svS[SE], tn_ * KVBLK); } FA_SBAR();
    FA_PV(vb0 + SHM_V, cB); FA_MSK(pA0, pA1, j + 1, cA);
    __syncthreads(); FA_SWAIT(); FA_SWRITE(1, skS[SO], svS[SO]);
    __syncthreads();
  }
  cB = FA_CLS(NT - 1);
  FA_SBAR(); FA_QK(pB0, pB1, 1, cB);
  FA_FIN(pA0, pA1, cA); FA_SBAR();
  FA_PV(vb0, cA); FA_MSK(pB0, pB1, NT - 1, cB);
  __syncthreads();
  FA_FIN(pB0, pB1, cB); FA_SBAR();
  FA_PV(vb0 + SHM_V, cB);
#undef FA_CLS
#undef FA_QK
#undef FA_MSK
#undef FA_FIN
#undef FA_PV
  }
  __builtin_amdgcn_s_setprio(0);
  if (hi == 0) li_l[r32] = l_reg; asm volatile("s_waitcnt lgkmcnt(0)" ::: "memory");
  float rli[16];
#pragma unroll
  for (int r = 0; r < 16; ++r) rli[r] = __builtin_amdgcn_rcpf(li_l[crow(r, hi)]);
  bf16* Ow = Ob + (size_t)(wid * 32) * LDO; const bool odd = lane & 1;
#pragma unroll
  for (int d0 = 0; d0 < NCB; ++d0)
#pragma unroll
    for (int r = 0; r < 16; r += 2) {
      const float a = o[d0][r] * rli[r], b = o[d0][r + 1] * rli[r + 1];
      const float x = odd ? a : b;
      const float y = __uint_as_float((unsigned)__builtin_amdgcn_update_dpp(0, (int)__float_as_uint(x), 0xB1, 0xF, 0xF, false));
      const unsigned w = odd ? cvtpk(y, b) : cvtpk(a, y);
      const int orow = crow(odd ? r + 1 : r, hi);
      *(unsigned*)(Ow + (size_t)orow * LDO + d0 * 32 + (r32 & ~1)) = w; }
#undef FA_SLOAD
#undef FA_SWRITE
#undef FA_SWAIT
}
}

__device__ __forceinline__ void xb_rows(const Frame& F, const float* x, bf16* xb, ssq_t* ss) {
    for (int m0 = F.gw * 4; m0 < T; m0 += F.ngw * 4) {
        f32x4 v[4][4];
#pragma unroll
        for (int r = 0; r < 4; ++r)
#pragma unroll
            for (int j = 0; j < 4; ++j) v[r][j] = __builtin_nontemporal_load((const f32x4*)(x + (size_t)(m0 + r) * D) + F.lane + 64 * j);
#pragma unroll
        for (int r = 0; r < 4; ++r) { u32x2* o8 = (u32x2*)(xb + (size_t)(m0 + r) * D) + F.lane; float s = 0.f;
#pragma unroll
            for (int j = 0; j < 4; ++j) { const f32x4 w = v[r][j]; s += (w.x * w.x + w.y * w.y) + (w.z * w.z + w.w * w.w); o8[64 * j] = (u32x2){hpk2(w.x, w.y), hpk2(w.z, w.w)}; }
            s = wave_sum(s); if (F.lane == 0) ss_set(ss, m0 + r, s); }
    }
}
__device__ __forceinline__ void cvt_flat(const Frame& F, const float* src, bf16* dst, size_t n8) {
    const size_t stride = (size_t)F.ngw * 64;
    for (size_t i = (size_t)F.gw * 64 + F.lane; i < n8; i += 4 * stride) {
        f32x4 a[4], b[4];
#pragma unroll
        for (int u = 0; u < 4; ++u) if (i + u * stride < n8) { a[u] = __builtin_nontemporal_load((const f32x4*)src + 2 * (i + u * stride)); b[u] = __builtin_nontemporal_load((const f32x4*)src + 2 * (i + u * stride) + 1); }
#pragma unroll
        for (int u = 0; u < 4; ++u) if (i + u * stride < n8) ((u32x4*)dst)[i + u * stride] = (u32x4){hpk2(a[u].x, a[u].y), hpk2(a[u].z, a[u].w), hpk2(b[u].x, b[u].y), hpk2(b[u].z, b[u].w)};
    }
}
__device__ __forceinline__ float quad_sum(float v, int lpv) { for (int o = 1; o < lpv; o <<= 1) v += __shfl_xor(v, o); return v; }
__device__ __forceinline__ void unpack8(const u32x4 a, float* v) { v[0] = bflo(a.x); v[1] = bfhi(a.x); v[2] = bflo(a.y); v[3] = bfhi(a.y); v[4] = bflo(a.z); v[5] = bfhi(a.z); v[6] = bflo(a.w); v[7] = bfhi(a.w); }
__device__ __forceinline__ void mla_kprep(const Frame& F, bf16* KV, const bf16* C, const float* kg) {
    const int h = F.lane >> 2, s = F.lane & 3; constexpr int R = 4;
    float gk[24], inv[4];
#pragma unroll
    for (int i = 0; i < 16; ++i) gk[i] = kg[16 * s + i];
#pragma unroll
    for (int i = 0; i < 4; ++i) { gk[16 + i] = kg[64 + 4 * s + i]; gk[20 + i] = kg[80 + 4 * s + i]; inv[i] = exp2f(-(float)(2 * (4 * s + i)) * (1.0f / 32.0f) * 13.287712379549449f); }
    for (int m0 = F.gw * R; m0 < T; m0 += F.ngw * R) {
        u32x4 a[R], b[R]; u32x2 r1[R], r2[R];
#pragma unroll
        for (int r = 0; r < R; ++r) { const bf16* nope = KV + (size_t)(m0 + r) * 2560 + h * 64 + 16 * s; const bf16* rs = C + (size_t)(m0 + r) * 512 + 384 + 4 * s;
            a[r] = *(const u32x4*)nope; b[r] = *(const u32x4*)(nope + 8); r1[r] = *(const u32x2*)rs; r2[r] = *(const u32x2*)(rs + 16); }
#pragma unroll
        for (int r = 0; r < R; ++r) { const int t = (m0 + r) & (S - 1); float v[24];
            unpack8(a[r], v); unpack8(b[r], v + 8);
            v[16] = bflo(r1[r].x); v[17] = bfhi(r1[r].x); v[18] = bflo(r1[r].y); v[19] = bfhi(r1[r].y); v[20] = bflo(r2[r].x); v[21] = bfhi(r2[r].x); v[22] = bflo(r2[r].y); v[23] = bfhi(r2[r].y);
            float q = 0.f;
#pragma unroll
            for (int i = 0; i < 24; ++i) q += v[i] * v[i];
            q = quad_sum(q, 4);
            const float sc = 1.0f / sqrtf(q * (1.0f / 96.0f) + EPS);
#pragma unroll
            for (int i = 0; i < 24; ++i) v[i] *= sc * gk[i];
#pragma unroll
            for (int i = 0; i < 4; ++i) { float sn, cs; sincosf((float)t * inv[i], &sn, &cs); const float x1 = v[16 + i], x2 = v[20 + i]; v[16 + i] = x1 * cs - x2 * sn; v[20 + i] = x1 * sn + x2 * cs; }
            bf16* nope = KV + (size_t)(m0 + r) * 2560 + h * 64 + 16 * s;
            *(u32x4*)nope = (u32x4){hpk2(v[0], v[1]), hpk2(v[2], v[3]), hpk2(v[4], v[5]), hpk2(v[6], v[7])};
            *(u32x4*)(nope + 8) = (u32x4){hpk2(v[8], v[9]), hpk2(v[10], v[11]), hpk2(v[12], v[13]), hpk2(v[14], v[15])};
            bf16* rd = KV + (size_t)(m0 + r) * 2560 + 1024 + h * 32 + 4 * s;
            *(u32x2*)rd = (u32x2){hpk2(v[16], v[17]), hpk2(v[18], v[19])}; *(u32x2*)(rd + 16) = (u32x2){hpk2(v[20], v[21]), hpk2(v[22], v[23])}; }
    }
}
__device__ __forceinline__ void swa_kprep(const Frame& F, bf16* QKV, const float* kg) {
    const int tk = F.lane >> 4, hv = (F.lane >> 2) & 3, s = F.lane & 3; constexpr int R = 2;
    float gk[16];
#pragma unroll
    for (int i = 0; i < 16; ++i) gk[i] = kg[16 * s + i];
    for (int m0 = F.gw * 4 * R; m0 < T; m0 += F.ngw * 4 * R) {
        u32x4 a[R], b[R];
#pragma unroll
        for (int r = 0; r < R; ++r) { const bf16* p = QKV + (size_t)(m0 + 4 * r + tk) * 1536 + 1024 + hv * 64 + 16 * s; a[r] = *(const u32x4*)p; b[r] = *(const u32x4*)(p + 8); }
#pragma unroll
        for (int r = 0; r < R; ++r) { float v[16]; unpack8(a[r], v); unpack8(b[r], v + 8); float q = 0.f;
#pragma unroll
            for (int i = 0; i < 16; ++i) q += v[i] * v[i];
            q = quad_sum(q, 4); const float sc = 1.0f / sqrtf(q * (1.0f / 64.0f) + EPS);
#pragma unroll
            for (int i = 0; i < 16; ++i) v[i] *= sc * gk[i];
            bf16* p = QKV + (size_t)(m0 + 4 * r + tk) * 1536 + 1024 + hv * 64 + 16 * s;
            *(u32x4*)p = (u32x4){hpk2(v[0], v[1]), hpk2(v[2], v[3]), hpk2(v[4], v[5]), hpk2(v[6], v[7])};
            *(u32x4*)(p + 8) = (u32x4){hpk2(v[8], v[9]), hpk2(v[10], v[11]), hpk2(v[12], v[13]), hpk2(v[14], v[15])}; }
    }
}
__device__ __forceinline__ void ax_kprep(const Frame& F, bf16* QKV, const float* kg) {
    const int tk = F.lane >> 5, hv = (F.lane >> 3) & 3, s = F.lane & 7; constexpr int R = 2;
    float gk[16], inv[4];
#pragma unroll
    for (int c = 0; c < 4; ++c)
#pragma unroll
        for (int i = 0; i < 4; ++i) gk[4 * c + i] = kg[32 * c + 4 * s + i];
#pragma unroll
    for (int i = 0; i < 4; ++i) inv[i] = exp2f(-(float)(2 * (4 * s + i)) * (1.0f / 64.0f) * 13.287712379549449f);
    for (int m0 = F.gw * 2 * R; m0 < T; m0 += F.ngw * 2 * R) {
        u32x2 w[R][4];
#pragma unroll
        for (int r = 0; r < R; ++r) { const bf16* p = QKV + (size_t)(m0 + 2 * r + tk) * 2048 + 1024 + hv * 128 + 4 * s;
#pragma unroll
            for (int c = 0; c < 4; ++c) w[r][c] = *(const u32x2*)(p + 32 * c); }
#pragma unroll
        for (int r = 0; r < R; ++r) { const int t = (m0 + 2 * r + tk) & (S - 1), prow = t >> 6, pcol = t & 63; float v[16];
#pragma unroll
            for (int c = 0; c < 4; ++c) { v[4 * c] = bflo(w[r][c].x); v[4 * c + 1] = bfhi(w[r][c].x); v[4 * c + 2] = bflo(w[r][c].y); v[4 * c + 3] = bfhi(w[r][c].y); }
            float q = 0.f;
#pragma unroll
            for (int i = 0; i < 16; ++i) q += v[i] * v[i];
            q = quad_sum(q, 8); const float sc = __builtin_amdgcn_rsqf(q * (1.0f / 128.0f) + EPS);
#pragma unroll
            for (int i = 0; i < 16; ++i) v[i] *= sc * gk[i];
#pragma unroll
            for (int i = 0; i < 4; ++i) { float sn, cs; fast_sincos((float)prow * inv[i], sn, cs); float x1 = v[i], x2 = v[4 + i];     v[i] = x1 * cs - x2 * sn; v[4 + i] = x1 * sn + x2 * cs;
                fast_sincos((float)pcol * inv[i], sn, cs); x1 = v[8 + i]; x2 = v[12 + i]; v[8 + i] = x1 * cs - x2 * sn; v[12 + i] = x1 * sn + x2 * cs; }
            bf16* p = QKV + (size_t)(m0 + 2 * r + tk) * 2048 + 1024 + hv * 128 + 4 * s;
#pragma unroll
            for (int c = 0; c < 4; ++c) *(u32x2*)(p + 32 * c) = (u32x2){hpk2(v[4 * c], v[4 * c + 1]), hpk2(v[4 * c + 2], v[4 * c + 3])}; }
    }
}

template <int DK, int DV, int MODE>
__device__ __forceinline__ void nattn_unit(const Frame& F, const bf16* Q, int ldq, const bf16* Kp, int ldk, const bf16* Vp, int ldv, bf16* O, int ldo, int q0, float slope2, float sink2) {
    constexpr int HK = DK / 2, HV = DV / 2;
    LAS bf16* Ks = (LAS bf16*)F.lds; LAS bf16* Vs = Ks + 64 * DK;
    const int qi = F.tid >> 1, half = F.tid & 1, t = q0 + qi;
    float q[HK], o[HV];
    { const bf16* qp = Q + (size_t)t * ldq + half * HK;
#pragma unroll
      for (int c = 0; c < HK / 8; ++c) { const u32x4 w = *(const u32x4*)(qp + 8 * c); q[8 * c] = bflo(w.x); q[8 * c + 1] = bfhi(w.x); q[8 * c + 2] = bflo(w.y); q[8 * c + 3] = bfhi(w.y);
          q[8 * c + 4] = bflo(w.z); q[8 * c + 5] = bfhi(w.z); q[8 * c + 6] = bflo(w.w); q[8 * c + 7] = bfhi(w.w); } }
#pragma unroll
    for (int i = 0; i < HV; ++i) o[i] = 0.f;
    float mx = MODE ? sink2 : -1e30f, l = MODE ? 1.f : 0.f;
    const int klo = MODE ? (q0 - 128 < 0 ? 0 : q0 - 128) : 0, khi = MODE ? (q0 + 384 > S ? S : q0 + 384) : S;
    for (int kt = klo; kt < khi; kt += 64) {
        __syncthreads();
        for (int p = F.tid; p < 64 * DK / 8; p += NTHREADS) { const int row = p / (DK / 8), c8 = p % (DK / 8); *(LAS u32x4*)(Ks + row * DK + c8 * 8) = *(const u32x4*)(Kp + (size_t)(kt + row) * ldk + c8 * 8); }
        for (int p = F.tid; p < 64 * DV / 8; p += NTHREADS) { const int row = p / (DV / 8), c8 = p % (DV / 8); *(LAS u32x4*)(Vs + row * DV + c8 * 8) = *(const u32x4*)(Vp + (size_t)(kt + row) * ldv + c8 * 8); }
        __syncthreads();
        for (int j = 0; j < 64; ++j) {
            const LAS u32x4* kr = (const LAS u32x4*)(Ks + j * DK + half * HK); float s = 0.f;
#pragma unroll
            for (int c = 0; c < HK / 8; ++c) { const u32x4 w = kr[c]; s += q[8 * c] * bflo(w.x) + q[8 * c + 1] * bfhi(w.x) + q[8 * c + 2] * bflo(w.y) + q[8 * c + 3] * bfhi(w.y)
                + q[8 * c + 4] * bflo(w.z) + q[8 * c + 5] * bfhi(w.z) + q[8 * c + 6] * bflo(w.w) + q[8 * c + 7] * bfhi(w.w); }
            s += __shfl_xor(s, 1);
            if (MODE) { int dist = t - (kt + j); dist = dist < 0 ? -dist : dist; if (dist > 128) continue; s -= slope2 * (float)dist; }
            if (s > mx) { const float corr = __builtin_amdgcn_exp2f(mx - s); l *= corr;
#pragma unroll
                for (int i = 0; i < HV; ++i) o[i] *= corr;
                mx = s; }
            const float p = __builtin_amdgcn_exp2f(s - mx); l += p;
            const LAS u32x4* vr = (const LAS u32x4*)(Vs + j * DV + half * HV);
#pragma unroll
            for (int c = 0; c < HV / 8; ++c) { const u32x4 w = vr[c]; o[8 * c] += p * bflo(w.x); o[8 * c + 1] += p * bfhi(w.x); o[8 * c + 2] += p * bflo(w.y); o[8 * c + 3] += p * bfhi(w.y);
                o[8 * c + 4] += p * bflo(w.z); o[8 * c + 5] += p * bfhi(w.z); o[8 * c + 6] += p * bflo(w.w); o[8 * c + 7] += p * bfhi(w.w); }
        }
    }
    const float rl = 1.0f / l; bf16* op = O + (size_t)t * ldo + half * HV;
#pragma unroll
    for (int c = 0; c < HV / 8; ++c) *(u32x4*)(op + 8 * c) = (u32x4){pk2(o[8 * c] * rl, o[8 * c + 1] * rl), pk2(o[8 * c + 2] * rl, o[8 * c + 3] * rl), pk2(o[8 * c + 4] * rl, o[8 * c + 5] * rl), pk2(o[8 * c + 6] * rl, o[8 * c + 7] * rl)};
}

__device__ __forceinline__ void moe_route(const Frame& F, const bf16* x, const float* gain, const float* Wr, const float* br, unsigned* cnt, unsigned* pub, int* idx, float* wl, float* rsl, int* tpos) {
    LAS int* lw = (LAS int*)(F.lds + 65536);
    float wr[16][8];
#pragma unroll
    for (int j = 0; j < 2; ++j)
#pragma unroll
        for (int i = 0; i < 8; ++i) { const int k = 512 * j + 8 * F.lane + i; const float g = gain[k]; const f32x4 a = *(const f32x4*)(Wr + k * 8), b = *(const f32x4*)(Wr + k * 8 + 4);
            wr[8 * j + i][0] = a.x * g; wr[8 * j + i][1] = a.y * g; wr[8 * j + i][2] = a.z * g; wr[8 * j + i][3] = a.w * g; wr[8 * j + i][4] = b.x * g; wr[8 * j + i][5] = b.y * g; wr[8 * j + i][6] = b.z * g; wr[8 * j + i][7] = b.w * g; }
    float bias[8];
#pragma unroll
    for (int e = 0; e < 8; ++e) bias[e] = br[e];
    for (int chunk = blockIdx.x; chunk < T / 128; chunk += gridDim.x) {
        int me0 = -1, me1 = -1; float mw0 = 0.f, mw1 = 0.f, mrs = 0.f;
        for (int r = 0; r < 16; ++r) {
            const int m = chunk * 128 + F.wave * 16 + r; const u32x4* xr = (const u32x4*)(x + (size_t)m * D) + F.lane;
            float lg[8], ssq = 0.f;
#pragma unroll
            for (int e = 0; e < 8; ++e) lg[e] = 0.f;
#pragma unroll
            for (int j = 0; j < 2; ++j) { f32x4 v, w; pg8::unpack8f(xr[64 * j], v, w); ssq += pg8::sumsq4(v) + pg8::sumsq4(w);
#pragma unroll
                for (int e = 0; e < 8; ++e) lg[e] += (v[0] * wr[8 * j][e] + v[1] * wr[8 * j + 1][e] + v[2] * wr[8 * j + 2][e] + v[3] * wr[8 * j + 3][e]) + (w[0] * wr[8 * j + 4][e] + w[1] * wr[8 * j + 5][e] + w[2] * wr[8 * j + 6][e] + w[3] * wr[8 * j + 7][e]); }
            ssq = wave_sum(ssq); const float rstd = 1.0f / sqrtf(ssq * (1.0f / D) + EPS);
            {
                const bool b5 = F.lane & 32, b4 = F.lane & 16, b3 = F.lane & 8; float t4[4], t2[2], t1;
#pragma unroll
                for (int k_ = 0; k_ < 4; ++k_) { const float snd = b5 ? lg[k_] : lg[4 + k_], kp = b5 ? lg[4 + k_] : lg[k_]; t4[k_] = kp + __shfl_xor(snd, 32); }
#pragma unroll
                for (int k_ = 0; k_ < 2; ++k_) { const float snd = b4 ? t4[k_] : t4[2 + k_], kp = b4 ? t4[2 + k_] : t4[k_]; t2[k_] = kp + __shfl_xor(snd, 16); }
                { const float snd = b3 ? t2[0] : t2[1], kp = b3 ? t2[1] : t2[0]; t1 = kp + __shfl_xor(snd, 8); }
                t1 += __shfl_xor(t1, 4); t1 += __shfl_xor(t1, 2); t1 += __shfl_xor(t1, 1);
#pragma unroll
                for (int e = 0; e < 8; ++e) lg[e] = __builtin_bit_cast(float, __builtin_amdgcn_readlane(__builtin_bit_cast(int, t1), 8 * e)) * rstd + bias[e];
            }
            int e0 = 0; float l0 = lg[0];
#pragma unroll
            for (int e = 1; e < 8; ++e) if (lg[e] > l0) { l0 = lg[e]; e0 = e; }
            int e1 = -1; float l1 = -3.0e38f;
#pragma unroll
            for (int e = 0; e < 8; ++e) if (e != e0 && lg[e] > l1) { l1 = lg[e]; e1 = e; }
            const float w1 = 1.0f / (1.0f + __expf(l0 - l1)), w0 = 1.0f - w1;
            if (F.lane == r) { me0 = e0; me1 = e1; mw0 = w0; mw1 = w1; mrs = rstd; }
        }
        unsigned long long m0[8], m1[8]; int nw[8];
#pragma unroll
        for (int e = 0; e < 8; ++e) { m0[e] = __ballot(me0 == e); m1[e] = __ballot(me1 == e); nw[e] = __popcll(m0[e]) + __popcll(m1[e]); }
        __syncthreads();
        if (F.lane < 8) { int v = 0;
#pragma unroll
            for (int e = 0; e < 8; ++e) if (F.lane == e) v = nw[e];
            lw[F.wave * 8 + F.lane] = v; }
        __syncthreads();
        if (F.wave == 0 && F.lane < 8) { int tot = 0; for (int w = 0; w < 8; ++w) tot += lw[w * 8 + F.lane]; lw[72 + F.lane] = tot;
            (void)xb_add(pub + chunk * 8 + F.lane, (unsigned)tot + 1u); }
        { int part = 0; const int e_ = F.lane & 7;
            for (int c2 = F.tid >> 3; c2 < chunk; c2 += NTHREADS / 8) { unsigned v, sp = 0u;
                while ((v = xb_ld(pub + c2 * 8 + e_)) == 0u) { __builtin_amdgcn_s_sleep(1); if (++sp > XB_SPIN_CAP) break; }
                part += (int)v - 1; }
            part += __shfl_xor(part, 8); part += __shfl_xor(part, 16); part += __shfl_xor(part, 32);
            if (F.lane < 8) lw[80 + F.wave * 8 + F.lane] = part; }
        __syncthreads();
        if (F.wave == 0 && F.lane < 8) { int base = 0; for (int w = 0; w < 8; ++w) base += lw[80 + w * 8 + F.lane]; lw[64 + F.lane] = base;
            if (chunk == T / 128 - 1) cnt[F.lane * 64] = (unsigned)(base + lw[72 + F.lane]); }
        __syncthreads();
        if (F.lane < 16) {
            const int m = chunk * 128 + F.wave * 16 + F.lane; const unsigned long long lt = (1ull << F.lane) - 1ull;
            int s0 = 0, s1 = 0;
#pragma unroll
            for (int e = 0; e < 8; ++e) { int base = lw[64 + e]; for (int w = 0; w < F.wave; ++w) base += lw[w * 8 + e];
                if (me0 == e) s0 = base + __popcll(m0[e] & lt); if (me1 == e) s1 = base + __popcll(m0[e]) + __popcll(m1[e] & lt); }
            idx[me0 * T + s0] = m; wl[me0 * T + s0] = mw0; rsl[me0 * T + s0] = mrs; idx[me1 * T + s1] = m; wl[me1 * T + s1] = mw1; rsl[me1 * T + s1] = mrs;
            tpos[2 * m] = me0 * T + s0; tpos[2 * m + 1] = me1 * T + s1;
        }
    }
}
__device__ __forceinline__ void moe_combine(const Frame& F, bf16* xb, ssq_t* ss, const bf16* Y, const unsigned* cnt, const int* tpos) {
    int tb[8]; { int base = 0;
#pragma unroll
        for (int e = 0; e < 8; ++e) { tb[e] = base; base += (((int)cnt[e * 64] + 255) >> 8) << 8; } }
    constexpr int R = 4;
    for (int m0 = F.gw * R; m0 < T; m0 += F.ngw * R) {
        int ra[R], rb[R];
#pragma unroll
        for (int r = 0; r < R; ++r) { const int p0 = tpos[2 * (m0 + r)], p1 = tpos[2 * (m0 + r) + 1]; ra[r] = 0; rb[r] = 0;
#pragma unroll
            for (int e = 0; e < 8; ++e) { if ((p0 / T) == e) ra[r] = tb[e] + (p0 % T); if ((p1 / T) == e) rb[r] = tb[e] + (p1 % T); } }
        u32x4 xv[R][2], ya[R][2], yb[R][2];
#pragma unroll
        for (int r = 0; r < R; ++r)
#pragma unroll
            for (int j = 0; j < 2; ++j) { xv[r][j] = ((const u32x4*)(xb + (size_t)(m0 + r) * D) + F.lane)[64 * j]; ya[r][j] = ((const u32x4*)(Y + (size_t)ra[r] * D) + F.lane)[64 * j]; yb[r][j] = ((const u32x4*)(Y + (size_t)rb[r] * D) + F.lane)[64 * j]; }
#pragma unroll
        for (int r = 0; r < R; ++r) { float sq = 0.f;
#pragma unroll
            for (int j = 0; j < 2; ++j) { f32x4 x0, x1, a0, a1, b0, b1; pg8::unpack8f(xv[r][j], x0, x1); pg8::unpack8f(ya[r][j], a0, a1); pg8::unpack8f(yb[r][j], b0, b1);
                x0 = x0 + a0 + b0; x1 = x1 + a1 + b1; sq += pg8::sumsq4(x0) + pg8::sumsq4(x1);
                ((u32x4*)(xb + (size_t)(m0 + r) * D) + F.lane)[64 * j] = (u32x4){hpk2(x0[0], x0[1]), hpk2(x0[2], x0[3]), hpk2(x1[0], x1[1]), hpk2(x1[2], x1[3])}; }
            sq = wave_sum(sq); if (F.lane == 0) ss_set(ss, m0 + r, sq); }
    }
}

__device__ __forceinline__ void tail_reduce(const Frame& F, const pg8::GroupedOrder<false>& So, int first, int ntail, int nsl, const float* P, bf16* Y, const float* wl) {
    for (int rw = F.gw; rw < ntail * 256; rw += F.ngw) { const int tu = rw >> 8, rr = rw & 255; pg8::Unit u; So.decode(first + tu, u);
        f32x4 s = {0.f, 0.f, 0.f, 0.f};
        for (int ks = 0; ks < nsl; ++ks) s += *(const f32x4*)(P + ((size_t)(ks * ntail + tu) * 65536 + rr * 256 + 4 * F.lane));
        const int slot = u.slot0 + rr; const float w_ = __builtin_nontemporal_load(wl + u.e * T + slot); const float w = slot < u.cnt ? w_ : 0.f;
        uint2 o; o.x = hpk2(s[0] * w, s[1] * w); o.y = hpk2(s[2] * w, s[3] * w);
        *(uint2*)(Y + (size_t)(u.pm * 256 + rr) * D + (u.pn - u.e * 4) * 256 + 4 * F.lane) = o; }
}

constexpr int N_STEPS = 32;
constexpr int PTR_TAB_OFF = RING_BYTES + 2048;
__device__ __forceinline__ const float* inp_ptr(LAS unsigned char* lds, int i) {
    const LAS unsigned* t = (const LAS unsigned*)(lds + PTR_TAB_OFF) + 2 * i;
    const unsigned lo_ = __builtin_amdgcn_readfirstlane(t[0]), hi_ = __builtin_amdgcn_readfirstlane(t[1]);
    return (const float*)(const GAS float*)(((unsigned long long)hi_ << 32) | lo_);
}
#ifndef PROBE_STEP
#define PROBE_STEP (-1)
#endif
#ifndef PROBE_REPS
#define PROBE_REPS 2
#endif
__device__ __forceinline__ void zero_fill16(const Frame& F, bf16* base, int nrows, int ld, int c0, int ncols) {
    const int per = ncols / 8;
    for (int i = F.gw * 64 + F.lane; i < nrows * per; i += F.ngw * 64) { const int r = i / per, c = i % per; *(u32x4*)(base + (size_t)r * ld + c0 + 8 * c) = (u32x4){0u, 0u, 0u, 0u}; }
}
__global__ void __launch_bounds__(NTHREADS, 2) mega(Args args) {
    extern __shared__ __attribute__((aligned(16))) unsigned char lds_raw[];
    Frame F; F.lds = (LAS unsigned char*)lds_raw; F.ctl = (unsigned*)(args.ws + WS_CTL);
    F.tid = threadIdx.x; F.lane = F.tid & 63; F.wave = __builtin_amdgcn_readfirstlane(F.tid >> 6);
    F.gw = blockIdx.x * NWAVES + F.wave; F.ngw = gridDim.x * NWAVES;
    volatile LAS unsigned* MISC = (volatile LAS unsigned*)(F.lds + MISC_OFF);
    for (int u = F.tid; u < (LDS_BYTES - RING_BYTES) / 4; u += NTHREADS) ((LAS unsigned*)(F.lds + RING_BYTES))[u] = 0u;
    __syncthreads();
    if (F.tid < N_IN) ((LAS unsigned long long*)(F.lds + PTR_TAB_OFF))[F.tid] = (unsigned long long)args.in[F.tid];
    if (F.tid == N_IN) ((LAS unsigned long long*)(F.lds + PTR_TAB_OFF))[N_IN] = (unsigned long long)args.ws;
    if (F.tid == N_IN + 1) ((LAS unsigned long long*)(F.lds + PTR_TAB_OFF))[N_IN + 1] = (unsigned long long)args.out;
    __syncthreads();
    XcdBarrier bar; bar.bar = F.ctl + CW_BAR; bar.x = 0; bar.st = nullptr;
    if (MK_N_LAUNCHES == 1) bar = xcd_barrier_post(F.ctl + CW_BAR, MISC + 8);
    const int lo = args.lo, hi = args.hi;
#define ws  ((unsigned char*)inp_ptr(F.lds, N_IN))
#define out ((float*)inp_ptr(F.lds, N_IN + 1))
#define act (ws + WS_ACT)
#define WT ((bf16*)(ws + WS_WT))
#define WM ((bf16*)(ws + WS_WMOE))
#define XB ((bf16*)(ws + WS_XB))
#define PB ((bf16*)(ws + WS_PB))
#define PT ((bf16*)(ws + WS_PT))
#define XA ((bf16*)(act + A_XA))
#define SS ((ssq_t*)(ws + CTL_SS))
#define SSC ((ssq_t*)(ws + CTL_SSC))
#define m_idx ((int*)(ws + WS_MOEL))
#define m_wl ((float*)(ws + WS_MOEL + 1 * MiB))
#define m_tpos ((int*)(ws + WS_MOEL + 2 * MiB))
#define m_rs ((float*)(ws + WS_MOEL + 3 * MiB))
    const int G = gridDim.x, cid = blockIdx.x;
    const int vcu = (G % 8 == 0) ? (cid % 8) * (G / 8) + cid / 8 : cid;
#define IN_(k) (lo <= (k) && (k) < hi)
#if PROBE_STEP >= 0
#define REPS(k) ((k) == PROBE_STEP ? PROBE_REPS : 1)
#define REP_LOOP(k) for (int rep_ = 0; rep_ < REPS(k); ++rep_)
#define SEAM(k) do { if (MK_N_LAUNCHES == 1 && ((k) + 1 < hi || rep_ + 1 < REPS(k))) xcd_barrier(bar); } while (0)
#else
#define REP_LOOP(k)
#define SEAM(k) do { if (MK_N_LAUNCHES == 1 && (k) + 1 < hi) xcd_barrier(bar); } while (0)
#endif
#define INP(i) inp_ptr(F.lds, (i))
#define REFRESH() do { F.tid = tid_now(); F.lane = F.tid & 63; F.wave = __builtin_amdgcn_readfirstlane(F.tid >> 6); F.gw = blockIdx.x * NWAVES + F.wave; } while (0)

    if (IN_(0)) REP_LOOP(0) { REFRESH();
        int wofs = 0;
        { constexpr int j = 0;
            cvt_job(F, INP(I_MLA_W_DOWN) + (size_t)j * D * 416, nullptr, 416, 416, INP(I_ATTN_NORM) + 3 * j * D, WT + WT_DOWN + (size_t)j * 512 * 1024, 1024, 512, 0, wofs); wofs += 16 * 16;
            cvt_job(F, INP(I_MLA_W_UQ) + (size_t)j * 256 * 1536, nullptr, 1536, 1536, INP(I_MLA_Q_NORM) + j * 256, WT + WT_UQ + (size_t)j * 1536 * 256, 256, 1536, 0, wofs); wofs += 4 * 48;
            cvt_job(F, INP(I_MLA_W_UKV) + (size_t)j * 128 * 2048, nullptr, 2048, 2048, INP(I_MLA_KV_NORM) + j * 128, WT + WT_UKV + (size_t)j * 2560 * 256, 128, 2048, 1, wofs); wofs += 2 * 64;
            cvt_job(F, INP(I_MLA_W_O) + (size_t)j * D * D, nullptr, D, D, nullptr, WT + WT_WO + (size_t)(3 * j) * D * D, 1024, 1024, 0, wofs); wofs += 16 * 32;
        }
        xb_rows(F, INP(I_X), XA, SS + 0 * T);
        SEAM(0);
    }

#define LATE_WEIGHTS() do { int wofs = 0; \
        for (int j = 0; j < 2; ++j) { \
            if (j == 1) { \
                cvt_job(F, INP(I_MLA_W_DOWN) + (size_t)j * D * 416, nullptr, 416, 416, INP(I_ATTN_NORM) + 3 * j * D, WT + WT_DOWN + (size_t)j * 512 * 1024, 1024, 512, 0, wofs); wofs += 16 * 16; \
                cvt_job(F, INP(I_MLA_W_UQ) + (size_t)j * 256 * 1536, nullptr, 1536, 1536, INP(I_MLA_Q_NORM) + j * 256, WT + WT_UQ + (size_t)j * 1536 * 256, 256, 1536, 0, wofs); wofs += 4 * 48; \
                cvt_job(F, INP(I_MLA_W_UKV) + (size_t)j * 128 * 2048, nullptr, 2048, 2048, INP(I_MLA_KV_NORM) + j * 128, WT + WT_UKV + (size_t)j * 2560 * 256, 128, 2048, 1, wofs); wofs += 2 * 64; \
                cvt_job(F, INP(I_MLA_W_O) + (size_t)j * D * D, nullptr, D, D, nullptr, WT + WT_WO + (size_t)(3 * j) * D * D, 1024, 1024, 0, wofs); wofs += 16 * 32; } \
            cvt_job(F, INP(I_FFN_W_GATE) + (size_t)j * D * FF, INP(I_FFN_W_UP) + (size_t)j * D * FF, FF, FF, INP(I_FFN_NORM) + 2 * j * D, WT + WT_FGU + (size_t)j * 5632 * 1024, 1024, 5632, 2, wofs); wofs += 16 * 88; \
            cvt_job(F, INP(I_FFN_W_DOWN) + (size_t)j * FF * D, nullptr, D, D, nullptr, WT + WT_FDN + (size_t)j * 1024 * FF, FF, 1024, 0, wofs); wofs += 44 * 16; \
        } \
        cvt_job(F, INP(I_SWA_W_QKV), nullptr, 1536, 1536, INP(I_ATTN_NORM) + 1 * D, WT + WT_SQKV, 1024, 1536, 0, wofs); wofs += 16 * 24; \
        cvt_job(F, INP(I_SWA_W_O), nullptr, D, D, nullptr, WT + WT_WO + (size_t)1 * D * D, 1024, 1024, 0, wofs); wofs += 16 * 16; \
        cvt_job(F, INP(I_AX_W_QKV), nullptr, 2048, 2048, INP(I_ATTN_NORM) + 2 * D, WT + WT_AQKV, 1024, 2048, 0, wofs); wofs += 16 * 32; \
        cvt_job(F, INP(I_AX_W_O), nullptr, D, D, nullptr, WT + WT_WO + (size_t)2 * D * D, 1024, 1024, 0, wofs); wofs += 16 * 16; \
        for (int l2 = 0; l2 < 4; ++l2) { \
            cvt_job(F, INP(I_PLE_W_IN) + (size_t)l2 * PLE * D, nullptr, D, D, nullptr, WT + WT_PIN + (size_t)l2 * 1024 * 256, 256, 1024, 0, wofs); wofs += 4 * 16; \
            cvt_job(F, INP(I_PLE_W_GATE) + (size_t)l2 * D * D, nullptr, D, D, INP(I_PLE_NORM) + l2 * D, WT + WT_PG + (size_t)l2 * D * D, 1024, 1024, 0, wofs); wofs += 16 * 16; } \
    } while (0)
    int k = 1;
    { constexpr int l = 0;
        const int kind = l % 3, jm = l / 3, f = l >> 1;
        const ssq_t* ss_attn = SS + (size_t)(3 * l) * T; ssq_t* ss_ffn = SS + (size_t)(3 * l + 1) * T; ssq_t* ss_ple = SS + (size_t)(3 * l + 2) * T; ssq_t* ss_next = l < 3 ? SS + (size_t)(3 * l + 3) * T : nullptr;
        if (kind == 0) {
            if (IN_(k)) REP_LOOP(k) { REFRESH(); pg8::Gemm g{XA, WT + WT_DOWN + (size_t)jm * 512 * 1024, 1024, 1024}; pg8::StaticOrder So; So.init(T, 512, G, cid);
                pg8::EpiPlain<true> E{(bf16*)(act + A_C), 512, 2, ss_attn, 1.0f / D, nullptr, SSC + (size_t)jm * T, SSC + (size_t)(2 + jm) * T};
                pg8::gemm_phase(F.lds, g, So, E); SEAM(k); } ++k;
            if (IN_(k)) REP_LOOP(k) { REFRESH(); { pg8::Gemm g{(const bf16*)(act + A_C), WT + WT_UQ + (size_t)jm * 1536 * 256, 256, 512}; pg8::StaticOrder So; So.init(T, 1536, G, cid);
                  pg8::EpiPlain<false> E{(bf16*)(act + A_QR), 1536, 6, SSC + (size_t)jm * T, 1.0f / 256, nullptr, nullptr, nullptr}; pg8::gemm_phase(F.lds, g, So, E); }
                { int k128_ = 128; asm volatile("" : "+s"(k128_));     pg8::Gemm g{(const bf16*)(act + A_C) + 256, WT + WT_UKV + (size_t)jm * 2560 * 256, k128_, 512}; pg8::StaticOrder So; So.init(T, 2048, G, cid);
                  pg8::EpiKN<true> E{(bf16*)(act + A_KV), 2560, 0, 4, 512, SSC + (size_t)(2 + jm) * T, 1.0f / 128, INP(I_MLA_K_GAIN) + jm * 96, (const bf16*)(act + A_C), (LAS float*)(F.lds + RING_BYTES + 4096)}; pg8::gemm_phase(F.lds, g, So, E); }
                SEAM(k); } ++k;
            if (IN_(k)) REP_LOOP(k) { REFRESH(); int it_ = 0; const int nit_ = (NB * 16 * 8 - vcu + G - 1) / G; const int stag_ = ((cid >> 3) & 7) % (nit_ > 0 ? nit_ : 1); constexpr int fc_ = l == 0 ? 0 : 1, lc_ = l == 0 ? 1 : 3;
                for (int u = vcu; u < NB * 16 * 8; u += G, ++it_) { const int qb = u & 7, h = (u >> 3) & 15, b = u >> 7;
                    if (it_ == stag_) {
                        __syncthreads();
                        REFRESH();
                        moe_cvt_all(F, INP(I_MOE_W_GATE) + (size_t)fc_ * NE * D * EF, INP(I_MOE_W_UP) + (size_t)fc_ * NE * D * EF, INP(I_MOE_W_DOWN) + (size_t)fc_ * NE * EF * D, INP(I_FFN_NORM) + lc_ * D, WM);
                        if (l == 0) { LATE_WEIGHTS(); cvt_flat(F, INP(I_P), PB, (size_t)4 * T * PLE / 8); }
                        __syncthreads(); }
                    fa::attn_unit<96, 64, 0, 0, 1536, 2560, 2560, D, 2>((const bf16*)(act + A_QR) + (size_t)(b * S + qb * 256) * 1536 + h * 96, (const bf16*)(act + A_KV) + (size_t)b * S * 2560 + h * 64,
                                          (const bf16*)(act + A_KV) + (size_t)b * S * 2560 + 1536 + h * 64, (bf16*)(act + A_O) + (size_t)(b * S + qb * 256) * D + h * 64, S / 64, qb * 256, 0, 0.f, 0.f, INP(I_MLA_Q_GAIN) + jm * 96, 1024 - 32 * h, F.lds); } SEAM(k); } ++k;
        } else if (kind == 1) {
            if (IN_(k)) REP_LOOP(k) { REFRESH(); pg8::Gemm g{XA, WT + WT_SQKV, 1024, 1024}; pg8::StaticOrder So; So.init(T, 1536, G, cid);
                pg8::EpiKN<false> E{(bf16*)(act + 0), 1536, 4, 5, 0, ss_attn, 1.0f / D, INP(I_SWA_K_GAIN), nullptr, (LAS float*)(F.lds + RING_BYTES + 4096)}; pg8::gemm_phase(F.lds, g, So, E); SEAM(k); } ++k;
            if (IN_(k)) REP_LOOP(k) { REFRESH(); for (int u = vcu; u < NB * 16 * 8; u += G) { const int qb = u & 7, h = (u >> 3) & 15, b = u >> 7; const int gq = h >> 2;
                    const float slope2 = exp2f(-8.0f * (float)(h + 1) / 16.0f) * LOG2E, sink2 = INP(I_SWA_SINK)[h] * LOG2E;
                    const int q0 = qb * 256, klo = q0 - 128 < 0 ? 0 : q0 - 128, khi = q0 + 384 > S ? S : q0 + 384;
                    fa::attn_unit<64, 64, 1, 1, 1536, 1536, 1536, D, 2>((const bf16*)(act + 0) + (size_t)(b * S + q0) * 1536 + h * 64, (const bf16*)(act + 0) + (size_t)(b * S + klo) * 1536 + 1024 + gq * 64,
                                          (const bf16*)(act + 0) + (size_t)(b * S + klo) * 1536 + 1280 + gq * 64, (bf16*)(act + A_O) + (size_t)(b * S + q0) * D + h * 64, (khi - klo) / 64, q0, klo, slope2, sink2, INP(I_SWA_Q_GAIN), 0, F.lds); } SEAM(k); } ++k;
        } else {
            if (IN_(k)) REP_LOOP(k) { REFRESH(); pg8::Gemm g{XA, WT + WT_AQKV, 1024, 1024}; pg8::StaticOrder So; So.init(T, 2048, G, cid);
                pg8::EpiPlain<false> E{(bf16*)(act + 0), 2048, 8, ss_attn, 1.0f / D, nullptr, nullptr, nullptr}; pg8::gemm_phase(F.lds, g, So, E); SEAM(k); } ++k;
            if (IN_(k)) REP_LOOP(k) { REFRESH(); ax_kprep(F, (bf16*)(act + 0), INP(I_AX_K_GAIN)); SEAM(k); } ++k;
            if (IN_(k)) REP_LOOP(k) { REFRESH(); for (int u = vcu; u < NB * 8 * 8; u += G) { const int qb = u & 7, h = (u >> 3) & 7, b = u >> 6; const int gq = h >> 1;
                    fa::attn_unit<128, 128, 0, 2, 2048, 2048, 2048, D, 1>((const bf16*)(act + 0) + (size_t)(b * S + qb * 256) * 2048 + h * 128, (const bf16*)(act + 0) + (size_t)b * S * 2048 + 1024 + gq * 128,
                                            (const bf16*)(act + 0) + (size_t)b * S * 2048 + 1536 + gq * 128, (bf16*)(act + A_O) + (size_t)(b * S + qb * 256) * D + h * 128, S / 64, qb * 256, 0, 0.f, 0.f, INP(I_AX_Q_GAIN), 0, F.lds); } SEAM(k); } ++k;
        }
        if (IN_(k)) REP_LOOP(k) { REFRESH(); __syncthreads(); pg8::Gemm g{(const bf16*)(act + A_O), WT + WT_WO + (size_t)l * D * D, 1024, 1024}; pg8::StaticOrder So; So.init(T, D, G, cid);
            pg8::EpiResid E{XA, XB, ss_ffn}; pg8::gemm_phase(F.lds, g, So, E); SEAM(k); } ++k;
        if ((l & 1) == 0) {
            if (IN_(k)) REP_LOOP(k) { REFRESH(); pg8::Gemm g{XB, WT + WT_FGU + (size_t)f * 5632 * 1024, 1024, 1024}; pg8::StaticOrder So; So.init(T, 5632, G, cid);
                pg8::EpiSwiglu E{(bf16*)(act + A_HID), FF, 22, ss_ffn, nullptr, (LAS float*)(F.lds + RING_BYTES + 4096)}; pg8::gemm_phase(F.lds, g, So, E); SEAM(k); } ++k;
            if (IN_(k)) REP_LOOP(k) { REFRESH(); pg8::Gemm g{(const bf16*)(act + A_HID), WT + WT_FDN + (size_t)f * 1024 * FF, FF, FF}; pg8::StaticOrder So; So.init(T, D, G, cid);
                pg8::EpiResid E{XB, XB, ss_ple}; pg8::gemm_phase(F.lds, g, So, E); SEAM(k); } ++k;
        } else {
            unsigned* cnt = F.ctl + CW_MOECNT + f * 1024;
            if (IN_(k)) REP_LOOP(k) { REFRESH();
                moe_route(F, XB, INP(I_FFN_NORM) + l * D, INP(I_MOE_W_ROUTER) + (size_t)f * D * NE, INP(I_MOE_B_ROUTER) + f * NE, cnt, F.ctl + CW_ROUTEPUB + f * 4096, m_idx, m_wl, m_rs, m_tpos); SEAM(k); } ++k;
            if (IN_(k)) REP_LOOP(k) { REFRESH(); __syncthreads(); pg8::Gemm g{XB, WM + WM_GU, 1024, 1024}; pg8::GroupedOrder<true> So; So.init(cnt, 28, G, cid, m_idx, (LAS int*)(F.lds + RING_BYTES + 1024));
                pg8::EpiSwiglu E{(bf16*)(act + A_HID), EF, 28, nullptr, m_rs, (LAS float*)(F.lds + RING_BYTES + 4096)}; pg8::gemm_phase(F.lds, g, So, E); SEAM(k); } ++k;
            if (IN_(k)) REP_LOOP(k) { REFRESH(); pg8::Gemm g{(const bf16*)(act + A_HID), WM + WM_DN, EF, EF}; pg8::GroupedOrder<false> So; So.init(cnt, 4, G, cid, nullptr, (LAS int*)(F.lds + RING_BYTES + 1024));
                const int ntail = So.nunits % G; int nsl = 0;
                if (ntail > 0 && So.nunits > G) nsl = ntail * 14 <= G ? 14 : ntail * 7 <= G ? 7 : ntail * 4 <= G ? 4 : ntail * 2 <= G ? 2 : 0;
                if (ntail * nsl > 256) nsl = 0;
                nsl = __builtin_amdgcn_readfirstlane(nsl);
                if (nsl) { So.nlim = So.nunits - ntail;
                    { const int ksl = EF / nsl; pg8::Gemm gs{(const bf16*)(act + A_HID), WM + WM_DN, ksl, EF, EF}; pg8::SliceOrder Ss{So, So.nlim, ntail, nsl, ksl * 2, G, cid};
                      pg8::EpiPartial Ep{(float*)(ws + WS_PT)}; pg8::gemm_phase(F.lds, gs, Ss, Ep); }
                    asm volatile("s_waitcnt vmcnt(0)" ::: "memory"); __syncthreads();
                    if (threadIdx.x == 0) { __builtin_amdgcn_fence(__ATOMIC_RELEASE, "agent"); asm volatile("s_waitcnt vmcnt(0)" ::: "memory"); xb_add(cnt + 768, 1u); } }
                pg8::EpiPlain<false> E{(bf16*)(act + A_Y), D, 4, nullptr, 0.f, m_wl, nullptr, nullptr}; pg8::gemm_phase(F.lds, g, So, E);
                if (nsl) { REFRESH();
                    if (threadIdx.x == 0) { XB_SPIN(xb_ld(cnt + 768) < (unsigned)G, F.ctl + CW_BAR); __builtin_amdgcn_fence(__ATOMIC_ACQUIRE, "agent"); asm volatile("s_waitcnt vmcnt(0)" ::: "memory"); }
                    __syncthreads();
                    tail_reduce(F, So, So.nlim, ntail, nsl, (const float*)(ws + WS_PT), (bf16*)(act + A_Y), m_wl); }
                SEAM(k); } ++k;
            if (IN_(k)) REP_LOOP(k) { REFRESH(); moe_combine(F, XB, ss_ple, (const bf16*)(act + A_Y), cnt, m_tpos); SEAM(k); } ++k;
        }
        if (IN_(k)) REP_LOOP(k) { REFRESH(); { pg8::Gemm g{PB + (size_t)l * T * PLE, WT + WT_PIN + (size_t)l * 1024 * 256, 256, 256}; pg8::StaticOrder So; So.init(T, D, G, cid);
              pg8::EpiPlain<false> E{PT, D, 4, nullptr, 0.f, nullptr, nullptr, nullptr}; pg8::gemm_phase(F.lds, g, So, E); }
            { pg8::Gemm g{XB, WT + WT_PG + (size_t)l * D * D, 1024, 1024}; pg8::StaticOrder So; So.init(T, D, G, cid);
              pg8::EpiPle E{PT, XB, XA, l == DEPTH - 1 ? out : nullptr, ss_ple, ss_next}; pg8::gemm_phase(F.lds, g, So, E); } SEAM(k); } ++k;
    }
    { constexpr int l = 1;
        const int kind = l % 3, jm = l / 3, f = l >> 1;
        const ssq_t* ss_attn = SS + (size_t)(3 * l) * T; ssq_t* ss_ffn = SS + (size_t)(3 * l + 1) * T; ssq_t* ss_ple = SS + (size_t)(3 * l + 2) * T; ssq_t* ss_next = l < 3 ? SS + (size_t)(3 * l + 3) * T : nullptr;
        if (kind == 0) {
            if (IN_(k)) REP_LOOP(k) { REFRESH(); pg8::Gemm g{XA, WT + WT_DOWN + (size_t)jm * 512 * 1024, 1024, 1024}; pg8::StaticOrder So; So.init(T, 512, G, cid);
                pg8::EpiPlain<true> E{(bf16*)(act + A_C), 512, 2, ss_attn, 1.0f / D, nullptr, SSC + (size_t)jm * T, SSC + (size_t)(2 + jm) * T};
                pg8::gemm_phase(F.lds, g, So, E); SEAM(k); } ++k;
            if (IN_(k)) REP_LOOP(k) { REFRESH(); { pg8::Gemm g{(const bf16*)(act + A_C), WT + WT_UQ + (size_t)jm * 1536 * 256, 256, 512}; pg8::StaticOrder So; So.init(T, 1536, G, cid);
                  pg8::EpiPlain<false> E{(bf16*)(act + A_QR), 1536, 6, SSC + (size_t)jm * T, 1.0f / 256, nullptr, nullptr, nullptr}; pg8::gemm_phase(F.lds, g, So, E); }
                { int k128_ = 128; asm volatile("" : "+s"(k128_));     pg8::Gemm g{(const bf16*)(act + A_C) + 256, WT + WT_UKV + (size_t)jm * 2560 * 256, k128_, 512}; pg8::StaticOrder So; So.init(T, 2048, G, cid);
                  pg8::EpiKN<true> E{(bf16*)(act + A_KV), 2560, 0, 4, 512, SSC + (size_t)(2 + jm) * T, 1.0f / 128, INP(I_MLA_K_GAIN) + jm * 96, (const bf16*)(act + A_C), (LAS float*)(F.lds + RING_BYTES + 4096)}; pg8::gemm_phase(F.lds, g, So, E); }
                SEAM(k); } ++k;
            if (IN_(k)) REP_LOOP(k) { REFRESH(); int it_ = 0; const int nit_ = (NB * 16 * 8 - vcu + G - 1) / G; const int stag_ = ((cid >> 3) & 7) % (nit_ > 0 ? nit_ : 1); constexpr int fc_ = l == 0 ? 0 : 1, lc_ = l == 0 ? 1 : 3;
                for (int u = vcu; u < NB * 16 * 8; u += G, ++it_) { const int qb = u & 7, h = (u >> 3) & 15, b = u >> 7;
                    if (it_ == stag_) {
                        __syncthreads();
                        REFRESH();
                        moe_cvt_all(F, INP(I_MOE_W_GATE) + (size_t)fc_ * NE * D * EF, INP(I_MOE_W_UP) + (size_t)fc_ * NE * D * EF, INP(I_MOE_W_DOWN) + (size_t)fc_ * NE * EF * D, INP(I_FFN_NORM) + lc_ * D, WM);
                        if (l == 0) { LATE_WEIGHTS(); cvt_flat(F, INP(I_P), PB, (size_t)4 * T * PLE / 8); }
                        __syncthreads(); }
                    fa::attn_unit<96, 64, 0, 0, 1536, 2560, 2560, D, 2>((const bf16*)(act + A_QR) + (size_t)(b * S + qb * 256) * 1536 + h * 96, (const bf16*)(act + A_KV) + (size_t)b * S * 2560 + h * 64,
                                          (const bf16*)(act + A_KV) + (size_t)b * S * 2560 + 1536 + h * 64, (bf16*)(act + A_O) + (size_t)(b * S + qb * 256) * D + h * 64, S / 64, qb * 256, 0, 0.f, 0.f, INP(I_MLA_Q_GAIN) + jm * 96, 1024 - 32 * h, F.lds); } SEAM(k); } ++k;
        } else if (kind == 1) {
            if (IN_(k)) REP_LOOP(k) { REFRESH(); pg8::Gemm g{XA, WT + WT_SQKV, 1024, 1024}; pg8::StaticOrder So; So.init(T, 1536, G, cid);
                pg8::EpiKN<false> E{(bf16*)(act + 0), 1536, 4, 5, 0, ss_attn, 1.0f / D, INP(I_SWA_K_GAIN), nullptr, (LAS float*)(F.lds + RING_BYTES + 4096)}; pg8::gemm_phase(F.lds, g, So, E); SEAM(k); } ++k;
            if (IN_(k)) REP_LOOP(k) { REFRESH(); for (int u = vcu; u < NB * 16 * 8; u += G) { const int qb = u & 7, h = (u >> 3) & 15, b = u >> 7; const int gq = h >> 2;
                    const float slope2 = exp2f(-8.0f * (float)(h + 1) / 16.0f) * LOG2E, sink2 = INP(I_SWA_SINK)[h] * LOG2E;
                    const int q0 = qb * 256, klo = q0 - 128 < 0 ? 0 : q0 - 128, khi = q0 + 384 > S ? S : q0 + 384;
                    fa::attn_unit<64, 64, 1, 1, 1536, 1536, 1536, D, 2>((const bf16*)(act + 0) + (size_t)(b * S + q0) * 1536 + h * 64, (const bf16*)(act + 0) + (size_t)(b * S + klo) * 1536 + 1024 + gq * 64,
                                          (const bf16*)(act + 0) + (size_t)(b * S + klo) * 1536 + 1280 + gq * 64, (bf16*)(act + A_O) + (size_t)(b * S + q0) * D + h * 64, (khi - klo) / 64, q0, klo, slope2, sink2, INP(I_SWA_Q_GAIN), 0, F.lds); } SEAM(k); } ++k;
        } else {
            if (IN_(k)) REP_LOOP(k) { REFRESH(); pg8::Gemm g{XA, WT + WT_AQKV, 1024, 1024}; pg8::StaticOrder So; So.init(T, 2048, G, cid);
                pg8::EpiPlain<false> E{(bf16*)(act + 0), 2048, 8, ss_attn, 1.0f / D, nullptr, nullptr, nullptr}; pg8::gemm_phase(F.lds, g, So, E); SEAM(k); } ++k;
            if (IN_(k)) REP_LOOP(k) { REFRESH(); ax_kprep(F, (bf16*)(act + 0), INP(I_AX_K_GAIN)); SEAM(k); } ++k;
            if (IN_(k)) REP_LOOP(k) { REFRESH(); for (int u = vcu; u < NB * 8 * 8; u += G) { const int qb = u & 7, h = (u >> 3) & 7, b = u >> 6; const int gq = h >> 1;
                    fa::attn_unit<128, 128, 0, 2, 2048, 2048, 2048, D, 1>((const bf16*)(act + 0) + (size_t)(b * S + qb * 256) * 2048 + h * 128, (const bf16*)(act + 0) + (size_t)b * S * 2048 + 1024 + gq * 128,
                                            (const bf16*)(act + 0) + (size_t)b * S * 2048 + 1536 + gq * 128, (bf16*)(act + A_O) + (size_t)(b * S + qb * 256) * D + h * 128, S / 64, qb * 256, 0, 0.f, 0.f, INP(I_AX_Q_GAIN), 0, F.lds); } SEAM(k); } ++k;
        }
        if (IN_(k)) REP_LOOP(k) { REFRESH(); __syncthreads(); pg8::Gemm g{(const bf16*)(act + A_O), WT + WT_WO + (size_t)l * D * D, 1024, 1024}; pg8::StaticOrder So; So.init(T, D, G, cid);
            pg8::EpiResid E{XA, XB, ss_ffn}; pg8::gemm_phase(F.lds, g, So, E); SEAM(k); } ++k;
        if ((l & 1) == 0) {
            if (IN_(k)) REP_LOOP(k) { REFRESH(); pg8::Gemm g{XB, WT + WT_FGU + (size_t)f * 5632 * 1024, 1024, 1024}; pg8::StaticOrder So; So.init(T, 5632, G, cid);
                pg8::EpiSwiglu E{(bf16*)(act + A_HID), FF, 22, ss_ffn, nullptr, (LAS float*)(F.lds + RING_BYTES + 4096)}; pg8::gemm_phase(F.lds, g, So, E); SEAM(k); } ++k;
            if (IN_(k)) REP_LOOP(k) { REFRESH(); pg8::Gemm g{(const bf16*)(act + A_HID), WT + WT_FDN + (size_t)f * 1024 * FF, FF, FF}; pg8::StaticOrder So; So.init(T, D, G, cid);
                pg8::EpiResid E{XB, XB, ss_ple}; pg8::gemm_phase(F.lds, g, So, E); SEAM(k); } ++k;
        } else {
            unsigned* cnt = F.ctl + CW_MOECNT + f * 1024;
            if (IN_(k)) REP_LOOP(k) { REFRESH();
                moe_route(F, XB, INP(I_FFN_NORM) + l * D, INP(I_MOE_W_ROUTER) + (size_t)f * D * NE, INP(I_MOE_B_ROUTER) + f * NE, cnt, F.ctl + CW_ROUTEPUB + f * 4096, m_idx, m_wl, m_rs, m_tpos); SEAM(k); } ++k;
            if (IN_(k)) REP_LOOP(k) { REFRESH(); __syncthreads(); pg8::Gemm g{XB, WM + WM_GU, 1024, 1024}; pg8::GroupedOrder<true> So; So.init(cnt, 28, G, cid, m_idx, (LAS int*)(F.lds + RING_BYTES + 1024));
                pg8::EpiSwiglu E{(bf16*)(act + A_HID), EF, 28, nullptr, m_rs, (LAS float*)(F.lds + RING_BYTES + 4096)}; pg8::gemm_phase(F.lds, g, So, E); SEAM(k); } ++k;
            if (IN_(k)) REP_LOOP(k) { REFRESH(); pg8::Gemm g{(const bf16*)(act + A_HID), WM + WM_DN, EF, EF}; pg8::GroupedOrder<false> So; So.init(cnt, 4, G, cid, nullptr, (LAS int*)(F.lds + RING_BYTES + 1024));
                const int ntail = So.nunits % G; int nsl = 0;
                if (ntail > 0 && So.nunits > G) nsl = ntail * 14 <= G ? 14 : ntail * 7 <= G ? 7 : ntail * 4 <= G ? 4 : ntail * 2 <= G ? 2 : 0;
                if (ntail * nsl > 256) nsl = 0;
                nsl = __builtin_amdgcn_readfirstlane(nsl);
                if (nsl) { So.nlim = So.nunits - ntail;
                    { const int ksl = EF / nsl; pg8::Gemm gs{(const bf16*)(act + A_HID), WM + WM_DN, ksl, EF, EF}; pg8::SliceOrder Ss{So, So.nlim, ntail, nsl, ksl * 2, G, cid};
                      pg8::EpiPartial Ep{(float*)(ws + WS_PT)}; pg8::gemm_phase(F.lds, gs, Ss, Ep); }
                    asm volatile("s_waitcnt vmcnt(0)" ::: "memory"); __syncthreads();
                    if (threadIdx.x == 0) { __builtin_amdgcn_fence(__ATOMIC_RELEASE, "agent"); asm volatile("s_waitcnt vmcnt(0)" ::: "memory"); xb_add(cnt + 768, 1u); } }
                pg8::EpiPlain<false> E{(bf16*)(act + A_Y), D, 4, nullptr, 0.f, m_wl, nullptr, nullptr}; pg8::gemm_phase(F.lds, g, So, E);
                if (nsl) { REFRESH();
                    if (threadIdx.x == 0) { XB_SPIN(xb_ld(cnt + 768) < (unsigned)G, F.ctl + CW_BAR); __builtin_amdgcn_fence(__ATOMIC_ACQUIRE, "agent"); asm volatile("s_waitcnt vmcnt(0)" ::: "memory"); }
                    __syncthreads();
                    tail_reduce(F, So, So.nlim, ntail, nsl, (const float*)(ws + WS_PT), (bf16*)(act + A_Y), m_wl); }
                SEAM(k); } ++k;
            if (IN_(k)) REP_LOOP(k) { REFRESH(); moe_combine(F, XB, ss_ple, (const bf16*)(act + A_Y), cnt, m_tpos); SEAM(k); } ++k;
        }
        if (IN_(k)) REP_LOOP(k) { REFRESH(); { pg8::Gemm g{PB + (size_t)l * T * PLE, WT + WT_PIN + (size_t)l * 1024 * 256, 256, 256}; pg8::StaticOrder So; So.init(T, D, G, cid);
              pg8::EpiPlain<false> E{PT, D, 4, nullptr, 0.f, nullptr, nullptr, nullptr}; pg8::gemm_phase(F.lds, g, So, E); }
            { pg8::Gemm g{XB, WT + WT_PG + (size_t)l * D * D, 1024, 1024}; pg8::StaticOrder So; So.init(T, D, G, cid);
              pg8::EpiPle E{PT, XB, XA, l == DEPTH - 1 ? out : nullptr, ss_ple, ss_next}; pg8::gemm_phase(F.lds, g, So, E); } SEAM(k); } ++k;
    }
    { constexpr int l = 2;
        const int kind = l % 3, jm = l / 3, f = l >> 1;
        const ssq_t* ss_attn = SS + (size_t)(3 * l) * T; ssq_t* ss_ffn = SS + (size_t)(3 * l + 1) * T; ssq_t* ss_ple = SS + (size_t)(3 * l + 2) * T; ssq_t* ss_next = l < 3 ? SS + (size_t)(3 * l + 3) * T : nullptr;
        if (kind == 0) {
            if (IN_(k)) REP_LOOP(k) { REFRESH(); pg8::Gemm g{XA, WT + WT_DOWN + (size_t)jm * 512 * 1024, 1024, 1024}; pg8::StaticOrder So; So.init(T, 512, G, cid);
                pg8::EpiPlain<true> E{(bf16*)(act + A_C), 512, 2, ss_attn, 1.0f / D, nullptr, SSC + (size_t)jm * T, SSC + (size_t)(2 + jm) * T};
                pg8::gemm_phase(F.lds, g, So, E); SEAM(k); } ++k;
            if (IN_(k)) REP_LOOP(k) { REFRESH(); { pg8::Gemm g{(const bf16*)(act + A_C), WT + WT_UQ + (size_t)jm * 1536 * 256, 256, 512}; pg8::StaticOrder So; So.init(T, 1536, G, cid);
                  pg8::EpiPlain<false> E{(bf16*)(act + A_QR), 1536, 6, SSC + (size_t)jm * T, 1.0f / 256, nullptr, nullptr, nullptr}; pg8::gemm_phase(F.lds, g, So, E); }
                { int k128_ = 128; asm volatile("" : "+s"(k128_));     pg8::Gemm g{(const bf16*)(act + A_C) + 256, WT + WT_UKV + (size_t)jm * 2560 * 256, k128_, 512}; pg8::StaticOrder So; So.init(T, 2048, G, cid);
                  pg8::EpiKN<true> E{(bf16*)(act + A_KV), 2560, 0, 4, 512, SSC + (size_t)(2 + jm) * T, 1.0f / 128, INP(I_MLA_K_GAIN) + jm * 96, (const bf16*)(act + A_C), (LAS float*)(F.lds + RING_BYTES + 4096)}; pg8::gemm_phase(F.lds, g, So, E); }
                SEAM(k); } ++k;
            if (IN_(k)) REP_LOOP(k) { REFRESH(); int it_ = 0; const int nit_ = (NB * 16 * 8 - vcu + G - 1) / G; const int stag_ = ((cid >> 3) & 7) % (nit_ > 0 ? nit_ : 1); constexpr int fc_ = l == 0 ? 0 : 1, lc_ = l == 0 ? 1 : 3;
                for (int u = vcu; u < NB * 16 * 8; u += G, ++it_) { const int qb = u & 7, h = (u >> 3) & 15, b = u >> 7;
                    if (it_ == stag_) {
                        __syncthreads();
                        REFRESH();
                        moe_cvt_all(F, INP(I_MOE_W_GATE) + (size_t)fc_ * NE * D * EF, INP(I_MOE_W_UP) + (size_t)fc_ * NE * D * EF, INP(I_MOE_W_DOWN) + (size_t)fc_ * NE * EF * D, INP(I_FFN_NORM) + lc_ * D, WM);
                        if (l == 0) { LATE_WEIGHTS(); cvt_flat(F, INP(I_P), PB, (size_t)4 * T * PLE / 8); }
                        __syncthreads(); }
                    fa::attn_unit<96, 64, 0, 0, 1536, 2560, 2560, D, 2>((const bf16*)(act + A_QR) + (size_t)(b * S + qb * 256) * 1536 + h * 96, (const bf16*)(act + A_KV) + (size_t)b * S * 2560 + h * 64,
                                          (const bf16*)(act + A_KV) + (size_t)b * S * 2560 + 1536 + h * 64, (bf16*)(act + A_O) + (size_t)(b * S + qb * 256) * D + h * 64, S / 64, qb * 256, 0, 0.f, 0.f, INP(I_MLA_Q_GAIN) + jm * 96, 1024 - 32 * h, F.lds); } SEAM(k); } ++k;
        } else if (kind == 1) {
            if (IN_(k)) REP_LOOP(k) { REFRESH(); pg8::Gemm g{XA, WT + WT_SQKV, 1024, 1024}; pg8::StaticOrder So; So.init(T, 1536, G, cid);
                pg8::EpiKN<false> E{(bf16*)(act + 0), 1536, 4, 5, 0, ss_attn, 1.0f / D, INP(I_SWA_K_GAIN), nullptr, (LAS float*)(F.lds + RING_BYTES + 4096)}; pg8::gemm_phase(F.lds, g, So, E); SEAM(k); } ++k;
            if (IN_(k)) REP_LOOP(k) { REFRESH(); for (int u = vcu; u < NB * 16 * 8; u += G) { const int qb = u & 7, h = (u >> 3) & 15, b = u >> 7; const int gq = h >> 2;
                    const float slope2 = exp2f(-8.0f * (float)(h + 1) / 16.0f) * LOG2E, sink2 = INP(I_SWA_SINK)[h] * LOG2E;
                    const int q0 = qb * 256, klo = q0 - 128 < 0 ? 0 : q0 - 128, khi = q0 + 384 > S ? S : q0 + 384;
                    fa::attn_unit<64, 64, 1, 1, 1536, 1536, 1536, D, 2>((const bf16*)(act + 0) + (size_t)(b * S + q0) * 1536 + h * 64, (const bf16*)(act + 0) + (size_t)(b * S + klo) * 1536 + 1024 + gq * 64,
                                          (const bf16*)(act + 0) + (size_t)(b * S + klo) * 1536 + 1280 + gq * 64, (bf16*)(act + A_O) + (size_t)(b * S + q0) * D + h * 64, (khi - klo) / 64, q0, klo, slope2, sink2, INP(I_SWA_Q_GAIN), 0, F.lds); } SEAM(k); } ++k;
        } else {
            if (IN_(k)) REP_LOOP(k) { REFRESH(); pg8::Gemm g{XA, WT + WT_AQKV, 1024, 1024}; pg8::StaticOrder So; So.init(T, 2048, G, cid);
                pg8::EpiPlain<false> E{(bf16*)(act + 0), 2048, 8, ss_attn, 1.0f / D, nullptr, nullptr, nullptr}; pg8::gemm_phase(F.lds, g, So, E); SEAM(k); } ++k;
            if (IN_(k)) REP_LOOP(k) { REFRESH(); ax_kprep(F, (bf16*)(act + 0), INP(I_AX_K_GAIN)); SEAM(k); } ++k;
            if (IN_(k)) REP_LOOP(k) { REFRESH(); for (int u = vcu; u < NB * 8 * 8; u += G) { const int qb = u & 7, h = (u >> 3) & 7, b = u >> 6; const int gq = h >> 1;
                    fa::attn_unit<128, 128, 0, 2, 2048, 2048, 2048, D, 1>((const bf16*)(act + 0) + (size_t)(b * S + qb * 256) * 2048 + h * 128, (const bf16*)(act + 0) + (size_t)b * S * 2048 + 1024 + gq * 128,
                                            (const bf16*)(act + 0) + (size_t)b * S * 2048 + 1536 + gq * 128, (bf16*)(act + A_O) + (size_t)(b * S + qb * 256) * D + h * 128, S / 64, qb * 256, 0, 0.f, 0.f, INP(I_AX_Q_GAIN), 0, F.lds); } SEAM(k); } ++k;
        }
        if (IN_(k)) REP_LOOP(k) { REFRESH(); __syncthreads(); pg8::Gemm g{(const bf16*)(act + A_O), WT + WT_WO + (size_t)l * D * D, 1024, 1024}; pg8::StaticOrder So; So.init(T, D, G, cid);
            pg8::EpiResid E{XA, XB, ss_ffn}; pg8::gemm_phase(F.lds, g, So, E); SEAM(k); } ++k;
        if ((l & 1) == 0) {
            if (IN_(k)) REP_LOOP(k) { REFRESH(); pg8::Gemm g{XB, WT + WT_FGU + (size_t)f * 5632 * 1024, 1024, 1024}; pg8::StaticOrder So; So.init(T, 5632, G, cid);
                pg8::EpiSwiglu E{(bf16*)(act + A_HID), FF, 22, ss_ffn, nullptr, (LAS float*)(F.lds + RING_BYTES + 4096)}; pg8::gemm_phase(F.lds, g, So, E); SEAM(k); } ++k;
            if (IN_(k)) REP_LOOP(k) { REFRESH(); pg8::Gemm g{(const bf16*)(act + A_HID), WT + WT_FDN + (size_t)f * 1024 * FF, FF, FF}; pg8::StaticOrder So; So.init(T, D, G, cid);
                pg8::EpiResid E{XB, XB, ss_ple}; pg8::gemm_phase(F.lds, g, So, E); SEAM(k); } ++k;
        } else {
            unsigned* cnt = F.ctl + CW_MOECNT + f * 1024;
            if (IN_(k)) REP_LOOP(k) { REFRESH();
                moe_route(F, XB, INP(I_FFN_NORM) + l * D, INP(I_MOE_W_ROUTER) + (size_t)f * D * NE, INP(I_MOE_B_ROUTER) + f * NE, cnt, F.ctl + CW_ROUTEPUB + f * 4096, m_idx, m_wl, m_rs, m_tpos); SEAM(k); } ++k;
            if (IN_(k)) REP_LOOP(k) { REFRESH(); __syncthreads(); pg8::Gemm g{XB, WM + WM_GU, 1024, 1024}; pg8::GroupedOrder<true> So; So.init(cnt, 28, G, cid, m_idx, (LAS int*)(F.lds + RING_BYTES + 1024));
                pg8::EpiSwiglu E{(bf16*)(act + A_HID), EF, 28, nullptr, m_rs, (LAS float*)(F.lds + RING_BYTES + 4096)}; pg8::gemm_phase(F.lds, g, So, E); SEAM(k); } ++k;
            if (IN_(k)) REP_LOOP(k) { REFRESH(); pg8::Gemm g{(const bf16*)(act + A_HID), WM + WM_DN, EF, EF}; pg8::GroupedOrder<false> So; So.init(cnt, 4, G, cid, nullptr, (LAS int*)(F.lds + RING_BYTES + 1024));
                const int ntail = So.nunits % G; int nsl = 0;
                if (ntail > 0 && So.nunits > G) nsl = ntail * 14 <= G ? 14 : ntail * 7 <= G ? 7 : ntail * 4 <= G ? 4 : ntail * 2 <= G ? 2 : 0;
                if (ntail * nsl > 256) nsl = 0;
                nsl = __builtin_amdgcn_readfirstlane(nsl);
                if (nsl) { So.nlim = So.nunits - ntail;
                    { const int ksl = EF / nsl; pg8::Gemm gs{(const bf16*)(act + A_HID), WM + WM_DN, ksl, EF, EF}; pg8::SliceOrder Ss{So, So.nlim, ntail, nsl, ksl * 2, G, cid};
                      pg8::EpiPartial Ep{(float*)(ws + WS_PT)}; pg8::gemm_phase(F.lds, gs, Ss, Ep); }
                    asm volatile("s_waitcnt vmcnt(0)" ::: "memory"); __syncthreads();
                    if (threadIdx.x == 0) { __builtin_amdgcn_fence(__ATOMIC_RELEASE, "agent"); asm volatile("s_waitcnt vmcnt(0)" ::: "memory"); xb_add(cnt + 768, 1u); } }
                pg8::EpiPlain<false> E{(bf16*)(act + A_Y), D, 4, nullptr, 0.f, m_wl, nullptr, nullptr}; pg8::gemm_phase(F.lds, g, So, E);
                if (nsl) { REFRESH();
                    if (threadIdx.x == 0) { XB_SPIN(xb_ld(cnt + 768) < (unsigned)G, F.ctl + CW_BAR); __builtin_amdgcn_fence(__ATOMIC_ACQUIRE, "agent"); asm volatile("s_waitcnt vmcnt(0)" ::: "memory"); }
                    __syncthreads();
                    tail_reduce(F, So, So.nlim, ntail, nsl, (const float*)(ws + WS_PT), (bf16*)(act + A_Y), m_wl); }
                SEAM(k); } ++k;
            if (IN_(k)) REP_LOOP(k) { REFRESH(); moe_combine(F, XB, ss_ple, (const bf16*)(act + A_Y), cnt, m_tpos); SEAM(k); } ++k;
        }
        if (IN_(k)) REP_LOOP(k) { REFRESH(); { pg8::Gemm g{PB + (size_t)l * T * PLE, WT + WT_PIN + (size_t)l * 1024 * 256, 256, 256}; pg8::StaticOrder So; So.init(T, D, G, cid);
              pg8::EpiPlain<false> E{PT, D, 4, nullptr, 0.f, nullptr, nullptr, nullptr}; pg8::gemm_phase(F.lds, g, So, E); }
            { pg8::Gemm g{XB, WT + WT_PG + (size_t)l * D * D, 1024, 1024}; pg8::StaticOrder So; So.init(T, D, G, cid);
              pg8::EpiPle E{PT, XB, XA, l == DEPTH - 1 ? out : nullptr, ss_ple, ss_next}; pg8::gemm_phase(F.lds, g, So, E); } SEAM(k); } ++k;
    }
    { constexpr int l = 3;
        const int kind = l % 3, jm = l / 3, f = l >> 1;
        const ssq_t* ss_attn = SS + (size_t)(3 * l) * T; ssq_t* ss_ffn = SS + (size_t)(3 * l + 1) * T; ssq_t* ss_ple = SS + (size_t)(3 * l + 2) * T; ssq_t* ss_next = l < 3 ? SS + (size_t)(3 * l + 3) * T : nullptr;
        if (kind == 0) {
            if (IN_(k)) REP_LOOP(k) { REFRESH(); pg8::Gemm g{XA, WT + WT_DOWN + (size_t)jm * 512 * 1024, 1024, 1024}; pg8::StaticOrder So; So.init(T, 512, G, cid);
                pg8::EpiPlain<true> E{(bf16*)(act + A_C), 512, 2, ss_attn, 1.0f / D, nullptr, SSC + (size_t)jm * T, SSC + (size_t)(2 + jm) * T};
                pg8::gemm_phase(F.lds, g, So, E); SEAM(k); } ++k;
            if (IN_(k)) REP_LOOP(k) { REFRESH(); { pg8::Gemm g{(const bf16*)(act + A_C), WT + WT_UQ + (size_t)jm * 1536 * 256, 256, 512}; pg8::StaticOrder So; So.init(T, 1536, G, cid);
                  pg8::EpiPlain<false> E{(bf16*)(act + A_QR), 1536, 6, SSC + (size_t)jm * T, 1.0f / 256, nullptr, nullptr, nullptr}; pg8::gemm_phase(F.lds, g, So, E); }
                { int k128_ = 128; asm volatile("" : "+s"(k128_));     pg8::Gemm g{(const bf16*)(act + A_C) + 256, WT + WT_UKV + (size_t)jm * 2560 * 256, k128_, 512}; pg8::StaticOrder So; So.init(T, 2048, G, cid);
                  pg8::EpiKN<true> E{(bf16*)(act + A_KV), 2560, 0, 4, 512, SSC + (size_t)(2 + jm) * T, 1.0f / 128, INP(I_MLA_K_GAIN) + jm * 96, (const bf16*)(act + A_C), (LAS float*)(F.lds + RING_BYTES + 4096)}; pg8::gemm_phase(F.lds, g, So, E); }
                SEAM(k); } ++k;
            if (IN_(k)) REP_LOOP(k) { REFRESH(); int it_ = 0; const int nit_ = (NB * 16 * 8 - vcu + G - 1) / G; const int stag_ = ((cid >> 3) & 7) % (nit_ > 0 ? nit_ : 1); constexpr int fc_ = l == 0 ? 0 : 1, lc_ = l == 0 ? 1 : 3;
                for (int u = vcu; u < NB * 16 * 8; u += G, ++it_) { const int qb = u & 7, h = (u >> 3) & 15, b = u >> 7;
                    if (it_ == stag_) {
                        __syncthreads();
                        REFRESH();
                        moe_cvt_all(F, INP(I_MOE_W_GATE) + (size_t)fc_ * NE * D * EF, INP(I_MOE_W_UP) + (size_t)fc_ * NE * D * EF, INP(I_MOE_W_DOWN) + (size_t)fc_ * NE * EF * D, INP(I_FFN_NORM) + lc_ * D, WM);
                        if (l == 0) { LATE_WEIGHTS(); cvt_flat(F, INP(I_P), PB, (size_t)4 * T * PLE / 8); }
                        __syncthreads(); }
                    fa::attn_unit<96, 64, 0, 0, 1536, 2560, 2560, D, 2>((const bf16*)(act + A_QR) + (size_t)(b * S + qb * 256) * 1536 + h * 96, (const bf16*)(act + A_KV) + (size_t)b * S * 2560 + h * 64,
                                          (const bf16*)(act + A_KV) + (size_t)b * S * 2560 + 1536 + h * 64, (bf16*)(act + A_O) + (size_t)(b * S + qb * 256) * D + h * 64, S / 64, qb * 256, 0, 0.f, 0.f, INP(I_MLA_Q_GAIN) + jm * 96, 1024 - 32 * h, F.lds); } SEAM(k); } ++k;
        } else if (kind == 1) {
            if (IN_(k)) REP_LOOP(k) { REFRESH(); pg8::Gemm g{XA, WT + WT_SQKV, 1024, 1024}; pg8::StaticOrder So; So.init(T, 1536, G, cid);
                pg8::EpiKN<false> E{(bf16*)(act + 0), 1536, 4, 5, 0, ss_attn, 1.0f / D, INP(I_SWA_K_GAIN), nullptr, (LAS float*)(F.lds + RING_BYTES + 4096)}; pg8::gemm_phase(F.lds, g, So, E); SEAM(k); } ++k;
            if (IN_(k)) REP_LOOP(k) { REFRESH(); for (int u = vcu; u < NB * 16 * 8; u += G) { const int qb = u & 7, h = (u >> 3) & 15, b = u >> 7; const int gq = h >> 2;
                    const float slope2 = exp2f(-8.0f * (float)(h + 1) / 16.0f) * LOG2E, sink2 = INP(I_SWA_SINK)[h] * LOG2E;
                    const int q0 = qb * 256, klo = q0 - 128 < 0 ? 0 : q0 - 128, khi = q0 + 384 > S ? S : q0 + 384;
                    fa::attn_unit<64, 64, 1, 1, 1536, 1536, 1536, D, 2>((const bf16*)(act + 0) + (size_t)(b * S + q0) * 1536 + h * 64, (const bf16*)(act + 0) + (size_t)(b * S + klo) * 1536 + 1024 + gq * 64,
                                          (const bf16*)(act + 0) + (size_t)(b * S + klo) * 1536 + 1280 + gq * 64, (bf16*)(act + A_O) + (size_t)(b * S + q0) * D + h * 64, (khi - klo) / 64, q0, klo, slope2, sink2, INP(I_SWA_Q_GAIN), 0, F.lds); } SEAM(k); } ++k;
        } else {
            if (IN_(k)) REP_LOOP(k) { REFRESH(); pg8::Gemm g{XA, WT + WT_AQKV, 1024, 1024}; pg8::StaticOrder So; So.init(T, 2048, G, cid);
                pg8::EpiPlain<false> E{(bf16*)(act + 0), 2048, 8, ss_attn, 1.0f / D, nullptr, nullptr, nullptr}; pg8::gemm_phase(F.lds, g, So, E); SEAM(k); } ++k;
            if (IN_(k)) REP_LOOP(k) { REFRESH(); ax_kprep(F, (bf16*)(act + 0), INP(I_AX_K_GAIN)); SEAM(k); } ++k;
            if (IN_(k)) REP_LOOP(k) { REFRESH(); for (int u = vcu; u < NB * 8 * 8; u += G) { const int qb = u & 7, h = (u >> 3) & 7, b = u >> 6; const int gq = h >> 1;
                    fa::attn_unit<128, 128, 0, 2, 2048, 2048, 2048, D, 1>((const bf16*)(act + 0) + (size_t)(b * S + qb * 256) * 2048 + h * 128, (const bf16*)(act + 0) + (size_t)b * S * 2048 + 1024 + gq * 128,
                                            (const bf16*)(act + 0) + (size_t)b * S * 2048 + 1536 + gq * 128, (bf16*)(act + A_O) + (size_t)(b * S + qb * 256) * D + h * 128, S / 64, qb * 256, 0, 0.f, 0.f, INP(I_AX_Q_GAIN), 0, F.lds); } SEAM(k); } ++k;
        }
        if (IN_(k)) REP_LOOP(k) { REFRESH(); __syncthreads(); pg8::Gemm g{(const bf16*)(act + A_O), WT + WT_WO + (size_t)l * D * D, 1024, 1024}; pg8::StaticOrder So; So.init(T, D, G, cid);
            pg8::EpiResid E{XA, XB, ss_ffn}; pg8::gemm_phase(F.lds, g, So, E); SEAM(k); } ++k;
        if ((l & 1) == 0) {
            if (IN_(k)) REP_LOOP(k) { REFRESH(); pg8::Gemm g{XB, WT + WT_FGU + (size_t)f * 5632 * 1024, 1024, 1024}; pg8::StaticOrder So; So.init(T, 5632, G, cid);
                pg8::EpiSwiglu E{(bf16*)(act + A_HID), FF, 22, ss_ffn, nullptr, (LAS float*)(F.lds + RING_BYTES + 4096)}; pg8::gemm_phase(F.lds, g, So, E); SEAM(k); } ++k;
            if (IN_(k)) REP_LOOP(k) { REFRESH(); pg8::Gemm g{(const bf16*)(act + A_HID), WT + WT_FDN + (size_t)f * 1024 * FF, FF, FF}; pg8::StaticOrder So; So.init(T, D, G, cid);
                pg8::EpiResid E{XB, XB, ss_ple}; pg8::gemm_phase(F.lds, g, So, E); SEAM(k); } ++k;
        } else {
            unsigned* cnt = F.ctl + CW_MOECNT + f * 1024;
            if (IN_(k)) REP_LOOP(k) { REFRESH();
                moe_route(F, XB, INP(I_FFN_NORM) + l * D, INP(I_MOE_W_ROUTER) + (size_t)f * D * NE, INP(I_MOE_B_ROUTER) + f * NE, cnt, F.ctl + CW_ROUTEPUB + f * 4096, m_idx, m_wl, m_rs, m_tpos); SEAM(k); } ++k;
            if (IN_(k)) REP_LOOP(k) { REFRESH(); __syncthreads(); pg8::Gemm g{XB, WM + WM_GU, 1024, 1024}; pg8::GroupedOrder<true> So; So.init(cnt, 28, G, cid, m_idx, (LAS int*)(F.lds + RING_BYTES + 1024));
                pg8::EpiSwiglu E{(bf16*)(act + A_HID), EF, 28, nullptr, m_rs, (LAS float*)(F.lds + RING_BYTES + 4096)}; pg8::gemm_phase(F.lds, g, So, E); SEAM(k); } ++k;
            if (IN_(k)) REP_LOOP(k) { REFRESH(); pg8::Gemm g{(const bf16*)(act + A_HID), WM + WM_DN, EF, EF}; pg8::GroupedOrder<false> So; So.init(cnt, 4, G, cid, nullptr, (LAS int*)(F.lds + RING_BYTES + 1024));
                const int ntail = So.nunits % G; int nsl = 0;
                if (ntail > 0 && So.nunits > G) nsl = ntail * 14 <= G ? 14 : ntail * 7 <= G ? 7 : ntail * 4 <= G ? 4 : ntail * 2 <= G ? 2 : 0;
                if (ntail * nsl > 256) nsl = 0;
                nsl = __builtin_amdgcn_readfirstlane(nsl);
                if (nsl) { So.nlim = So.nunits - ntail;
                    { const int ksl = EF / nsl; pg8::Gemm gs{(const bf16*)(act + A_HID), WM + WM_DN, ksl, EF, EF}; pg8::SliceOrder Ss{So, So.nlim, ntail, nsl, ksl * 2, G, cid};
                      pg8::EpiPartial Ep{(float*)(ws + WS_PT)}; pg8::gemm_phase(F.lds, gs, Ss, Ep); }
                    asm volatile("s_waitcnt vmcnt(0)" ::: "memory"); __syncthreads();
                    if (threadIdx.x == 0) { __builtin_amdgcn_fence(__ATOMIC_RELEASE, "agent"); asm volatile("s_waitcnt vmcnt(0)" ::: "memory"); xb_add(cnt + 768, 1u); } }
                pg8::EpiPlain<false> E{(bf16*)(act + A_Y), D, 4, nullptr, 0.f, m_wl, nullptr, nullptr}; pg8::gemm_phase(F.lds, g, So, E);
                if (nsl) { REFRESH();
                    if (threadIdx.x == 0) { XB_SPIN(xb_ld(cnt + 768) < (unsigned)G, F.ctl + CW_BAR); __builtin_amdgcn_fence(__ATOMIC_ACQUIRE, "agent"); asm volatile("s_waitcnt vmcnt(0)" ::: "memory"); }
                    __syncthreads();
                    tail_reduce(F, So, So.nlim, ntail, nsl, (const float*)(ws + WS_PT), (bf16*)(act + A_Y), m_wl); }
                SEAM(k); } ++k;
            if (IN_(k)) REP_LOOP(k) { REFRESH(); moe_combine(F, XB, ss_ple, (const bf16*)(act + A_Y), cnt, m_tpos); SEAM(k); } ++k;
        }
        if (IN_(k)) REP_LOOP(k) { REFRESH(); { pg8::Gemm g{PB + (size_t)l * T * PLE, WT + WT_PIN + (size_t)l * 1024 * 256, 256, 256}; pg8::StaticOrder So; So.init(T, D, G, cid);
              pg8::EpiPlain<false> E{PT, D, 4, nullptr, 0.f, nullptr, nullptr, nullptr}; pg8::gemm_phase(F.lds, g, So, E); }
            { pg8::Gemm g{XB, WT + WT_PG + (size_t)l * D * D, 1024, 1024}; pg8::StaticOrder So; So.init(T, D, G, cid);
              pg8::EpiPle E{PT, XB, XA, l == DEPTH - 1 ? out : nullptr, ss_ple, ss_next}; pg8::gemm_phase(F.lds, g, So, E); } SEAM(k); } ++k;
    }
}

#undef ws
#undef out
#undef act
#undef WT
#undef WM
#undef XB
#undef PB
#undef PT
#undef XA
#undef SS
#undef SSC
#undef m_idx
#undef m_wl
#undef m_tpos
#undef m_rs
extern "C" void kernel_launch(void* const* d_in, const int* in_sizes, int n_in, void* d_out, int out_size, void* d_ws, size_t ws_size, hipStream_t stream) {
    static int grid = 0;
    if (grid == 0) {
        if (n_in != N_IN || in_sizes[0] != T * D || out_size != T * D || ws_size < WS_END) { fprintf(stderr, "kernel_launch: shape mismatch n_in %d in0 %d out %d ws %zu (need %zu)\n", n_in, n_in > 0 ? in_sizes[0] : -1, out_size, ws_size, (size_t)WS_END); grid = -1; return; }
        int dev = 0, cus = 0;
        if (hipGetDevice(&dev) != hipSuccess || hipDeviceGetAttribute(&cus, hipDeviceAttributeMultiprocessorCount, dev) != hipSuccess) { grid = -1; return; }
        if (hipFuncSetAttribute((const void*)mega, hipFuncAttributeMaxDynamicSharedMemorySize, LDS_BYTES) != hipSuccess) { fprintf(stderr, "kernel_launch: hipFuncSetAttribute failed\n"); grid = -1; return; }
        int per_cu = 0;
        if (hipOccupancyMaxActiveBlocksPerMultiprocessor(&per_cu, (const void*)mega, NTHREADS, LDS_BYTES) != hipSuccess || per_cu < 1) fprintf(stderr, "kernel_launch: occupancy query says %d\n", per_cu);
        (void)hipGetLastError();
        grid = cus;
    }
    if (grid < 0) return;
    if (hipMemsetAsync((char*)d_ws + WS_CTL, 0, CTL_ZERO_BYTES, stream) != hipSuccess) { fprintf(stderr, "kernel_launch: memset failed\n"); return; }
    Args a{};
    for (int i = 0; i < N_IN; ++i) a.in[i] = (const float*)d_in[i];
    a.out = (float*)d_out; a.ws = (unsigned char*)d_ws;
    if (MK_N_LAUNCHES == 1) { a.lo = 0; a.hi = N_STEPS; hipLaunchKernelGGL(mega, dim3(grid), dim3(NTHREADS), LDS_BYTES, stream, a); }
    else for (int s = 0; s < N_STEPS; ++s) { a.lo = s; a.hi = s + 1; hipLaunchKernelGGL(mega, dim3(grid), dim3(NTHREADS), LDS_BYTES, stream, a); }
    const hipError_t le = hipPeekAtLastError();
    if (le != hipSuccess) fprintf(stderr, "kernel_launch: launch failed: %s\n", hipGetErrorName(le));
}
```

```cpp
#include <hip/hip_runtime.h>
#include <cstdio>
#include <cstdint>

#ifndef MK_N_LAUNCHES
#define MK_N_LAUNCHES 1
#endif

#define GAS __attribute__((address_space(1)))
#define LAS __attribute__((address_space(3)))
typedef unsigned short bf16;
typedef short bf16x8 __attribute__((ext_vector_type(8)));
typedef float f32x4 __attribute__((ext_vector_type(4)));
typedef float f32x16 __attribute__((ext_vector_type(16)));
typedef unsigned u32x4 __attribute__((ext_vector_type(4)));
typedef unsigned u32x2 __attribute__((ext_vector_type(2)));
typedef float f32x2 __attribute__((ext_vector_type(2)));

constexpr int NB = 16, S = 2048, T = NB * S, D = 1024, DEPTH = 4;
constexpr int FF = 2816, EF = 3584, NE = 8, PLE = 256;
constexpr float EPS = 1e-6f, LOG2E = 1.4426950408889634f;
constexpr int NWAVES = 8, NTHREADS = 512;
constexpr int MOE_ROWS = 2 * T + NE * 256;

enum { I_X = 0, I_P, I_ATTN_NORM, I_FFN_NORM, I_PLE_NORM, I_PLE_W_IN, I_PLE_W_GATE, I_MLA_W_DOWN, I_MLA_Q_NORM, I_MLA_W_UQ, I_MLA_KV_NORM, I_MLA_W_UKV,
       I_MLA_Q_GAIN, I_MLA_K_GAIN, I_MLA_W_O, I_SWA_W_QKV, I_SWA_Q_GAIN, I_SWA_K_GAIN, I_SWA_SINK, I_SWA_W_O, I_AX_W_QKV, I_AX_Q_GAIN, I_AX_K_GAIN, I_AX_W_O,
       I_FFN_W_GATE, I_FFN_W_UP, I_FFN_W_DOWN, I_MOE_W_ROUTER, I_MOE_B_ROUTER, I_MOE_W_GATE, I_MOE_W_UP, I_MOE_W_DOWN, N_IN };

constexpr size_t MiB = 1u << 20;
constexpr size_t WS_CTL = 0, CTL_ZERO_BYTES = 8 * MiB;
constexpr size_t WS_WT = 8 * MiB;
constexpr size_t WS_WMOE = 72 * MiB;
constexpr size_t WS_XB = 240 * MiB;
constexpr size_t WS_PB = 304 * MiB;
constexpr size_t WS_MOEL = 368 * MiB;
constexpr size_t WS_ACT = 372 * MiB;
constexpr size_t WS_PT = 966 * MiB;
constexpr size_t WS_END = 1030 * MiB;
constexpr size_t A_C = 0, A_QR = 32 * MiB, A_KV = 128 * MiB, A_O = 288 * MiB;
constexpr size_t A_XA = 352 * MiB;
constexpr size_t A_HID = 0;
constexpr size_t A_Y = 462 * MiB;
static_assert((size_t)MOE_ROWS * EF * 2 <= A_Y && A_Y + (size_t)MOE_ROWS * D * 2 <= 594 * MiB, "act map");
constexpr size_t WT_DOWN = 0, WT_UQ = 1048576, WT_UKV = 1835008, WT_WO = 3145728, WT_SQKV = 7340032, WT_AQKV = 8912896, WT_FGU = 11010048, WT_FDN = 22544384,
                 WT_PIN = 28311552, WT_PG = 29360128, WT_TOTAL = 33554432;
static_assert(WT_TOTAL * 2 <= 64 * MiB, "weights");
constexpr size_t WM_GU = 0, WM_DN = (size_t)NE * 7168 * 1024;
constexpr int CW_BAR = 4096;
constexpr int CW_MOECNT = 16384;
constexpr int CW_ROUTEPUB = 32768;
constexpr size_t CTL_SS = 1 * MiB;
constexpr size_t CTL_SSC = CTL_SS + 12 * (size_t)T * 8;
static_assert(CTL_SSC + 4 * (size_t)T * 8 <= CTL_ZERO_BYTES, "ctl");
typedef unsigned long long ssq_t;

constexpr int RING_BYTES = 131072, MISC_OFF = RING_BYTES + 320, LDS_BYTES = 147456;

__device__ __forceinline__ unsigned f2bf(float f) { unsigned u = __builtin_bit_cast(unsigned, f); return (u + 0x7fffu + ((u >> 16) & 1u)) >> 16; }
__device__ __forceinline__ unsigned pk2(float lo, float hi) { return f2bf(lo) | (f2bf(hi) << 16); }
__device__ __forceinline__ unsigned hpk2(float lo, float hi) { unsigned r; asm volatile("v_cvt_pk_bf16_f32 %0, %1, %2" : "=v"(r) : "v"(lo), "v"(hi)); return r; }
__device__ __forceinline__ float bf2f(unsigned short b) { return __builtin_bit_cast(float, (unsigned)b << 16); }
__device__ __forceinline__ float bflo(unsigned w) { return __builtin_bit_cast(float, w << 16); }
__device__ __forceinline__ float bfhi(unsigned w) { return __builtin_bit_cast(float, w & 0xffff0000u); }
__device__ __forceinline__ float wave_sum(float v) {
#pragma unroll
    for (int o = 1; o < 64; o <<= 1) v += __shfl_xor(v, o);
    return v;
}
__device__ __forceinline__ float u64f(ssq_t u) { return __builtin_fmaf((float)(unsigned)(u >> 32), 4294967296.0f, (float)(unsigned)u); }
__device__ __forceinline__ ssq_t f64u(float x) { const unsigned hi = (unsigned)(x * 2.3283064365386963e-10f); const unsigned lo = (unsigned)__builtin_fmaf(-(float)hi, 4294967296.0f, x); return ((ssq_t)hi << 32) | (ssq_t)lo; }
__device__ __forceinline__ float ss_get(const ssq_t* p, int m) { return u64f(p[m]) * (1.0f / 16777216.0f); }
__device__ __forceinline__ void ss_add(ssq_t* p, int m, float q) { atomicAdd(p + m, f64u(q * 16777216.0f)); }
__device__ __forceinline__ void ss_set(ssq_t* p, int m, float q) { p[m] = f64u(q * 16777216.0f); }
__device__ __forceinline__ void fast_sincos(float ang, float& sn, float& cs) { float r = ang * 0.15915494309189535f; r = r - floorf(r); sn = __builtin_amdgcn_sinf(r); cs = __builtin_amdgcn_cosf(r); }
__device__ __forceinline__ int tid_now() { int t = threadIdx.x; asm volatile("" : "+v"(t)); return t; }
__device__ __forceinline__ int crow(int r, int hi) { return (r & 3) + 8 * (r >> 2) + 4 * hi; }
#define LDS_WAIT() asm volatile("s_waitcnt lgkmcnt(0)" ::: "memory")

#define XB_TMO      128
#define XB_XCNT(j)  (256  + 64 * (j))
#define XB_XSUB(j)  (1280 + 64 * (j))
#define XB_XGEN(j)  (2304 + 64 * (j))
#define XB_TOP      3328
#define XB_TOPGEN   3392
#define XCD_BAR_WORDS 3456
#define XB_SPIN_CAP (1u << 22)
__device__ __forceinline__ unsigned xb_ld(unsigned* p)              { return __hip_atomic_load(p, __ATOMIC_RELAXED, __HIP_MEMORY_SCOPE_AGENT); }
__device__ __forceinline__ unsigned xb_add(unsigned* p, unsigned v) { return __hip_atomic_fetch_add(p, v, __ATOMIC_RELAXED, __HIP_MEMORY_SCOPE_AGENT); }
__device__ __forceinline__ unsigned xb_xcc_id() { return (unsigned)__builtin_amdgcn_s_getreg((3 << 11) | 20) & 0xFu; }
#define XB_SPIN(cond, bar) do { unsigned _sp = 0; while (cond) { __builtin_amdgcn_s_sleep(1); \
    if ((++_sp & 255u) == 0u) { if (xb_ld(&(bar)[XB_TMO])) break; if (_sp > XB_SPIN_CAP) { atomicAdd(&(bar)[XB_TMO], 1u); break; } } } } while (0)
struct XcdBarrier { unsigned* bar; unsigned x; volatile LAS unsigned* st; };
__device__ __forceinline__ XcdBarrier xcd_barrier_post(unsigned* bar, volatile LAS unsigned* st) {
    XcdBarrier b; b.bar = bar; b.x = xb_xcc_id(); b.st = st;
    if (threadIdx.x == 0) (void)xb_add(&bar[XB_XCNT(b.x)], 1u);
    return b;
}
__device__ __forceinline__ void xcd_barrier_complete(unsigned* bar, unsigned x, unsigned& nloc, unsigned& nx) {
    const unsigned G = gridDim.x * gridDim.y * gridDim.z;
    unsigned sum, cnt, mine, sp = 0u;
    for (;;) {
        sum = 0u; cnt = 0u; mine = 0u;
#pragma unroll
        for (unsigned j = 0; j < 16; ++j) { const unsigned c = xb_ld(&bar[XB_XCNT(j)]); sum += c; cnt += (c > 0u) ? 1u : 0u; mine = (j == x) ? c : mine; }
        if (sum == G) break;
        __builtin_amdgcn_s_sleep(1);
        if ((++sp & 255u) == 0u) { if (xb_ld(&bar[XB_TMO])) break; if (sp > XB_SPIN_CAP) { atomicAdd(&bar[XB_TMO], 1u); break; } }
    }
    nloc = mine > 0u ? mine : 1u; nx = cnt > 0u ? cnt : 1u;
}
__device__ __forceinline__ void xcd_barrier(const XcdBarrier& b) {
    asm volatile("s_waitcnt vmcnt(0)" ::: "memory");
    __syncthreads();
    if (threadIdx.x == 0) {
        unsigned* bar = b.bar;
        __builtin_amdgcn_s_waitcnt(0);
        unsigned nloc = b.st[0], nx = b.st[1];
        if (nloc == 0u) { xcd_barrier_complete(bar, b.x, nloc, nx); b.st[0] = nloc; b.st[1] = nx; }
        const unsigned old = xb_add(&bar[XB_XSUB(b.x)], 1u);
        const unsigned gen = old / nloc;
        if (old + 1u == (gen + 1u) * nloc) {
            __builtin_amdgcn_fence(__ATOMIC_RELEASE, "agent");
            asm volatile("s_waitcnt vmcnt(0)" ::: "memory");
            const unsigned og = xb_add(&bar[XB_TOP], 1u);
            const unsigned tg = og / nx;
            if (og + 1u == (tg + 1u) * nx) xb_add(&bar[XB_TOPGEN], 1u);
            else XB_SPIN(xb_ld(&bar[XB_TOPGEN]) == tg, bar);
            __builtin_amdgcn_fence(__ATOMIC_ACQUIRE, "agent");
            xb_add(&bar[XB_XGEN(b.x)], 1u);
            asm volatile("s_waitcnt vmcnt(0)" ::: "memory");
        } else {
            XB_SPIN(xb_ld(&bar[XB_XGEN(b.x)]) == gen, bar);
            __builtin_amdgcn_fence(__ATOMIC_ACQUIRE, "agent");
            asm volatile("s_waitcnt vmcnt(0)" ::: "memory");
        }
    }
    __syncthreads();
}

struct Args { const float* in[N_IN]; float* out; unsigned char* ws; int lo, hi; };
struct Frame {
    LAS unsigned char* lds; unsigned* ctl;
    int tid, lane, wave, gw, ngw;
};

__device__ __forceinline__ const float* cvt_src(int mode, int n0, const float* W, const float* W2, int nsrc) {
    if (mode == 0) return n0 < nsrc ? W + n0 : nullptr;
    if (mode == 1) { if (n0 < 1024) return W + (n0 >> 6) * 128 + (n0 & 63); const int n = n0 - 1024; return W + (n >> 6) * 128 + 64 + (n & 63); }
    const int tile = n0 / 256, w = n0 % 256; return w < 128 ? W + tile * 128 + w : W2 + tile * 128 + (w - 128);
}
__device__ __forceinline__ void cvt_load64(f32x4 (&v)[16], const float* s0, const float* s1, int ldw, int k0, int lane) {
    const int nl = lane & 15, kq = lane >> 4;
    const float* sp = (nl >> 3) ? s1 : s0;
    if (sp) { sp += (size_t)k0 * ldw + 4 * (nl & 7);
#pragma unroll
        for (int i = 0; i < 16; ++i) v[i] = __builtin_nontemporal_load((const f32x4*)(sp + (size_t)(8 * (i >> 1) + 2 * kq + (i & 1)) * ldw)); }
    else {
#pragma unroll
        for (int i = 0; i < 16; ++i) v[i] = (f32x4){0.f, 0.f, 0.f, 0.f}; }
}
__device__ __forceinline__ void cvt_finish64(const f32x4 (&v)[16], const float* gain, bf16* WT, int ldk, int dstrow0, int k0, LAS unsigned* scr, int lane) {
    const int nl = lane & 15, kq = lane >> 4;
    float g[16];
    if (gain) {
#pragma unroll
        for (int p = 0; p < 8; ++p) { const f32x2 gg = *(const f32x2*)(gain + k0 + 8 * p + 2 * kq); g[2 * p] = gg.x; g[2 * p + 1] = gg.y; } }
    else {
#pragma unroll
        for (int p = 0; p < 16; ++p) g[p] = 1.f; }
#pragma unroll
    for (int p = 0; p < 8; ++p) {
#pragma unroll
        for (int j = 0; j < 4; ++j) scr[(4 * nl + j) * 34 + 4 * p + kq] = hpk2(v[2 * p][j] * g[2 * p], v[2 * p + 1][j] * g[2 * p + 1]); }
    LDS_WAIT(); asm volatile("" ::: "memory");
    const int c = lane & 7;
#pragma unroll
    for (int r = 0; r < 8; ++r) { const int n = (lane >> 3) + 8 * r; const u32x2 lo_ = *(const LAS u32x2*)(scr + n * 34 + 4 * c), hi_ = *(const LAS u32x2*)(scr + n * 34 + 4 * c + 2);
        *(u32x4*)(WT + (size_t)(dstrow0 + n) * ldk + k0 + 8 * c) = (u32x4){lo_.x, lo_.y, hi_.x, hi_.y}; }
    LDS_WAIT(); asm volatile("" ::: "memory");
}
__device__ __forceinline__ void cvt_item64(const float* s0, const float* s1, int ldw, const float* gain, bf16* WT, int ldk, int dstrow0, int k0, LAS unsigned* scr, int lane) {
    f32x4 v[16]; cvt_load64(v, s0, s1, ldw, k0, lane); cvt_finish64(v, gain, WT, ldk, dstrow0, k0, scr, lane);
}
struct MoeCvtItem { const float* s0; const float* s1; const float* gain; bf16* dst; int ldw, ldk, n0, k0; };
__device__ __forceinline__ MoeCvtItem moe_cvt_item(int it, const float* Wg, const float* Wu, const float* Wd, const float* gain, bf16* WM) {
    const int e = it / 2688; int r = it - e * 2688; MoeCvtItem d;
    if (r < 1792) { const int kb = r / 112, nb = r - kb * 112, n0 = nb * 64, tile = n0 >> 8, w = n0 & 255; const float* base = (w < 128 ? Wg : Wu) + (size_t)e * D * EF + tile * 128 + (w & 127);
        d.s0 = base; d.s1 = base + 32; d.gain = gain; d.dst = WM + WM_GU + (size_t)e * 7168 * 1024; d.ldw = EF; d.ldk = 1024; d.n0 = n0; d.k0 = kb * 64; }
    else { r -= 1792; const int kb = r >> 4, nb = r & 15, n0 = nb * 64; const float* base = Wd + (size_t)e * EF * D + n0;
        d.s0 = base; d.s1 = base + 32; d.gain = nullptr; d.dst = WM + WM_DN + (size_t)e * 1024 * EF; d.ldw = D; d.ldk = EF; d.n0 = n0; d.k0 = kb * 64; }
    return d;
}
__device__ __forceinline__ void moe_cvt_all(const Frame& F, const float* Wg, const float* Wu, const float* Wd, const float* gain, bf16* WM) {
    LAS unsigned* scr = (LAS unsigned*)(F.lds + F.wave * 16384);
    constexpr int NIT = NE * 2688;
    for (int it = F.gw; it < NIT; it += F.ngw) {
        const MoeCvtItem da = moe_cvt_item(it, Wg, Wu, Wd, gain, WM);
        cvt_item64(da.s0, da.s1, da.ldw, da.gain, da.dst, da.ldk, da.n0, da.k0, scr, F.lane);
    }
}
__device__ __forceinline__ void cvt_job(const Frame& F, const float* W, const float* W2, int ldw, int nsrc, const float* gain, bf16* WT, int K, int Ndst, int mode, int wofs, int ldk = 0) {
    if (ldk == 0) ldk = K;
    LAS unsigned* scr = (LAS unsigned*)(F.lds + F.wave * 16384);
    const int nblk = Ndst / 64, nitems = (K / 64) * nblk;
    int start = F.gw - (wofs % F.ngw); if (start < 0) start += F.ngw;
    for (int it = start; it < nitems; it += F.ngw) {
        const int kb = it / nblk, nb = it % nblk, n0 = nb * 64;
        cvt_item64(cvt_src(mode, n0, W, W2, nsrc), cvt_src(mode, n0 + 32, W, W2, nsrc), ldw, gain, WT, ldk, n0, kb * 64, scr, F.lane);
    }
}

template <int NSUB, class P>
__device__ __forceinline__ void ngemm(const Frame& F, const P& p) {
    const int r32 = F.lane & 31, hi = F.lane >> 5;
    const int ntn = p.ntn(), ntiles = p.ntm() * ntn;
    for (int tile = F.gw; tile < ntiles; tile += F.ngw) {
        const int tm = tile / ntn, tn = tile % ntn;
        typename P::Ctx c;
        if (!p.setup(tm * 64, c)) continue;
        const bf16* a0 = p.arow(c, tm * 64 + r32) + hi * 8;
        const bf16* a1 = p.arow(c, tm * 64 + 32 + r32) + hi * 8;
        const bf16* b[NSUB];
#pragma unroll
        for (int s = 0; s < NSUB; ++s) b[s] = p.brow(c, s, tn * 32 + r32) + hi * 8;
        f32x16 acc[2][NSUB];
#pragma unroll
        for (int i = 0; i < 2; ++i)
#pragma unroll
            for (int s = 0; s < NSUB; ++s)
#pragma unroll
                for (int r = 0; r < 16; ++r) acc[i][s][r] = 0.f;
#pragma unroll 4
        for (int k = 0; k < p.K; k += 16) {
            const bf16x8 fa0 = *(const bf16x8*)(a0 + k), fa1 = *(const bf16x8*)(a1 + k);
#pragma unroll
            for (int s = 0; s < NSUB; ++s) { const bf16x8 fb = *(const bf16x8*)(b[s] + k);
                acc[0][s] = __builtin_amdgcn_mfma_f32_32x32x16_bf16(fa0, fb, acc[0][s], 0, 0, 0);
                acc[1][s] = __builtin_amdgcn_mfma_f32_32x32x16_bf16(fa1, fb, acc[1][s], 0, 0, 0); }
        }
#pragma unroll
        for (int i = 0; i < 2; ++i)
#pragma unroll
            for (int r = 0; r < 16; ++r) p.store(c, tm * 64 + 32 * i + crow(r, hi), tn * 32 + r32, acc[i][0][r], NSUB > 1 ? acc[i][NSUB - 1][r] : 0.f);
    }
}
__device__ __forceinline__ float half_sum32(float v) {
#pragma unroll
    for (int o = 1; o < 32; o <<= 1) v += __shfl_xor(v, o);
    return v;
}
struct NoCtx {};
struct PlainP {
    typedef NoCtx Ctx;
    const bf16* A; int lda; const bf16* Bt; int M, N, K; bf16* O; int ldo; const ssq_t* rs; int rs_mode; float rs_inv_dim;
    ssq_t* st0; int st0_end; ssq_t* st1; int st1_end;
    __device__ int ntm() const { return M / 64; } __device__ int ntn() const { return N / 32; }
    __device__ bool setup(int, Ctx&) const { return true; }
    __device__ const bf16* arow(const Ctx&, int m) const { return A + (size_t)m * lda; }
    __device__ const bf16* brow(const Ctx&, int, int n) const { return Bt + (size_t)n * K; }
    __device__ void store(const Ctx&, int m, int n, float v, float) const {
        float sc = 1.f; if (rs_mode == 1) sc = 1.0f / sqrtf(ss_get(rs, m) * rs_inv_dim + EPS);
        v *= sc; O[(size_t)m * ldo + n] = (bf16)f2bf(v);
        const int n0 = n & ~31;
        if (st0 && n0 < st1_end) { const float q = half_sum32(v * v); if ((n & 31) == 0) ss_add(n0 < st0_end ? st0 : st1, m, q); }
    }
};
struct ResidP {
    typedef NoCtx Ctx;
    const bf16* A; int lda; const bf16* Bt; int M, N, K; const float* xsrc; float* out; bf16* xb; ssq_t* ss;
    __device__ int ntm() const { return M / 64; } __device__ int ntn() const { return N / 32; }
    __device__ bool setup(int, Ctx&) const { return true; }
    __device__ const bf16* arow(const Ctx&, int m) const { return A + (size_t)m * lda; }
    __device__ const bf16* brow(const Ctx&, int, int n) const { return Bt + (size_t)n * K; }
    __device__ void store(const Ctx&, int m, int n, float v, float) const {
        const size_t o = (size_t)m * D + n; const float x = xsrc[o] + v; out[o] = x; xb[o] = (bf16)f2bf(x);
        const float q = half_sum32(x * x); if ((n & 31) == 0) ss_add(ss, m, q);
    }
};
struct SwigluP {
    typedef NoCtx Ctx;
    const bf16* A; const bf16* Bt; int M, NH, K; bf16* H; const ssq_t* ss;
    __device__ int ntm() const { return M / 64; } __device__ int ntn() const { return NH / 32; }
    __device__ bool setup(int, Ctx&) const { return true; }
    __device__ const bf16* arow(const Ctx&, int m) const { return A + (size_t)m * D; }
    __device__ const bf16* brow(const Ctx&, int s, int n) const { return Bt + (size_t)((n >> 7) * 256 + (n & 127) + s * 128) * K; }
    __device__ void store(const Ctx&, int m, int n, float g, float u) const {
        const float sc = 1.0f / sqrtf(ss_get(ss, m) * (1.0f / D) + EPS); g *= sc; u *= sc;
        H[(size_t)m * NH + n] = (bf16)f2bf(g / (1.0f + __expf(-g)) * u);
    }
};
struct MoeCtx { int e, row0, cnt; };
__device__ __forceinline__ bool moe_find(const unsigned* cnt, int m0, MoeCtx& c) {
    int base = 0;
#pragma unroll
    for (int e = 0; e < NE; ++e) { const int n = (int)cnt[e * 64]; const int rows = ((n + 255) >> 8) << 8; if (m0 < base + rows) { c.e = e; c.row0 = base; c.cnt = n; return true; } base += rows; }
    return false;
}
struct MoeGuP {
    typedef MoeCtx Ctx;
    const bf16* XB; const bf16* Wgu; int K; bf16* H; const ssq_t* ss; const unsigned* cnt; const int* idx;
    __device__ int ntm() const { return MOE_ROWS / 64; } __device__ int ntn() const { return EF / 32; }
    __device__ bool setup(int m0, Ctx& c) const { return moe_find(cnt, m0, c); }
    __device__ int tok(const Ctx& c, int m) const { const int slot = m - c.row0; return slot < c.cnt ? idx[c.e * T + slot] : 0; }
    __device__ const bf16* arow(const Ctx& c, int m) const { return XB + (size_t)tok(c, m) * D; }
    __device__ const bf16* brow(const Ctx& c, int s, int n) const { return Wgu + ((size_t)c.e * 7168 + (n >> 7) * 256 + (n & 127) + s * 128) * K; }
    __device__ void store(const Ctx& c, int m, int n, float g, float u) const {
        const float sc = 1.0f / sqrtf(ss_get(ss, tok(c, m)) * (1.0f / D) + EPS); g *= sc; u *= sc;
        H[(size_t)m * EF + n] = (bf16)f2bf(g / (1.0f + __expf(-g)) * u);
    }
};
struct MoeDnP {
    typedef MoeCtx Ctx;
    const bf16* Hd; const bf16* Wdn; int K; bf16* Y; const unsigned* cnt; const float* wl;
    __device__ int ntm() const { return MOE_ROWS / 64; } __device__ int ntn() const { return D / 32; }
    __device__ bool setup(int m0, Ctx& c) const { return moe_find(cnt, m0, c); }
    __device__ const bf16* arow(const Ctx&, int m) const { return Hd + (size_t)m * EF; }
    __device__ const bf16* brow(const Ctx& c, int, int n) const { return Wdn + ((size_t)c.e * D + n) * K; }
    __device__ void store(const Ctx& c, int m, int n, float v, float) const {
        const int slot = m - c.row0; const float w = slot < c.cnt ? wl[c.e * T + slot] : 0.f;
        Y[(size_t)m * D + n] = (bf16)f2bf(v * w);
    }
};
struct PleP {
    typedef NoCtx Ctx;
    const bf16* A; const bf16* Bt; int M, N, K; const bf16* PT; float* out; bf16* xb; const ssq_t* ss; ssq_t* ssn;
    __device__ int ntm() const { return M / 64; } __device__ int ntn() const { return N / 32; }
    __device__ bool setup(int, Ctx&) const { return true; }
    __device__ const bf16* arow(const Ctx&, int m) const { return A + (size_t)m * D; }
    __device__ const bf16* brow(const Ctx&, int, int n) const { return Bt + (size_t)n * K; }
    __device__ void store(const Ctx&, int m, int n, float v, float) const {
        const size_t o = (size_t)m * D + n; const float sc = 1.0f / sqrtf(ss_get(ss, m) * (1.0f / D) + EPS);
        const float g = 1.0f / (1.0f + __expf(-v * sc)); const float x = out[o] + bf2f(PT[o]) * g; out[o] = x; xb[o] = (bf16)f2bf(x);
        if (ssn) { const float q = half_sum32(x * x); if ((n & 31) == 0) ss_add(ssn, m, q); }
    }
};


namespace pg8 {
constexpr int BM = 256, BK = 64, HALF = 128, HTB = HALF * BK * 2, STAGE_BYTES = 8 * HTB, NXCD = 8, WGM = 8;
__host__ __device__ __forceinline__ int lds_byte(int r, int c) { const int st = (r >> 4) * 2 + (c >> 5), rr = r & 15, cc = c & 31, ob = rr * 64 + cc * 2; return st * 1024 + (ob ^ (((ob >> 9) & 1) << 5)); }
__host__ __device__ __forceinline__ void stage_rc(int b, int& R, int& C) { const int st = b / 1024, sb = b % 1024, swz = sb ^ (((sb >> 9) & 1) << 5); R = (st >> 1) * 16 + swz / 64; C = (st & 1) * 32 + (swz % 64) / 2; }
__host__ __device__ __forceinline__ int perm32(int rho) { const int n = rho >> 4, i = rho & 15; return 8 * (i >> 2) + 4 * n + (i & 3); }
struct Unit { int pm, pn, e, slot0, cnt, ks, aux; };
struct Gemm { const bf16* A; const bf16* Bt; int K, lda, ldb; };

struct StaticOrder {
    static constexpr bool GATHER = false;
    int nM, nN, nwg, G, c;
    __device__ __forceinline__ void init(int M, int N, int G_, int c_) { nM = M / BM; nN = N / BM; nwg = nM * nN; G = G_; c = c_; }
    __device__ __forceinline__ bool next(int i, Unit& u) const {
        const long L = (long)i * G + c; if (L >= nwg) return false;
        int wgid = (int)L; { const int q = nwg / NXCD, r = nwg % NXCD, xcd = wgid % NXCD, off = wgid / NXCD; wgid = (xcd < r ? xcd * (q + 1) : r * (q + 1) + (xcd - r) * q) + off; }
        const int nig = WGM * nN, gid = wgid / nig, fm = gid * WGM, gsz = (nM - fm) < WGM ? (nM - fm) : WGM;
        u.pm = fm + ((wgid % nig) % gsz); u.pn = (wgid % nig) / gsz; u.e = 0; u.slot0 = 0; u.cnt = 0; return true;
    }
    __device__ __forceinline__ const char* a_base(const Gemm& g, const Unit& u) const { return (const char*)g.A + (size_t)u.pm * ((size_t)BM * g.lda * 2); }
    __device__ __forceinline__ size_t k_off(const Unit&) const { return 0; }
    __device__ __forceinline__ void a_raw(const Unit&, const int (&)[2], int (&)[2][2]) const {}
    __device__ __forceinline__ void a_fin(const Unit&, const int (&)[2], const int (&)[2], int, const int (&)[2][2], unsigned (&)[2][2]) const {}
    __device__ __forceinline__ void a_offs(const Unit&, const int (&RA)[2], const int (&CA)[2], int lda, unsigned (&v)[2][2]) const {
#pragma unroll
        for (int h = 0; h < 2; ++h)
#pragma unroll
            for (int i = 0; i < 2; ++i) v[h][i] = (unsigned)((RA[i] + HALF * h) * lda + CA[i]) * 2u;
    }
};
template <bool GATHER_> struct GroupedOrder {
    static constexpr bool GATHER = GATHER_;
    int NT, G, c, nunits, nlim; const LAS int* tab; const int* idx;
    __device__ __forceinline__ void init(const unsigned* cnt, int NT_, int G_, int c_, const int* idx_, LAS int* tab_) { NT = NT_; G = G_; c = c_; idx = idx_; tab = tab_;
        __syncthreads();
        if (threadIdx.x < 8) tab_[threadIdx.x] = (int)cnt[threadIdx.x * 64];
        __syncthreads();
        if (threadIdx.x == 0) { int t = 0; tab_[8] = 0; for (int e = 0; e < 8; ++e) { t += (tab_[e] + 255) >> 8; tab_[9 + e] = t; } }
        __syncthreads();
        nunits = __builtin_amdgcn_readfirstlane(tab_[16]) * NT; nlim = nunits; }
    __device__ __forceinline__ bool next(int i, Unit& u) const {
        const int L = i * G + c; if (L >= nlim) return false;
        int wgid = L; { const int q = nlim / NXCD, r = nlim % NXCD, xcd = wgid % NXCD, off = wgid / NXCD; wgid = (xcd < r ? xcd * (q + 1) : r * (q + 1) + (xcd - r) * q) + off; }
        decode(wgid, u); return true;
    }
    __device__ __forceinline__ void decode(int wgid, Unit& u) const {
        const int nM = nunits / NT, nig = WGM * NT, gid = wgid / nig, fm = gid * WGM, gsz = (nM - fm) < WGM ? (nM - fm) : WGM, rem = wgid - gid * nig;
        const int mt = fm + rem % gsz, pnl = rem / gsz; int e = 0;
#pragma unroll
        for (int j = 1; j < 8; ++j) if (mt >= tab[8 + j]) e = j;
        e = __builtin_amdgcn_readfirstlane(e);
        u.pm = mt; u.pn = e * NT + pnl; u.e = e; u.slot0 = (mt - __builtin_amdgcn_readfirstlane(tab[8 + e])) * 256; u.cnt = __builtin_amdgcn_readfirstlane(tab[e]);
    }
    __device__ __forceinline__ const char* a_base(const Gemm& g, const Unit& u) const { return GATHER ? (const char*)g.A : (const char*)g.A + (size_t)u.pm * ((size_t)BM * g.lda * 2); }
    __device__ __forceinline__ size_t k_off(const Unit&) const { return 0; }
    __device__ __forceinline__ void a_raw(const Unit& u, const int (&RA)[2], int (&tk)[2][2]) const {
#pragma unroll
        for (int h = 0; h < 2; ++h)
#pragma unroll
            for (int i = 0; i < 2; ++i) tk[h][i] = GATHER ? __builtin_nontemporal_load(idx + u.e * T + u.slot0 + RA[i] + HALF * h) : 0;
    }
    __device__ __forceinline__ void a_fin(const Unit& u, const int (&RA)[2], const int (&CA)[2], int lda, const int (&tk)[2][2], unsigned (&v)[2][2]) const {
#pragma unroll
        for (int h = 0; h < 2; ++h)
#pragma unroll
            for (int i = 0; i < 2; ++i) { const int slot = u.slot0 + RA[i] + HALF * h; int raw = tk[h][i]; asm volatile("" : "+v"(raw));
                const int tok = slot < u.cnt ? raw : 0; v[h][i] = (unsigned)(tok * lda + CA[i]) * 2u; }
    }
    __device__ __forceinline__ void a_offs(const Unit& u, const int (&RA)[2], const int (&CA)[2], int lda, unsigned (&v)[2][2]) const {
#pragma unroll
        for (int h = 0; h < 2; ++h)
#pragma unroll
            for (int i = 0; i < 2; ++i) {
                if (GATHER) { const int slot = u.slot0 + RA[i] + HALF * h; int tok = __builtin_nontemporal_load(idx + u.e * T + slot); tok = slot < u.cnt ? tok : 0; v[h][i] = (unsigned)(tok * lda + CA[i]) * 2u; }
                else v[h][i] = (unsigned)((RA[i] + HALF * h) * lda + CA[i]) * 2u; }
    }
};

struct SliceOrder {
    static constexpr bool GATHER = false;
    GroupedOrder<false> go; int first, ntail, nslice, kbytes, G, c;
    __device__ __forceinline__ bool next(int i, Unit& u) const {
        const int j = i * G + c; if (j >= ntail * nslice) return false;
        const int ks = j / ntail; go.decode(first + (j - ks * ntail), u); u.ks = ks; u.aux = j; return true;
    }
    __device__ __forceinline__ const char* a_base(const Gemm& g, const Unit& u) const { return (const char*)g.A + (size_t)u.pm * ((size_t)BM * g.lda * 2) + (size_t)u.ks * kbytes; }
    __device__ __forceinline__ size_t k_off(const Unit& u) const { return (size_t)u.ks * kbytes; }
    __device__ __forceinline__ void a_raw(const Unit&, const int (&)[2], int (&)[2][2]) const {}
    __device__ __forceinline__ void a_fin(const Unit&, const int (&)[2], const int (&)[2], int, const int (&)[2][2], unsigned (&)[2][2]) const {}
    __device__ __forceinline__ void a_offs(const Unit&, const int (&RA)[2], const int (&CA)[2], int lda, unsigned (&v)[2][2]) const {
#pragma unroll
        for (int h = 0; h < 2; ++h)
#pragma unroll
            for (int i = 0; i < 2; ++i) v[h][i] = (unsigned)((RA[i] + HALF * h) * lda + CA[i]) * 2u;
    }
};

__device__ __forceinline__ unsigned cvt_pk_bf16(float lo, float hi) { unsigned r; asm volatile("v_cvt_pk_bf16_f32 %0, %1, %2" : "=v"(r) : "v"(lo), "v"(hi)); return r; }
struct EpiCache { int pm; };
__device__ __forceinline__ float rstd_of(const ssq_t* p, int row, float inv_dim) { return __builtin_amdgcn_rsqf(u64f(p[row]) * (1.0f / 16777216.0f) * inv_dim + EPS); }
__device__ __forceinline__ float sumsq4(f32x4 v) { return (v[0] * v[0] + v[1] * v[1]) + (v[2] * v[2] + v[3] * v[3]); }

template <bool STATS> struct EpiPlain {
    static constexpr bool PERM = true;
    bf16* O; int ldo, ntile; const ssq_t* rs; float rs_inv_dim; const float* wl; ssq_t* st0; ssq_t* st1;
    __device__ __forceinline__ void operator()(const f32x4 (&acc)[2][2][4][2], const Unit& u, int wr, int wc, int fr, int fq, EpiCache& ec) const {
        const int pnl = u.pn - u.e * ntile, row0 = u.pm * BM + wr * 64 + fr, col0 = pnl * BM + wc * 32 + 8 * fq;
        float sc[2][4];
#pragma unroll
        for (int ai = 0; ai < 2; ++ai)
#pragma unroll
            for (int m = 0; m < 4; ++m) { const int r = ai * HALF + m * 16;
                if (rs) sc[ai][m] = rstd_of(rs, row0 + r, rs_inv_dim);
                else if (wl) { const int slot = u.slot0 + wr * 64 + fr + r; const float w_ = __builtin_nontemporal_load(wl + u.e * T + slot); sc[ai][m] = slot < u.cnt ? w_ : 0.f; }
                else sc[ai][m] = 1.f; }
#pragma unroll
        for (int ai = 0; ai < 2; ++ai)
#pragma unroll
            for (int m = 0; m < 4; ++m) { const int row = row0 + ai * HALF + m * 16; bf16* rowp = O + (size_t)row * ldo + col0; float q = 0.f;
#pragma unroll
                for (int bj = 0; bj < 2; ++bj) { const f32x4 v0 = acc[ai][bj][m][0] * sc[ai][m], v1 = acc[ai][bj][m][1] * sc[ai][m];
                    u32x4 w; w.x = cvt_pk_bf16(v0[0], v0[1]); w.y = cvt_pk_bf16(v0[2], v0[3]); w.z = cvt_pk_bf16(v1[0], v1[1]); w.w = cvt_pk_bf16(v1[2], v1[3]);
                    *(u32x4*)(rowp + bj * HALF) = w;
                    if (STATS) { if (pnl == 0 || bj == 0) q += sumsq4(v0) + sumsq4(v1); } }
                if (STATS) { q += __shfl_xor(q, 16); q += __shfl_xor(q, 32); if (fq == 0) ss_add(pnl == 0 ? st0 : st1, row, q); } }
    }
};
struct EpiPartial {
    static constexpr bool PERM = true;
    float* P;
    __device__ __forceinline__ void operator()(const f32x4 (&acc)[2][2][4][2], const Unit& u, int wr, int wc, int fr, int fq, EpiCache& ec) const {
        float* p = P + (size_t)u.aux * 65536 + (wr * 64 + fr) * 256 + wc * 32 + 8 * fq;
#pragma unroll
        for (int ai = 0; ai < 2; ++ai)
#pragma unroll
            for (int m = 0; m < 4; ++m)
#pragma unroll
                for (int bj = 0; bj < 2; ++bj) { float* q = p + (ai * HALF + m * 16) * 256 + bj * HALF; *(f32x4*)q = acc[ai][bj][m][0]; *(f32x4*)(q + 4) = acc[ai][bj][m][1]; }
    }
};
struct EpiPlainNP {
    static constexpr bool PERM = false;
    bf16* O; int ldo;
    __device__ __forceinline__ void operator()(const f32x4 (&acc)[2][2][4][2], const Unit& u, int wr, int wc, int fr, int fq, EpiCache& ec) const {
        const int row0 = u.pm * BM + wr * 64 + fr, col0 = u.pn * BM + wc * 32 + 4 * fq;
#pragma unroll
        for (int ai = 0; ai < 2; ++ai)
#pragma unroll
            for (int m = 0; m < 4; ++m) { bf16* rowp = O + (size_t)(row0 + ai * HALF + m * 16) * ldo + col0;
#pragma unroll
                for (int bj = 0; bj < 2; ++bj)
#pragma unroll
                    for (int n = 0; n < 2; ++n) { const f32x4 x = acc[ai][bj][m][n]; *(u32x2*)(rowp + bj * HALF + n * 16) = (u32x2){cvt_pk_bf16(x[0], x[1]), cvt_pk_bf16(x[2], x[3])}; } }
    }
};
template <bool ROPE> struct EpiKN {
    static constexpr bool PERM = true;
    bf16* O; int ldo, kt_lo, kt_hi, vshift; const ssq_t* rs; float rs_inv_dim; const float* kgain; const bf16* Crope; LAS float* part;
    __device__ __forceinline__ void operator()(const f32x4 (&acc)[2][2][4][2], const Unit& u, int wr, int wc, int fr, int fq, EpiCache& ec) const {
        const int pn = u.pn; const bool kn = pn >= kt_lo && pn < kt_hi;
        int fro = fr, fqo = fq; asm volatile("" : "+v"(fro), "+v"(fqo));
        const int row0 = u.pm * BM + wr * 64 + fro, col0 = pn * BM + (pn >= kt_hi ? vshift : 0) + wc * 32 + 8 * fqo, rt0 = wr * 64 + fro;
        if (!kn) {
#pragma unroll
            for (int ai = 0; ai < 2; ++ai)
#pragma unroll
                for (int m = 0; m < 4; ++m) { const int row = row0 + ai * HALF + m * 16; bf16* rowp = O + (size_t)row * ldo + col0; const float sc = rstd_of(rs, row, rs_inv_dim);
#pragma unroll
                    for (int bj = 0; bj < 2; ++bj) { const f32x4 v0 = acc[ai][bj][m][0] * sc, v1 = acc[ai][bj][m][1] * sc;
                        *(u32x4*)(rowp + bj * HALF) = (u32x4){cvt_pk_bf16(v0[0], v0[1]), cvt_pk_bf16(v0[2], v0[3]), cvt_pk_bf16(v1[0], v1[1]), cvt_pk_bf16(v1[2], v1[3])}; }
                    if (m & 1) asm volatile("" ::: "memory"); }
            return;
        }
#pragma unroll
        for (int ai = 0; ai < 2; ++ai)
#pragma unroll
            for (int m = 0; m < 4; ++m) { const float sc = rstd_of(rs, row0 + ai * HALF + m * 16, rs_inv_dim);
#pragma unroll
                for (int bj = 0; bj < 2; ++bj) { float q = (sumsq4(acc[ai][bj][m][0]) + sumsq4(acc[ai][bj][m][1])) * (sc * sc);
                    q += __shfl_xor(q, 16); q += __shfl_xor(q, 32);
                    if (fqo == 0) part[(rt0 + ai * HALF + m * 16) * 8 + bj * 4 + wc] = q; }
                if (m & 1) asm volatile("" ::: "memory"); }
        asm volatile("s_waitcnt lgkmcnt(0)" ::: "memory"); __builtin_amdgcn_s_barrier(); asm volatile("" ::: "memory");
        constexpr float HD = ROPE ? 96.0f : 64.0f;
        const int dcol = (wc & 1) * 32 + 8 * fqo;
        const f32x4 g0 = *(const f32x4*)(kgain + dcol), g1 = *(const f32x4*)(kgain + dcol + 4);
#pragma unroll
        for (int ai = 0; ai < 2; ++ai)
#pragma unroll
            for (int m = 0; m < 4; ++m) { const int row = row0 + ai * HALF + m * 16, rt = rt0 + ai * HALF + m * 16; bf16* rowp = O + (size_t)row * ldo + col0; const float sc = rstd_of(rs, row, rs_inv_dim);
                float rq = 0.f; f32x4 ka = {0.f, 0.f, 0.f, 0.f}, kb = {0.f, 0.f, 0.f, 0.f};
                if (ROPE) { const u32x2 wa = *(const u32x2*)(Crope + (size_t)row * 512 + 384 + 4 * fqo), wb = *(const u32x2*)(Crope + (size_t)row * 512 + 400 + 4 * fqo);
                    ka = (f32x4){bflo(wa.x), bfhi(wa.x), bflo(wa.y), bfhi(wa.y)}; kb = (f32x4){bflo(wb.x), bfhi(wb.x), bflo(wb.y), bfhi(wb.y)};
                    rq = sumsq4(ka) + sumsq4(kb); rq += __shfl_xor(rq, 16); rq += __shfl_xor(rq, 32);
                    const f32x4 ga = *(const f32x4*)(kgain + 64 + 4 * fqo), gb = *(const f32x4*)(kgain + 80 + 4 * fqo); ka = ka * ga; kb = kb * gb; }
                f32x4 cs4 = {1.f, 1.f, 1.f, 1.f}, sn4 = {0.f, 0.f, 0.f, 0.f};
                if (ROPE) { const int t = row & (S - 1);
#pragma unroll
                    for (int i = 0; i < 4; ++i) { float sn, cs; fast_sincos((float)t * __builtin_amdgcn_exp2f(-(float)(2 * (4 * fqo + i)) * (13.287712379549449f / 32.0f)), sn, cs); cs4[i] = cs; sn4[i] = sn; } }
#pragma unroll
                for (int bj = 0; bj < 2; ++bj) { const float hs = part[rt * 8 + bj * 4 + wc] + part[rt * 8 + bj * 4 + (wc ^ 1)] + rq;
                    const float rh = __builtin_amdgcn_rsqf(hs * (1.0f / HD) + EPS), s_ = sc * rh;
                    const f32x4 v0 = acc[ai][bj][m][0] * s_ * g0, v1 = acc[ai][bj][m][1] * s_ * g1;
                    *(u32x4*)(rowp + bj * HALF) = (u32x4){cvt_pk_bf16(v0[0], v0[1]), cvt_pk_bf16(v0[2], v0[3]), cvt_pk_bf16(v1[0], v1[1]), cvt_pk_bf16(v1[2], v1[3])};
                    if (ROPE) {
                        const int h = (pn - kt_lo) * 4 + bj * 2 + (wc >> 1);
                        const f32x4 o = ((wc & 1) ? ka * sn4 + kb * cs4 : ka * cs4 - kb * sn4) * rh;
                        *(u32x2*)(O + (size_t)row * ldo + 1024 + h * 32 + 16 * (wc & 1) + 4 * fqo) = (u32x2){cvt_pk_bf16(o[0], o[1]), cvt_pk_bf16(o[2], o[3])}; } }
                asm volatile("" ::: "memory"); }
    }
};
__device__ __forceinline__ void unpack8f(const u32x4 w, f32x4& lo, f32x4& hi) { lo = (f32x4){bflo(w.x), bfhi(w.x), bflo(w.y), bfhi(w.y)}; hi = (f32x4){bflo(w.z), bfhi(w.z), bflo(w.w), bfhi(w.w)}; }
struct EpiResid {
    static constexpr bool PERM = true;
    const bf16* base; bf16* xb; ssq_t* ss;
    __device__ __forceinline__ void operator()(const f32x4 (&acc)[2][2][4][2], const Unit& u, int wr, int wc, int fr, int fq, EpiCache& ec) const {
        const int row0 = u.pm * BM + wr * 64 + fr, col0 = u.pn * BM + wc * 32 + 8 * fq;
        u32x4 bv[2][4][2];
#pragma unroll
        for (int ai = 0; ai < 2; ++ai)
#pragma unroll
            for (int m = 0; m < 4; ++m)
#pragma unroll
                for (int bj = 0; bj < 2; ++bj) bv[ai][m][bj] = *(const u32x4*)(base + (size_t)(row0 + ai * HALF + m * 16) * D + col0 + bj * HALF);
#pragma unroll
        for (int ai = 0; ai < 2; ++ai)
#pragma unroll
            for (int m = 0; m < 4; ++m) { const int row = row0 + ai * HALF + m * 16; const size_t off = (size_t)row * D + col0; float q = 0.f;
#pragma unroll
                for (int bj = 0; bj < 2; ++bj) { const size_t o = off + bj * HALF; f32x4 b0, b1; unpack8f(bv[ai][m][bj], b0, b1);
                    const f32x4 x0 = b0 + acc[ai][bj][m][0], x1 = b1 + acc[ai][bj][m][1];
                    *(u32x4*)(xb + o) = (u32x4){cvt_pk_bf16(x0[0], x0[1]), cvt_pk_bf16(x0[2], x0[3]), cvt_pk_bf16(x1[0], x1[1]), cvt_pk_bf16(x1[2], x1[3])}; q += sumsq4(x0) + sumsq4(x1); }
                q += __shfl_xor(q, 16); q += __shfl_xor(q, 32); if (fq == 0) ss_add(ss, row, q); }
    }
};
__device__ __forceinline__ float silu_mul(float g, float u) { return g * __builtin_amdgcn_rcpf(1.0f + __expf(-g)) * u; }
struct EpiSwiglu {
    static constexpr bool PERM = true;
    bf16* H; int ldh, ntile; const ssq_t* ss; const float* rsl; LAS float* ctab;
    __device__ __forceinline__ void operator()(const f32x4 (&acc)[2][2][4][2], const Unit& u, int wr, int wc, int fr, int fq, EpiCache& ec) const {
        const int pnl = u.pn - u.e * ntile, row0 = u.pm * BM + wr * 64 + fr, col0 = pnl * HALF + wc * 32 + 8 * fq;
        LAS float* tabw = ctab + (wr * 4 + wc) * 128 + fr;
        if (ec.pm != u.pm) {
            ec.pm = u.pm;
            if (fq == 0) {
#pragma unroll
                for (int ai = 0; ai < 2; ++ai)
#pragma unroll
                    for (int m = 0; m < 4; ++m) { const int r = ai * HALF + m * 16; float v_;
                        if (ss) v_ = rstd_of(ss, row0 + r, 1.0f / D);
                        else { const int slot = u.slot0 + wr * 64 + fr + r; const float w_ = __builtin_nontemporal_load(rsl + u.e * T + slot); v_ = slot < u.cnt ? w_ : 0.f; }
                        tabw[(ai * 4 + m) * 16] = v_; } }
            asm volatile("s_waitcnt lgkmcnt(0)" ::: "memory");
        }
#pragma unroll
        for (int ai = 0; ai < 2; ++ai)
#pragma unroll
            for (int m = 0; m < 4; ++m) { const int row = row0 + ai * HALF + m * 16; const float s_ = tabw[(ai * 4 + m) * 16], c1 = -s_ * LOG2E, s2 = s_ * s_;
                const f32x4 g0 = acc[ai][0][m][0], g1 = acc[ai][0][m][1], u0 = acc[ai][1][m][0], u1 = acc[ai][1][m][1];
#define SGL(g, u) (((g) * (u)) * (s2 * __builtin_amdgcn_rcpf(1.0f + __builtin_amdgcn_exp2f((g) * c1))))
                u32x4 w; w.x = cvt_pk_bf16(SGL(g0[0], u0[0]), SGL(g0[1], u0[1])); w.y = cvt_pk_bf16(SGL(g0[2], u0[2]), SGL(g0[3], u0[3]));
                w.z = cvt_pk_bf16(SGL(g1[0], u1[0]), SGL(g1[1], u1[1])); w.w = cvt_pk_bf16(SGL(g1[2], u1[2]), SGL(g1[3], u1[3]));
#undef SGL
                *(u32x4*)(H + (size_t)row * ldh + col0) = w; }
    }
};
__device__ __forceinline__ float sigm(float a) { return __builtin_amdgcn_rcpf(1.0f + __expf(-a)); }
struct EpiPle {
    static constexpr bool PERM = true;
    const bf16* PT; const bf16* base; bf16* xa; float* outf; const ssq_t* ss; ssq_t* ssn;
    __device__ __forceinline__ void operator()(const f32x4 (&acc)[2][2][4][2], const Unit& u, int wr, int wc, int fr, int fq, EpiCache& ec) const {
        const int row0 = u.pm * BM + wr * 64 + fr, col0 = u.pn * BM + wc * 32 + 8 * fq;
#pragma unroll
        for (int g = 0; g < 4; ++g) {
            const int ai = g >> 1, mb = (g & 1) * 2;
            u32x4 bv[2][2], pv[2][2]; float sc[2];
#pragma unroll
            for (int mm = 0; mm < 2; ++mm) { sc[mm] = rstd_of(ss, row0 + ai * HALF + (mb + mm) * 16, 1.0f / D);
#pragma unroll
                for (int bj = 0; bj < 2; ++bj) { const size_t o = (size_t)(row0 + ai * HALF + (mb + mm) * 16) * D + col0 + bj * HALF; bv[mm][bj] = *(const u32x4*)(base + o); pv[mm][bj] = *(const u32x4*)(PT + o); } }
#pragma unroll
            for (int mm = 0; mm < 2; ++mm) { const int m = mb + mm; const int row = row0 + ai * HALF + m * 16; const size_t off = (size_t)row * D + col0; const float s_ = sc[mm]; float q = 0.f;
#pragma unroll
                for (int bj = 0; bj < 2; ++bj) { const size_t o = off + bj * HALF; f32x4 b0, b1, p0, p1; unpack8f(bv[mm][bj], b0, b1); unpack8f(pv[mm][bj], p0, p1);
                    const f32x4 a0 = acc[ai][bj][m][0] * s_, a1 = acc[ai][bj][m][1] * s_; f32x4 x0, x1;
#pragma unroll
                    for (int i = 0; i < 4; ++i) { x0[i] = b0[i] + p0[i] * sigm(a0[i]); x1[i] = b1[i] + p1[i] * sigm(a1[i]); }
                    if (outf) { __builtin_nontemporal_store(x0, (f32x4*)(outf + o)); __builtin_nontemporal_store(x1, (f32x4*)(outf + o + 4)); }
                    else *(u32x4*)(xa + o) = (u32x4){cvt_pk_bf16(x0[0], x0[1]), cvt_pk_bf16(x0[2], x0[3]), cvt_pk_bf16(x1[0], x1[1]), cvt_pk_bf16(x1[2], x1[3])};
                    q += sumsq4(x0) + sumsq4(x1); }
                if (ssn) { q += __shfl_xor(q, 16); q += __shfl_xor(q, 32); if (fq == 0) ss_add(ssn, row, q); } }
        }
    }
};

template <class Epi, class Sched>
__device__ __forceinline__ void gemm_phase(LAS unsigned char* lds, const Gemm g, const Sched& S, const Epi& E) {
    const int tid = tid_now(), wid = __builtin_amdgcn_readfirstlane(tid >> 6), lane = tid & 63, wr = wid >> 2, wc = wid & 3, fr = lane & 15, fq = lane >> 4;
    const int K = g.K, nt = K / BK, lda = g.lda, ldb = g.ldb > 0 ? g.ldb : K;
    int RA[2], CA[2]; unsigned voffB[2];
#pragma unroll
    for (int i = 0; i < 2; ++i) { int R, C; stage_rc(tid * 16 + i * 8192, R, C); const int Rb = Epi::PERM ? ((R & ~31) + perm32(R & 31)) : R; RA[i] = R; CA[i] = C; voffB[i] = (unsigned)(Rb * ldb + C) * 2u; }
    const size_t kstep = (size_t)(BK * 2);
    const size_t hstep = (size_t)HALF * ldb * 2;
    const size_t tstep = 2 * hstep;
    const unsigned ldsw = (unsigned)wid * 1024u;
    const int aoff = lds_byte(wr * 64 + fr, fq * 8), boff = lds_byte(wc * 32 + fr, fq * 8);
#define PG8_SA(b, h) (((b) * 2 + (h)) * HTB)
#define PG8_SB(b, h) ((4 + (b) * 2 + (h)) * HTB)
#define PG8_STAGE(bufoff, gbase, voff) do { _Pragma("unroll") for (int _i = 0; _i < 2; ++_i) \
        __builtin_amdgcn_global_load_lds((const unsigned*)((const char*)(gbase) + (voff)[_i]), (LAS unsigned*)(lds + (bufoff) + ldsw + _i * 8192), 16, 0, 0); } while (0)
#define PG8_LDA(dst, b, h) do { _Pragma("unroll") for (int m = 0; m < 4; ++m) _Pragma("unroll") for (int k = 0; k < 2; ++k) dst[m][k] = *(const LAS bf16x8*)(lds + PG8_SA(b, h) + aoff + m * 2048 + k * 1024); } while (0)
#define PG8_LDB(dst, b, h) do { _Pragma("unroll") for (int n = 0; n < 2; ++n) _Pragma("unroll") for (int k = 0; k < 2; ++k) dst[n][k] = *(const LAS bf16x8*)(lds + PG8_SB(b, h) + boff + n * 2048 + k * 1024); } while (0)
#define PG8_MMA(ai, bj, At, Bt) do { __builtin_amdgcn_s_setprio(1); _Pragma("unroll") for (int m = 0; m < 4; ++m) _Pragma("unroll") for (int n = 0; n < 2; ++n) _Pragma("unroll") for (int k = 0; k < 2; ++k) \
        acc[ai][bj][m][n] = __builtin_amdgcn_mfma_f32_16x16x32_bf16(Bt[n][k], At[m][k], acc[ai][bj][m][n], 0, 0, 0); __builtin_amdgcn_s_setprio(0); } while (0)
#define PG8_WAIT_V(n) asm volatile("s_waitcnt vmcnt(" #n ")" ::: "memory")
#define PG8_WAIT_L(n) asm volatile("s_waitcnt lgkmcnt(" #n ")" ::: "memory")
#define PG8_BAR __builtin_amdgcn_s_barrier()
#define PG8_SCHED __builtin_amdgcn_sched_barrier(0)
    Unit cur, nxt; int ui = 0;
    if (!S.next(0, cur)) return;
    f32x4 acc[2][2][4][2];
#pragma unroll
    for (int a = 0; a < 2; ++a)
#pragma unroll
        for (int b = 0; b < 2; ++b)
#pragma unroll
            for (int m = 0; m < 4; ++m)
#pragma unroll
                for (int n = 0; n < 2; ++n) acc[a][b][m][n] = (f32x4){0.f, 0.f, 0.f, 0.f};
    bf16x8 At[4][2], B0[2][2], B1[2][2];
    unsigned vc[2][2], vn[2][2]; EpiCache ec; ec.pm = -1;
    S.a_offs(cur, RA, CA, lda, vc);
    const char* cA = S.a_base(g, cur); const char* cB = (const char*)g.Bt + (size_t)cur.pn * tstep + S.k_off(cur);
    PG8_STAGE(PG8_SB(0, 0), cB, voffB); PG8_STAGE(PG8_SB(0, 1), cB + hstep, voffB); PG8_STAGE(PG8_SA(0, 0), cA, vc[0]); PG8_STAGE(PG8_SA(0, 1), cA, vc[1]);
    if (wr == 1) PG8_BAR;
    PG8_WAIT_V(2); PG8_BAR;
    PG8_STAGE(PG8_SB(1, 0), cB + kstep, voffB); PG8_STAGE(PG8_SA(1, 0), cA + kstep, vc[0]); PG8_STAGE(PG8_SB(1, 1), cB + hstep + kstep, voffB);
    PG8_WAIT_V(6); PG8_BAR;
    for (;;) {
        const bool has_next = S.next(ui + 1, nxt);
        const char* nA = has_next ? S.a_base(g, nxt) : cA; const char* nB = has_next ? (const char*)g.Bt + (size_t)nxt.pn * tstep + S.k_off(nxt) : cB;
        int tkr[2][2]; const bool newpanel = has_next && nxt.pm != cur.pm;
        if (Sched::GATHER && newpanel) S.a_raw(nxt, RA, tkr);
#pragma nounroll
        for (int t = 0; t < nt; t += 2) {
            const bool last = (t == nt - 2);
            const char* a1 = cA + (size_t)(t + 1) * kstep;
            const char* a2 = last ? nA : cA + (size_t)(t + 2) * kstep; const char* b2 = last ? nB : cB + (size_t)(t + 2) * kstep;
            const char* a3 = a2 + kstep; const char* b3 = b2 + kstep;
            unsigned v2[2][2];
#pragma unroll
            for (int h = 0; h < 2; ++h)
#pragma unroll
                for (int i = 0; i < 2; ++i) v2[h][i] = vc[h][i];
            if (Sched::GATHER && last) {
                if (newpanel) S.a_fin(nxt, RA, CA, lda, tkr, vn);
#pragma unroll
                for (int h = 0; h < 2; ++h)
#pragma unroll
                    for (int i = 0; i < 2; ++i) { if (!newpanel) vn[h][i] = vc[h][i]; v2[h][i] = vn[h][i]; } }
            PG8_LDB(B0, 0, 0); PG8_LDB(B1, 0, 1); PG8_SCHED; PG8_LDA(At, 0, 0); PG8_STAGE(PG8_SA(1, 1), a1, vc[1]);
            PG8_WAIT_V(8); PG8_WAIT_L(0); PG8_BAR; PG8_MMA(0, 0, At, B0); PG8_MMA(0, 1, At, B1); PG8_BAR; PG8_SCHED;
            PG8_LDA(At, 0, 1); PG8_STAGE(PG8_SB(0, 0), b2, voffB); PG8_STAGE(PG8_SB(0, 1), b2 + hstep, voffB); PG8_STAGE(PG8_SA(0, 0), a2, v2[0]);
            PG8_WAIT_V(8); PG8_WAIT_L(0); PG8_BAR; PG8_MMA(1, 0, At, B0); PG8_MMA(1, 1, At, B1); PG8_BAR; PG8_SCHED;
            PG8_LDB(B0, 1, 0); PG8_LDB(B1, 1, 1); PG8_SCHED; PG8_LDA(At, 1, 0); PG8_STAGE(PG8_SA(0, 1), a2, v2[1]);
            PG8_WAIT_V(8); PG8_WAIT_L(0); PG8_BAR; PG8_MMA(0, 0, At, B0); PG8_MMA(0, 1, At, B1); PG8_BAR; PG8_SCHED;
            PG8_LDA(At, 1, 1); PG8_STAGE(PG8_SB(1, 0), b3, voffB); PG8_STAGE(PG8_SB(1, 1), b3 + hstep, voffB); PG8_STAGE(PG8_SA(1, 0), a3, v2[0]);
            PG8_WAIT_V(8); PG8_WAIT_L(0); PG8_BAR; PG8_MMA(1, 0, At, B0); PG8_MMA(1, 1, At, B1); PG8_BAR; PG8_SCHED;
        }
        if (wr == 0) PG8_BAR;
        E(acc, cur, wr, wc, fr, fq, ec);
        if (!has_next) break;
#pragma unroll
        for (int a = 0; a < 2; ++a)
#pragma unroll
            for (int b = 0; b < 2; ++b)
#pragma unroll
                for (int m = 0; m < 4; ++m)
#pragma unroll
                    for (int n = 0; n < 2; ++n) acc[a][b][m][n] = (f32x4){0.f, 0.f, 0.f, 0.f};
        cur = nxt; cA = nA; cB = nB; ++ui;
#pragma unroll
        for (int h = 0; h < 2; ++h)
#pragma unroll
            for (int i = 0; i < 2; ++i) vc[h][i] = Sched::GATHER ? vn[h][i] : vc[h][i];
        if (wr == 1) PG8_BAR;
    }
    PG8_WAIT_V(0);
    PG8_BAR;
#undef PG8_SA
#undef PG8_SB
#undef PG8_STAGE
#undef PG8_LDA
#undef PG8_LDB
#undef PG8_MMA
#undef PG8_WAIT_V
#undef PG8_WAIT_L
#undef PG8_BAR
#undef PG8_SCHED
}
}


namespace fa {
typedef short s16x4 __attribute__((ext_vector_type(4)));
#define FA_SBAR() __builtin_amdgcn_sched_barrier(0)
constexpr float THR2 = 11.5f;
template <int DK> __device__ __forceinline__ int kswz(int row, int colB) { return DK == 64 ? row * 128 + (colB ^ (((row >> 1) & 7) << 4)) : row * 256 + (colB ^ ((row & 7) << 4)); }
template <int NCB> __device__ __forceinline__ int v_st(int k, int c) { const int kk = (k & ~0xC) | ((k & 4) << 1) | ((k & 8) >> 1); return ((kk >> 3) * NCB + (c >> 5)) * 512 + ((kk & 7) * 32 + (c & 31)) * 2; }
__device__ __forceinline__ int v_rd_base(int lane) { return ((lane & 3) << 3) | (((lane >> 2) & 3) << 6) | (((lane >> 4) & 1) << 5) | (((lane >> 5) & 1) << 8); }
template <int OFF> __device__ __forceinline__ s16x4 tr_read(int vb) { s16x4 r; asm volatile("ds_read_b64_tr_b16 %0, %1 offset:%2" : "=&v"(r) : "v"(vb), "i"(OFF) : "memory"); return r; }
__device__ __forceinline__ unsigned cvtpk(float lo, float hi) { unsigned r; asm volatile("v_cvt_pk_bf16_f32 %0, %1, %2" : "=v"(r) : "v"(lo), "v"(hi)); return r; }

constexpr float C0 = 8.0f;
__device__ __forceinline__ void partialSM(f32x16& p0) {
#pragma unroll
  for (int r = 0; r < 16; ++r) p0[r] = __builtin_amdgcn_exp2f(p0[r]);
}
__device__ __forceinline__ void finishSM(f32x16& p0, f32x16& p1, float& l_reg, bf16x8& pa0, bf16x8& pa1, bf16x8& pa2, bf16x8& pa3) {
#pragma unroll
  for (int r = 0; r < 16; ++r) p1[r] = __builtin_amdgcn_exp2f(p1[r]);
  float ps = 0;
#pragma unroll
  for (int r = 0; r < 16; ++r) ps += p0[r];
#pragma unroll
  for (int r = 0; r < 16; ++r) ps += p1[r];
  { auto rr = __builtin_amdgcn_permlane32_swap(__float_as_uint(ps), __float_as_uint(ps), false, false); ps = __uint_as_float(rr[0]) + __uint_as_float(rr[1]); }
  l_reg += ps;
#define FA_PK4(P, BASE, OUT) do { unsigned a0 = cvtpk(P[BASE + 0], P[BASE + 1]), a1 = cvtpk(P[BASE + 2], P[BASE + 3]);   \
    unsigned b0 = cvtpk(P[BASE + 4], P[BASE + 5]), b1 = cvtpk(P[BASE + 6], P[BASE + 7]);                              \
    auto r0 = __builtin_amdgcn_permlane32_swap(a0, b0, false, false); auto r1 = __builtin_amdgcn_permlane32_swap(a1, b1, false, false); \
    u32x4 w = {r0[0], r1[0], r0[1], r1[1]}; OUT = __builtin_bit_cast(bf16x8, w); } while (0)
  FA_PK4(p0, 0, pa0); FA_PK4(p0, 8, pa1); FA_PK4(p1, 0, pa2); FA_PK4(p1, 8, pa3);
#undef FA_PK4
}
__device__ __forceinline__ void swa_mask(f32x16& p0, f32x16& p1, int kt, int tq, int hi, float slope2) {
  const int kb = kt + 4 * hi - tq;
#pragma unroll
  for (int r = 0; r < 16; ++r) { int d = kb + (r & 3) + 8 * (r >> 2); int d2 = d + 32; d = d < 0 ? -d : d; d2 = d2 < 0 ? -d2 : d2;
    p0[r] = d <= 128 ? p0[r] - slope2 * (float)d : -INFINITY; p1[r] = d2 <= 128 ? p1[r] - slope2 * (float)d2 : -INFINITY; }
}
__device__ __forceinline__ void swa_maskf(f32x16& p0, f32x16& p1, int kt, int tq, int hi, float slope2) {
  const float kb = (float)(kt + 4 * hi - tq), ns = -slope2;
#pragma unroll
  for (int r = 0; r < 16; ++r) { const float x = kb + (float)((r & 3) + 8 * (r >> 2)), x2 = kb + (float)((r & 3) + 8 * (r >> 2) + 32);
    const float t0 = __builtin_fmaf(ns, __builtin_fabsf(x), p0[r]), t1 = __builtin_fmaf(ns, __builtin_fabsf(x2), p1[r]);
    p0[r] = __builtin_fabsf(x) <= 128.0f ? t0 : -INFINITY; p1[r] = __builtin_fabsf(x2) <= 128.0f ? t1 : -INFINITY; }
}
__device__ __forceinline__ void swa_bias(f32x16& p0, f32x16& p1, int kt, int tq, int hi, float slope2) {
  const float kb = (float)(kt + 4 * hi - tq), ns = -slope2;
#pragma unroll
  for (int r = 0; r < 16; ++r) { const float x = kb + (float)((r & 3) + 8 * (r >> 2)), x2 = kb + (float)((r & 3) + 8 * (r >> 2) + 32);
    p0[r] = __builtin_fmaf(ns, __builtin_fabsf(x), p0[r]); p1[r] = __builtin_fmaf(ns, __builtin_fabsf(x2), p1[r]); }
}
template <int DK> __device__ __forceinline__ void qkt(f32x16& p0, f32x16& p1, const LAS unsigned char* Ks, const bf16x8* qr, int r32, int hi) {
#pragma unroll
  for (int r = 0; r < 16; ++r) { p0[r] = -C0; p1[r] = -C0; }
#pragma unroll
  for (int d0 = 0; d0 < DK / 16; ++d0) { const int cb = (d0 * 16 + hi * 8) * 2;
    const bf16x8 b0 = *(const LAS bf16x8*)(Ks + kswz<DK>(r32, cb));
    const bf16x8 b1 = *(const LAS bf16x8*)(Ks + kswz<DK>(32 + r32, cb));
    p0 = __builtin_amdgcn_mfma_f32_32x32x16_bf16(b0, qr[d0], p0, 0, 0, 0);
    p1 = __builtin_amdgcn_mfma_f32_32x32x16_bf16(b1, qr[d0], p1, 0, 0, 0); }
}
template <int DK> __device__ __forceinline__ void qkt4(f32x16& p0, f32x16& p1, const LAS unsigned char* const (&ka)[4], int boff, const bf16x8* qr) {
  constexpr int RSK_ = (DK == 64) ? 128 : 256;
#pragma unroll
  for (int r = 0; r < 16; ++r) { p0[r] = -C0; p1[r] = -C0; }
#pragma unroll
  for (int d0 = 0; d0 < DK / 16; ++d0) { const LAS unsigned char* a_ = ka[d0 & 3] + boff + (d0 >> 2) * 128;
    const bf16x8 b0 = *(const LAS bf16x8*)(a_);
    const bf16x8 b1 = *(const LAS bf16x8*)(a_ + 32 * RSK_);
    p0 = __builtin_amdgcn_mfma_f32_32x32x16_bf16(b0, qr[d0], p0, 0, 0, 0);
    p1 = __builtin_amdgcn_mfma_f32_32x32x16_bf16(b1, qr[d0], p1, 0, 0, 0); }
}
template <int NCB, int D0> __device__ __forceinline__ void pv_one(f32x16& od, int vb, bf16x8 pa0, bf16x8 pa1, bf16x8 pa2, bf16x8 pa3) {
  constexpr int KS = 2 * NCB * 512, HF = NCB * 512;
  const s16x4 l0 = tr_read<D0 * 512 + 0 * KS>(vb), h0 = tr_read<D0 * 512 + 0 * KS + HF>(vb), l1 = tr_read<D0 * 512 + 1 * KS>(vb), h1 = tr_read<D0 * 512 + 1 * KS + HF>(vb);
  const s16x4 l2 = tr_read<D0 * 512 + 2 * KS>(vb), h2 = tr_read<D0 * 512 + 2 * KS + HF>(vb), l3 = tr_read<D0 * 512 + 3 * KS>(vb), h3 = tr_read<D0 * 512 + 3 * KS + HF>(vb);
  asm volatile("s_waitcnt lgkmcnt(0)" ::: "memory"); FA_SBAR();
#define FA_PK(L, H) (bf16x8){L[0], L[1], L[2], L[3], H[0], H[1], H[2], H[3]}
  od = __builtin_amdgcn_mfma_f32_32x32x16_bf16(pa0, FA_PK(l0, h0), od, 0, 0, 0);
  od = __builtin_amdgcn_mfma_f32_32x32x16_bf16(pa1, FA_PK(l1, h1), od, 0, 0, 0);
  od = __builtin_amdgcn_mfma_f32_32x32x16_bf16(pa2, FA_PK(l2, h2), od, 0, 0, 0);
  od = __builtin_amdgcn_mfma_f32_32x32x16_bf16(pa3, FA_PK(l3, h3), od, 0, 0, 0);
#undef FA_PK
}
template <int NCB> __device__ __forceinline__ void pv_d0(f32x16* o, int vb, bf16x8 pa0, bf16x8 pa1, bf16x8 pa2, bf16x8 pa3) {
  pv_one<NCB, 0>(o[0], vb, pa0, pa1, pa2, pa3); pv_one<NCB, 1>(o[1], vb, pa0, pa1, pa2, pa3);
  if constexpr (NCB == 4) { pv_one<NCB, 2>(o[2], vb, pa0, pa1, pa2, pa3); pv_one<NCB, 3>(o[3], vb, pa0, pa1, pa2, pa3); }
}

template <int DK, int DV, int MODE, int QMODE, int LDQ, int LDK, int LDV, int LDO, int SD>
__device__ __forceinline__ void attn_unit(const bf16* __restrict__ Qb, const bf16* __restrict__ Kh, const bf16* __restrict__ Vh, bf16* __restrict__ Ob, int NT, int tq0, int klo, float slope2, float sink2, const float* __restrict__ qgain, int krope_off, LAS unsigned char* lds) {
  constexpr int NCB = DV / 32, NQ = DK / 16, RSK = (DK == 64) ? 128 : 256, SHM_K = 64 * RSK, SHM_V = 64 * DV * 2, KVBLK = 64;
  constexpr int KPR = DK / 8, VPR = DV / 8, NKP = (64 * KPR + 511) / 512, NVP = (64 * VPR) / 512, NLD = NKP + NVP;
  constexpr bool DMA = (DK == 96 && MODE == 0), DMAX = (DK == 128 && MODE == 0);
  constexpr int NBUF = (DMA || DMAX) ? 4 : 2;
  const int tid = tid_now(), wid = tid >> 6, lane = tid & 63, r32 = lane & 31, hi = lane >> 5;
  LAS unsigned char* const V_lds = lds; LAS unsigned char* const K_lds = lds + NBUF * SHM_V;
  LAS float* wsf = (LAS float*)(lds + (NBUF * (SHM_V + SHM_K) >= RING_BYTES ? RING_BYTES + 4096 : NBUF * (SHM_V + SHM_K))) + wid * 64; LAS float* li_l = wsf; LAS float* al_l = wsf + 32;
  bf16x8 qr[NQ];
  const bf16* Qw = Qb + (size_t)(wid * 32 + r32) * LDQ + hi * 8;
#pragma unroll
  for (int d0 = 0; d0 < NQ; ++d0) qr[d0] = *(const bf16x8*)(Qw + d0 * 16);
  const int tq = tq0 + wid * 32 + r32;
  {
    float qf[NQ][8]; float ssq = 0.f;
#pragma unroll
    for (int d0 = 0; d0 < NQ; ++d0)
#pragma unroll
      for (int j = 0; j < 8; ++j) { qf[d0][j] = bf2f((unsigned short)qr[d0][j]); ssq += qf[d0][j] * qf[d0][j]; }
    { auto rr = __builtin_amdgcn_permlane32_swap(__float_as_uint(ssq), __float_as_uint(ssq), false, false); ssq = __uint_as_float(rr[0]) + __uint_as_float(rr[1]); }
    const float sc = __builtin_amdgcn_rsqf(ssq * (1.0f / DK) + EPS) * (DK == 96 ? 0.10206207261596575f : (DK == 64 ? 0.125f : 0.08838834764831845f)) * LOG2E;
#pragma unroll
    for (int d0 = 0; d0 < NQ; ++d0) { const f32x4 g0 = *(const f32x4*)(qgain + d0 * 16 + hi * 8), g1 = *(const f32x4*)(qgain + d0 * 16 + hi * 8 + 4);
#pragma unroll
      for (int j = 0; j < 4; ++j) { qf[d0][j] *= sc * g0[j]; qf[d0][4 + j] *= sc * g1[j]; } }
    if constexpr (QMODE == 0) {
#pragma unroll
      for (int j = 0; j < 8; ++j) { float sn, cs; fast_sincos((float)tq * __builtin_amdgcn_exp2f(-(float)(2 * (hi * 8 + j)) * (13.287712379549449f / 32.0f)), sn, cs);
        const float x1 = qf[4][j], x2 = qf[5][j]; qf[4][j] = x1 * cs - x2 * sn; qf[5][j] = x1 * sn + x2 * cs; }
    } else if constexpr (QMODE == 2) {
      const int prow = tq >> 6, pcol = tq & 63;
#pragma unroll
      for (int d = 0; d < 2; ++d)
#pragma unroll
        for (int j = 0; j < 8; ++j) { const float inv = __builtin_amdgcn_exp2f(-(float)(2 * (d * 16 + hi * 8 + j)) * (13.287712379549449f / 64.0f)); float sn, cs;
          fast_sincos((float)prow * inv, sn, cs); float x1 = qf[d][j], x2 = qf[d + 2][j]; qf[d][j] = x1 * cs - x2 * sn; qf[d + 2][j] = x1 * sn + x2 * cs;
          fast_sincos((float)pcol * inv, sn, cs); x1 = qf[4 + d][j]; x2 = qf[6 + d][j]; qf[4 + d][j] = x1 * cs - x2 * sn; qf[6 + d][j] = x1 * sn + x2 * cs; }
    }
#pragma unroll
    for (int d0 = 0; d0 < NQ; ++d0) { const u32x4 w = {cvtpk(qf[d0][0], qf[d0][1]), cvtpk(qf[d0][2], qf[d0][3]), cvtpk(qf[d0][4], qf[d0][5]), cvtpk(qf[d0][6], qf[d0][7])}; qr[d0] = __builtin_bit_cast(bf16x8, w); }
  }
  asm volatile("" ::: "memory");
  float l_reg = MODE ? __builtin_amdgcn_exp2f(sink2 - C0) : 0.f; f32x16 o[NCB];
#pragma unroll
  for (int d = 0; d < NCB; ++d)
#pragma unroll
    for (int r = 0; r < 16; ++r) o[d][r] = 0.f;
  if constexpr (DMA) {
    const int widu = __builtin_amdgcn_readfirstlane(wid);
    int kgo[2], vgo;
#pragma unroll
    for (int i = 0; i < 2; ++i) { const int row = 4 * (wid * 2 + i) + (lane >> 4), cp_ = lane & 15; int c8 = (cp_ & 8) | ((cp_ & 7) ^ (row & 7)); if (c8 >= 12) c8 -= 4;
      kgo[i] = row * LDK + (c8 < 8 ? c8 * 8 : krope_off + (c8 - 8) * 8); }
    { const int kk = wid * 8 + ((lane & 31) >> 2), c = (lane >> 5) * 32 + (lane & 3) * 8, k_ = (kk & ~0xC) | ((kk & 4) << 1) | ((kk & 8) >> 1); vgo = k_ * LDV + c; }
    const int vb0 = (int)(unsigned)(uintptr_t)V_lds + v_rd_base(lane);
#define FA_DMA(t, b) do { const int t_ = (t) < NT ? (t) : NT - 1; const bf16* kp_ = Kh + (size_t)t_ * KVBLK * LDK; const bf16* vp_ = Vh + (size_t)t_ * KVBLK * LDV; \
      __builtin_amdgcn_global_load_lds((const unsigned*)(kp_ + kgo[0]), (LAS unsigned*)(K_lds + (b) * SHM_K + (widu * 2 + 0) * 1024), 16, 0, 0); \
      __builtin_amdgcn_global_load_lds((const unsigned*)(kp_ + kgo[1]), (LAS unsigned*)(K_lds + (b) * SHM_K + (widu * 2 + 1) * 1024), 16, 0, 0); \
      __builtin_amdgcn_global_load_lds((const unsigned*)(vp_ + vgo), (LAS unsigned*)(V_lds + (b) * SHM_V + widu * 1024), 16, 0, 0); } while (0)
#define FA_LAND(n) do { asm volatile("s_waitcnt vmcnt(" #n ")" ::: "memory"); __builtin_amdgcn_s_barrier(); asm volatile("" ::: "memory"); } while (0)
    f32x16 pA0, pA1, pB0, pB1; bf16x8 pa0, pa1, pa2, pa3;
    asm volatile("s_waitcnt vmcnt(0)" ::: "memory");
    __syncthreads();
    if (__builtin_amdgcn_readfirstlane(tid) >= 256) __builtin_amdgcn_s_setprio(1);
    FA_DMA(0, 0); FA_DMA(1, 1); FA_DMA(2, 2);
    FA_LAND(6);
    qkt<DK>(pA0, pA1, K_lds, qr, r32, hi); partialSM(pA0);
    FA_LAND(3);
    for (int j = 1; j + 1 < NT; j += 2) {
      FA_DMA(j + 2, (j + 2) & 3);
      FA_SBAR(); qkt<DK>(pB0, pB1, K_lds + (j & 3) * SHM_K, qr, r32, hi);
      finishSM(pA0, pA1, l_reg, pa0, pa1, pa2, pa3); FA_SBAR();
      pv_d0<NCB>(o, vb0 + ((j - 1) & 3) * SHM_V, pa0, pa1, pa2, pa3); partialSM(pB0);
      FA_LAND(3);
      FA_DMA(j + 3, (j + 3) & 3);
      FA_SBAR(); qkt<DK>(pA0, pA1, K_lds + ((j + 1) & 3) * SHM_K, qr, r32, hi);
      finishSM(pB0, pB1, l_reg, pa0, pa1, pa2, pa3); FA_SBAR();
      pv_d0<NCB>(o, vb0 + (j & 3) * SHM_V, pa0, pa1, pa2, pa3); partialSM(pA0);
      FA_LAND(3);
    }
    FA_SBAR(); qkt<DK>(pB0, pB1, K_lds + ((NT - 1) & 3) * SHM_K, qr, r32, hi);
    finishSM(pA0, pA1, l_reg, pa0, pa1, pa2, pa3); FA_SBAR();
    pv_d0<NCB>(o, vb0 + ((NT - 2) & 3) * SHM_V, pa0, pa1, pa2, pa3); partialSM(pB0);
    finishSM(pB0, pB1, l_reg, pa0, pa1, pa2, pa3); FA_SBAR();
    pv_d0<NCB>(o, vb0 + ((NT - 1) & 3) * SHM_V, pa0, pa1, pa2, pa3);
    asm volatile("s_waitcnt vmcnt(0)" ::: "memory");
#undef FA_DMA
#undef FA_LAND
  } else if constexpr (DMAX) {
    const int widu = __builtin_amdgcn_readfirstlane(wid);
    constexpr int NVB = SHM_V / 8192;
    const LAS unsigned char* ka[4];
#pragma unroll
    for (int m = 0; m < 4; ++m) ka[m] = K_lds + r32 * RSK + (((m * 32) | (hi * 16)) ^ ((r32 & 7) << 4));
    const int vb0 = (int)(unsigned)(uintptr_t)V_lds + v_rd_base(lane);
#define FA_DMA(t, b) do { const int t_ = (t) < NT ? (t) : NT - 1; const bf16* kp_ = Kh + (size_t)t_ * KVBLK * LDK; const bf16* vp_ = Vh + (size_t)t_ * KVBLK * LDV; \
      int ln_ = lane; asm volatile("" : "+v"(ln_)); \
      _Pragma("unroll") for (int i_ = 0; i_ < 2; ++i_) { const int row_ = 4 * (widu * 2 + i_) + (ln_ >> 4), cp_ = ln_ & 15; const int c8_ = (cp_ & 8) | ((cp_ & 7) ^ (row_ & 7)); \
        __builtin_amdgcn_global_load_lds((const unsigned*)(kp_ + (row_ * LDK + c8_ * 8)), (LAS unsigned*)(K_lds + (b) * SHM_K + (widu * 2 + i_) * 1024), 16, 0, 0); } \
      _Pragma("unroll") for (int i_ = 0; i_ < NVB; ++i_) { const int st_ = 2 * (widu * NVB + i_) + (ln_ >> 5), kk_ = (st_ / NCB) * 8 + ((ln_ & 31) >> 2), c_ = (st_ % NCB) * 32 + (ln_ & 3) * 8, k_ = (kk_ & ~0xC) | ((kk_ & 4) << 1) | ((kk_ & 8) >> 1); \
        __builtin_amdgcn_global_load_lds((const unsigned*)(vp_ + (k_ * LDV + c_)), (LAS unsigned*)(V_lds + (b) * SHM_V + (widu * NVB + i_) * 1024), 16, 0, 0); } } while (0)
#define FA_LAND(n) do { asm volatile("s_waitcnt vmcnt(%0)" :: "n"((n) * (2 + NVB)) : "memory"); __builtin_amdgcn_s_barrier(); asm volatile("" ::: "memory"); } while (0)
    f32x16 pA0, pA1, pB0, pB1; bf16x8 pa0, pa1, pa2, pa3;
    asm volatile("s_waitcnt vmcnt(0)" ::: "memory");
    __syncthreads();
    if (__builtin_amdgcn_readfirstlane(tid) >= 256) __builtin_amdgcn_s_setprio(1);
    FA_DMA(0, 0); FA_DMA(1, 1);
    FA_LAND(1);
    qkt4<DK>(pA0, pA1, ka, 0, qr); FA_DMA(2, 2); partialSM(pA0);
    FA_LAND(1);
#define FA_HALF(PN0, PN1, PP0, PP1, jt, bn, bp) do { \
      FA_SBAR(); qkt4<DK>(PN0, PN1, ka, (bn) * SHM_K, qr); \
      finishSM(PP0, PP1, l_reg, pa0, pa1, pa2, pa3); FA_SBAR(); \
      FA_DMA((jt) + 2, ((bn) + 2) & 3); FA_SBAR(); \
      pv_d0<NCB>(o, vb0 + (bp) * SHM_V, pa0, pa1, pa2, pa3); partialSM(PN0); \
      FA_LAND(1); } while (0)
    for (int j = 1; j + 4 < NT; j += 4) {
      FA_HALF(pB0, pB1, pA0, pA1, j, 1, 0); FA_HALF(pA0, pA1, pB0, pB1, j + 1, 2, 1); FA_HALF(pB0, pB1, pA0, pA1, j + 2, 3, 2); FA_HALF(pA0, pA1, pB0, pB1, j + 3, 0, 3);
    }
    FA_HALF(pB0, pB1, pA0, pA1, NT - 3, 1, 0); FA_HALF(pA0, pA1, pB0, pB1, NT - 2, 2, 1);
    FA_SBAR(); qkt4<DK>(pB0, pB1, ka, 3 * SHM_K, qr);
    finishSM(pA0, pA1, l_reg, pa0, pa1, pa2, pa3); FA_SBAR();
    pv_d0<NCB>(o, vb0 + 2 * SHM_V, pa0, pa1, pa2, pa3); partialSM(pB0);
    finishSM(pB0, pB1, l_reg, pa0, pa1, pa2, pa3); FA_SBAR();
    pv_d0<NCB>(o, vb0 + 3 * SHM_V, pa0, pa1, pa2, pa3);
    asm volatile("s_waitcnt vmcnt(0)" ::: "memory");
#undef FA_HALF
#undef FA_DMA
#undef FA_LAND
  } else {
  int kg[NKP], kl[NKP]; bool kok[NKP]; int vg[NVP], vl[NVP];
#pragma unroll
  for (int i = 0; i < NKP; ++i) { int p = tid + 512 * i; kok[i] = p < 64 * KPR; if (!kok[i]) p = tid; const int row = p / KPR, c8 = p % KPR; kg[i] = row * LDK + ((DK == 96 && c8 >= 8) ? krope_off + (c8 - 8) * 8 : c8 * 8); kl[i] = kswz<DK>(row, c8 * 16); }
#pragma unroll
  for (int i = 0; i < NVP; ++i) { const int p = tid + 512 * i; const int row = p / VPR, c8 = p % VPR; vg[i] = row * LDV + c8 * 8; vl[i] = v_st<NCB>(row, c8 * 8); }
  const int vb0 = (int)(unsigned)(uintptr_t)V_lds + v_rd_base(lane);
  bf16x8 skS[SD][NKP], svS[SD][NVP]; constexpr int SE = 0, SO = SD - 1;
#define FA_SLOAD(SK, SV, k0) do { _Pragma("unroll") for (int _j = 0; _j < NVP; ++_j) SV[_j] = *(const bf16x8*)(Vh + (size_t)(k0) * LDV + vg[_j]); \
    _Pragma("unroll") for (int _j = 0; _j < NKP; ++_j) SK[_j] = *(const bf16x8*)(Kh + (size_t)(k0) * LDK + kg[_j]); } while (0)
#define FA_SWRITE(b, SK, SV) do { _Pragma("unroll") for (int _j = 0; _j < NVP; ++_j) *(LAS bf16x8*)(V_lds + (b) * SHM_V + vl[_j]) = SV[_j]; \
    _Pragma("unroll") for (int _j = 0; _j < NKP; ++_j) if (kok[_j]) *(LAS bf16x8*)(K_lds + (b) * SHM_K + kl[_j]) = SK[_j]; } while (0)
#define FA_SWAIT() asm volatile("s_waitcnt vmcnt(%0)" :: "n"(SD == 2 ? NLD : 0) : "memory")
  f32x16 pA0, pA1, pB0, pB1; bf16x8 pa0, pa1, pa2, pa3;
  const int tqw = MODE ? __builtin_amdgcn_readfirstlane(tq0 + wid * 32) : 0;
#define FA_CLS(i) (!MODE ? 2 : ((klo + (i) * KVBLK + 63 < tqw - 128 || klo + (i) * KVBLK > tqw + 159) ? 0 : ((klo + (i) * KVBLK >= tqw - 97 && klo + (i) * KVBLK + 63 <= tqw + 128) ? 2 : 1)))
#define FA_QK(P0, P1, b, c) do { if (c) qkt<DK>(P0, P1, K_lds + (b) * SHM_K, qr, r32, hi); } while (0)
#define FA_MSK(P0, P1, i, c) do { if (c) { if (MODE) { if ((c) == 1) swa_maskf(P0, P1, klo + (i) * KVBLK, tq, hi, slope2); else swa_bias(P0, P1, klo + (i) * KVBLK, tq, hi, slope2); } partialSM(P0); } } while (0)
#define FA_FIN(P0, P1, c) do { if (c) finishSM(P0, P1, l_reg, pa0, pa1, pa2, pa3); } while (0)
#define FA_PV(vb, c) do { if (c) pv_d0<NCB>(o, vb, pa0, pa1, pa2, pa3); } while (0)
  __syncthreads();
  if (__builtin_amdgcn_readfirstlane(tid) >= 256) __builtin_amdgcn_s_setprio(1);
  int cA = FA_CLS(0), cB;
  FA_SLOAD(skS[SE], svS[SE], 0); asm volatile("s_waitcnt vmcnt(0)" ::: "memory"); FA_SWRITE(0, skS[SE], svS[SE]); __syncthreads();
  FA_QK(pA0, pA1, 0, cA); FA_MSK(pA0, pA1, 0, cA);
  FA_SLOAD(skS[SO], svS[SO], KVBLK); if (SD == 2) FA_SLOAD(skS[SE], svS[SE], 2 * KVBLK);
  FA_SWAIT(); FA_SWRITE(1, skS[SO], svS[SO]); __syncthreads();
  for (int j = 1; j + 1 < NT; j += 2) {
    cB = FA_CLS(j);
    FA_SBAR(); FA_QK(pB0, pB1, 1, cB);
    FA_FIN(pA0, pA1, cA); FA_SBAR();
    FA_SLOAD(skS[SO], svS[SO], (j + SD) * KVBLK); FA_SBAR();
    FA_PV(vb0, cA); FA_MSK(pB0, pB1, j, cB);
    __syncthreads(); FA_SWAIT(); FA_SWRITE(0, skS[SE], svS[SE]);
    __syncthreads();
    cA = FA_CLS(j + 1);
    FA_SBAR(); FA_QK(pA0, pA1, 0, cA);
    FA_FIN(pB0, pB1, cB); FA_SBAR();
    { const int tn_ = j + 1 + SD < NT ? j + 1 + SD : NT - 1; FA_SLOAD(skS[SE], svS[SE], tn_ * KVBLK); } FA_SBAR();
    FA_PV(vb0 + SHM_V, cB); FA_MSK(pA0, pA1, j + 1, cA);
    __syncthreads(); FA_SWAIT(); FA_SWRITE(1, skS[SO], svS[SO]);
    __syncthreads();
  }
  cB = FA_CLS(NT - 1);
  FA_SBAR(); FA_QK(pB0, pB1, 1, cB);
  FA_FIN(pA0, pA1, cA); FA_SBAR();
  FA_PV(vb0, cA); FA_MSK(pB0, pB1, NT - 1, cB);
  __syncthreads();
  FA_FIN(pB0, pB1, cB); FA_SBAR();
  FA_PV(vb0 + SHM_V, cB);
#undef FA_CLS
#undef FA_QK
#undef FA_MSK
#undef FA_FIN
#undef FA_PV
  }
  __builtin_amdgcn_s_setprio(0);
  if (hi == 0) li_l[r32] = l_reg; asm volatile("s_waitcnt lgkmcnt(0)" ::: "memory");
  float rli[16];
#pragma unroll
  for (int r = 0; r < 16; ++r) rli[r] = __builtin_amdgcn_rcpf(li_l[crow(r, hi)]);
  bf16* Ow = Ob + (size_t)(wid * 32) * LDO; const bool odd = lane & 1;
#pragma unroll
  for (int d0 = 0; d0 < NCB; ++d0)
#pragma unroll
    for (int r = 0; r < 16; r += 2) {
      const float a = o[d0][r] * rli[r], b = o[d0][r + 1] * rli[r + 1];
      const float x = odd ? a : b;
      const float y = __uint_as_float((unsigned)__builtin_amdgcn_update_dpp(0, (int)__float_as_uint(x), 0xB1, 0xF, 0xF, false));
      const unsigned w = odd ? cvtpk(y, b) : cvtpk(a, y);
      const int orow = crow(odd ? r + 1 : r, hi);
      *(unsigned*)(Ow + (size_t)orow * LDO + d0 * 32 + (r32 & ~1)) = w; }
#undef FA_SLOAD
#undef FA_SWRITE
#undef FA_SWAIT
}
}

__device__ __forceinline__ void xb_rows(const Frame& F, const float* x, bf16* xb, ssq_t* ss) {
    for (int m0 = F.gw * 4; m0 < T; m0 += F.ngw * 4) {
        f32x4 v[4][4];
#pragma unroll
        for (int r = 0; r < 4; ++r)
#pragma unroll
            for (int j = 0; j < 4; ++j) v[r][j] = __builtin_nontemporal_load((const f32x4*)(x + (size_t)(m0 + r) * D) + F.lane + 64 * j);
#pragma unroll
        for (int r = 0; r < 4; ++r) { u32x2* o8 = (u32x2*)(xb + (size_t)(m0 + r) * D) + F.lane; float s = 0.f;
#pragma unroll
            for (int j = 0; j < 4; ++j) { const f32x4 w = v[r][j]; s += (w.x * w.x + w.y * w.y) + (w.z * w.z + w.w * w.w); o8[64 * j] = (u32x2){hpk2(w.x, w.y), hpk2(w.z, w.w)}; }
            s = wave_sum(s); if (F.lane == 0) ss_set(ss, m0 + r, s); }
    }
}
__device__ __forceinline__ void cvt_flat(const Frame& F, const float* src, bf16* dst, size_t n8) {
    const size_t stride = (size_t)F.ngw * 64;
    for (size_t i = (size_t)F.gw * 64 + F.lane; i < n8; i += 4 * stride) {
        f32x4 a[4], b[4];
#pragma unroll
        for (int u = 0; u < 4; ++u) if (i + u * stride < n8) { a[u] = __builtin_nontemporal_load((const f32x4*)src + 2 * (i + u * stride)); b[u] = __builtin_nontemporal_load((const f32x4*)src + 2 * (i + u * stride) + 1); }
#pragma unroll
        for (int u = 0; u < 4; ++u) if (i + u * stride < n8) ((u32x4*)dst)[i + u * stride] = (u32x4){hpk2(a[u].x, a[u].y), hpk2(a[u].z, a[u].w), hpk2(b[u].x, b[u].y), hpk2(b[u].z, b[u].w)};
    }
}
__device__ __forceinline__ float quad_sum(float v, int lpv) { for (int o = 1; o < lpv; o <<= 1) v += __shfl_xor(v, o); return v; }
__device__ __forceinline__ void unpack8(const u32x4 a, float* v) { v[0] = bflo(a.x); v[1] = bfhi(a.x); v[2] = bflo(a.y); v[3] = bfhi(a.y); v[4] = bflo(a.z); v[5] = bfhi(a.z); v[6] = bflo(a.w); v[7] = bfhi(a.w); }
__device__ __forceinline__ void mla_kprep(const Frame& F, bf16* KV, const bf16* C, const float* kg) {
    const int h = F.lane >> 2, s = F.lane & 3; constexpr int R = 4;
    float gk[24], inv[4];
#pragma unroll
    for (int i = 0; i < 16; ++i) gk[i] = kg[16 * s + i];
#pragma unroll
    for (int i = 0; i < 4; ++i) { gk[16 + i] = kg[64 + 4 * s + i]; gk[20 + i] = kg[80 + 4 * s + i]; inv[i] = exp2f(-(float)(2 * (4 * s + i)) * (1.0f / 32.0f) * 13.287712379549449f); }
    for (int m0 = F.gw * R; m0 < T; m0 += F.ngw * R) {
        u32x4 a[R], b[R]; u32x2 r1[R], r2[R];
#pragma unroll
        for (int r = 0; r < R; ++r) { const bf16* nope = KV + (size_t)(m0 + r) * 2560 + h * 64 + 16 * s; const bf16* rs = C + (size_t)(m0 + r) * 512 + 384 + 4 * s;
            a[r] = *(const u32x4*)nope; b[r] = *(const u32x4*)(nope + 8); r1[r] = *(const u32x2*)rs; r2[r] = *(const u32x2*)(rs + 16); }
#pragma unroll
        for (int r = 0; r < R; ++r) { const int t = (m0 + r) & (S - 1); float v[24];
            unpack8(a[r], v); unpack8(b[r], v + 8);
            v[16] = bflo(r1[r].x); v[17] = bfhi(r1[r].x); v[18] = bflo(r1[r].y); v[19] = bfhi(r1[r].y); v[20] = bflo(r2[r].x); v[21] = bfhi(r2[r].x); v[22] = bflo(r2[r].y); v[23] = bfhi(r2[r].y);
            float q = 0.f;
#pragma unroll
            for (int i = 0; i < 24; ++i) q += v[i] * v[i];
            q = quad_sum(q, 4);
            const float sc = 1.0f / sqrtf(q * (1.0f / 96.0f) + EPS);
#pragma unroll
            for (int i = 0; i < 24; ++i) v[i] *= sc * gk[i];
#pragma unroll
            for (int i = 0; i < 4; ++i) { float sn, cs; sincosf((float)t * inv[i], &sn, &cs); const float x1 = v[16 + i], x2 = v[20 + i]; v[16 + i] = x1 * cs - x2 * sn; v[20 + i] = x1 * sn + x2 * cs; }
            bf16* nope = KV + (size_t)(m0 + r) * 2560 + h * 64 + 16 * s;
            *(u32x4*)nope = (u32x4){hpk2(v[0], v[1]), hpk2(v[2], v[3]), hpk2(v[4], v[5]), hpk2(v[6], v[7])};
            *(u32x4*)(nope + 8) = (u32x4){hpk2(v[8], v[9]), hpk2(v[10], v[11]), hpk2(v[12], v[13]), hpk2(v[14], v[15])};
            bf16* rd = KV + (size_t)(m0 + r) * 2560 + 1024 + h * 32 + 4 * s;
            *(u32x2*)rd = (u32x2){hpk2(v[16], v[17]), hpk2(v[18], v[19])}; *(u32x2*)(rd + 16) = (u32x2){hpk2(v[20], v[21]), hpk2(v[22], v[23])}; }
    }
}
__device__ __forceinline__ void swa_kprep(const Frame& F, bf16* QKV, const float* kg) {
    const int tk = F.lane >> 4, hv = (F.lane >> 2) & 3, s = F.lane & 3; constexpr int R = 2;
    float gk[16];
#pragma unroll
    for (int i = 0; i < 16; ++i) gk[i] = kg[16 * s + i];
    for (int m0 = F.gw * 4 * R; m0 < T; m0 += F.ngw * 4 * R) {
        u32x4 a[R], b[R];
#pragma unroll
        for (int r = 0; r < R; ++r) { const bf16* p = QKV + (size_t)(m0 + 4 * r + tk) * 1536 + 1024 + hv * 64 + 16 * s; a[r] = *(const u32x4*)p; b[r] = *(const u32x4*)(p + 8); }
#pragma unroll
        for (int r = 0; r < R; ++r) { float v[16]; unpack8(a[r], v); unpack8(b[r], v + 8); float q = 0.f;
#pragma unroll
            for (int i = 0; i < 16; ++i) q += v[i] * v[i];
            q = quad_sum(q, 4); const float sc = 1.0f / sqrtf(q * (1.0f / 64.0f) + EPS);
#pragma unroll
            for (int i = 0; i < 16; ++i) v[i] *= sc * gk[i];
            bf16* p = QKV + (size_t)(m0 + 4 * r + tk) * 1536 + 1024 + hv * 64 + 16 * s;
            *(u32x4*)p = (u32x4){hpk2(v[0], v[1]), hpk2(v[2], v[3]), hpk2(v[4], v[5]), hpk2(v[6], v[7])};
            *(u32x4*)(p + 8) = (u32x4){hpk2(v[8], v[9]), hpk2(v[10], v[11]), hpk2(v[12], v[13]), hpk2(v[14], v[15])}; }
    }
}
__device__ __forceinline__ void ax_kprep(const Frame& F, bf16* QKV, const float* kg) {
    const int tk = F.lane >> 5, hv = (F.lane >> 3) & 3, s = F.lane & 7; constexpr int R = 2;
    float gk[16], inv[4];
#pragma unroll
    for (int c = 0; c < 4; ++c)
#pragma unroll
        for (int i = 0; i < 4; ++i) gk[4 * c + i] = kg[32 * c + 4 * s + i];
#pragma unroll
    for (int i = 0; i < 4; ++i) inv[i] = exp2f(-(float)(2 * (4 * s + i)) * (1.0f / 64.0f) * 13.287712379549449f);
    for (int m0 = F.gw * 2 * R; m0 < T; m0 += F.ngw * 2 * R) {
        u32x2 w[R][4];
#pragma unroll
        for (int r = 0; r < R; ++r) { const bf16* p = QKV + (size_t)(m0 + 2 * r + tk) * 2048 + 1024 + hv * 128 + 4 * s;
#pragma unroll
            for (int c = 0; c < 4; ++c) w[r][c] = *(const u32x2*)(p + 32 * c); }
#pragma unroll
        for (int r = 0; r < R; ++r) { const int t = (m0 + 2 * r + tk) & (S - 1), prow = t >> 6, pcol = t & 63; float v[16];
#pragma unroll
            for (int c = 0; c < 4; ++c) { v[4 * c] = bflo(w[r][c].x); v[4 * c + 1] = bfhi(w[r][c].x); v[4 * c + 2] = bflo(w[r][c].y); v[4 * c + 3] = bfhi(w[r][c].y); }
            float q = 0.f;
#pragma unroll
            for (int i = 0; i < 16; ++i) q += v[i] * v[i];
            q = quad_sum(q, 8); const float sc = __builtin_amdgcn_rsqf(q * (1.0f / 128.0f) + EPS);
#pragma unroll
            for (int i = 0; i < 16; ++i) v[i] *= sc * gk[i];
#pragma unroll
            for (int i = 0; i < 4; ++i) { float sn, cs; fast_sincos((float)prow * inv[i], sn, cs); float x1 = v[i], x2 = v[4 + i];     v[i] = x1 * cs - x2 * sn; v[4 + i] = x1 * sn + x2 * cs;
                fast_sincos((float)pcol * inv[i], sn, cs); x1 = v[8 + i]; x2 = v[12 + i]; v[8 + i] = x1 * cs - x2 * sn; v[12 + i] = x1 * sn + x2 * cs; }
            bf16* p = QKV + (size_t)(m0 + 2 * r + tk) * 2048 + 1024 + hv * 128 + 4 * s;
#pragma unroll
            for (int c = 0; c < 4; ++c) *(u32x2*)(p + 32 * c) = (u32x2){hpk2(v[4 * c], v[4 * c + 1]), hpk2(v[4 * c + 2], v[4 * c + 3])}; }
    }
}

template <int DK, int DV, int MODE>
__device__ __forceinline__ void nattn_unit(const Frame& F, const bf16* Q, int ldq, const bf16* Kp, int ldk, const bf16* Vp, int ldv, bf16* O, int ldo, int q0, float slope2, float sink2) {
    constexpr int HK = DK / 2, HV = DV / 2;
    LAS bf16* Ks = (LAS bf16*)F.lds; LAS bf16* Vs = Ks + 64 * DK;
    const int qi = F.tid >> 1, half = F.tid & 1, t = q0 + qi;
    float q[HK], o[HV];
    { const bf16* qp = Q + (size_t)t * ldq + half * HK;
#pragma unroll
      for (int c = 0; c < HK / 8; ++c) { const u32x4 w = *(const u32x4*)(qp + 8 * c); q[8 * c] = bflo(w.x); q[8 * c + 1] = bfhi(w.x); q[8 * c + 2] = bflo(w.y); q[8 * c + 3] = bfhi(w.y);
          q[8 * c + 4] = bflo(w.z); q[8 * c + 5] = bfhi(w.z); q[8 * c + 6] = bflo(w.w); q[8 * c + 7] = bfhi(w.w); } }
#pragma unroll
    for (int i = 0; i < HV; ++i) o[i] = 0.f;
    float mx = MODE ? sink2 : -1e30f, l = MODE ? 1.f : 0.f;
    const int klo = MODE ? (q0 - 128 < 0 ? 0 : q0 - 128) : 0, khi = MODE ? (q0 + 384 > S ? S : q0 + 384) : S;
    for (int kt = klo; kt < khi; kt += 64) {
        __syncthreads();
        for (int p = F.tid; p < 64 * DK / 8; p += NTHREADS) { const int row = p / (DK / 8), c8 = p % (DK / 8); *(LAS u32x4*)(Ks + row * DK + c8 * 8) = *(const u32x4*)(Kp + (size_t)(kt + row) * ldk + c8 * 8); }
        for (int p = F.tid; p < 64 * DV / 8; p += NTHREADS) { const int row = p / (DV / 8), c8 = p % (DV / 8); *(LAS u32x4*)(Vs + row * DV + c8 * 8) = *(const u32x4*)(Vp + (size_t)(kt + row) * ldv + c8 * 8); }
        __syncthreads();
        for (int j = 0; j < 64; ++j) {
            const LAS u32x4* kr = (const LAS u32x4*)(Ks + j * DK + half * HK); float s = 0.f;
#pragma unroll
            for (int c = 0; c < HK / 8; ++c) { const u32x4 w = kr[c]; s += q[8 * c] * bflo(w.x) + q[8 * c + 1] * bfhi(w.x) + q[8 * c + 2] * bflo(w.y) + q[8 * c + 3] * bfhi(w.y)
                + q[8 * c + 4] * bflo(w.z) + q[8 * c + 5] * bfhi(w.z) + q[8 * c + 6] * bflo(w.w) + q[8 * c + 7] * bfhi(w.w); }
            s += __shfl_xor(s, 1);
            if (MODE) { int dist = t - (kt + j); dist = dist < 0 ? -dist : dist; if (dist > 128) continue; s -= slope2 * (float)dist; }
            if (s > mx) { const float corr = __builtin_amdgcn_exp2f(mx - s); l *= corr;
#pragma unroll
                for (int i = 0; i < HV; ++i) o[i] *= corr;
                mx = s; }
            const float p = __builtin_amdgcn_exp2f(s - mx); l += p;
            const LAS u32x4* vr = (const LAS u32x4*)(Vs + j * DV + half * HV);
#pragma unroll
            for (int c = 0; c < HV / 8; ++c) { const u32x4 w = vr[c]; o[8 * c] += p * bflo(w.x); o[8 * c + 1] += p * bfhi(w.x); o[8 * c + 2] += p * bflo(w.y); o[8 * c + 3] += p * bfhi(w.y);
                o[8 * c + 4] += p * bflo(w.z); o[8 * c + 5] += p * bfhi(w.z); o[8 * c + 6] += p * bflo(w.w); o[8 * c + 7] += p * bfhi(w.w); }
        }
    }
    const float rl = 1.0f / l; bf16* op = O + (size_t)t * ldo + half * HV;
#pragma unroll
    for (int c = 0; c < HV / 8; ++c) *(u32x4*)(op + 8 * c) = (u32x4){pk2(o[8 * c] * rl, o[8 * c + 1] * rl), pk2(o[8 * c + 2] * rl, o[8 * c + 3] * rl), pk2(o[8 * c + 4] * rl, o[8 * c + 5] * rl), pk2(o[8 * c + 6] * rl, o[8 * c + 7] * rl)};
}

__device__ __forceinline__ void moe_route(const Frame& F, const bf16* x, const float* gain, const float* Wr, const float* br, unsigned* cnt, unsigned* pub, int* idx, float* wl, float* rsl, int* tpos) {
    LAS int* lw = (LAS int*)(F.lds + 65536);
    float wr[16][8];
#pragma unroll
    for (int j = 0; j < 2; ++j)
#pragma unroll
        for (int i = 0; i < 8; ++i) { const int k = 512 * j + 8 * F.lane + i; const float g = gain[k]; const f32x4 a = *(const f32x4*)(Wr + k * 8), b = *(const f32x4*)(Wr + k * 8 + 4);
            wr[8 * j + i][0] = a.x * g; wr[8 * j + i][1] = a.y * g; wr[8 * j + i][2] = a.z * g; wr[8 * j + i][3] = a.w * g; wr[8 * j + i][4] = b.x * g; wr[8 * j + i][5] = b.y * g; wr[8 * j + i][6] = b.z * g; wr[8 * j + i][7] = b.w * g; }
    float bias[8];
#pragma unroll
    for (int e = 0; e < 8; ++e) bias[e] = br[e];
    for (int chunk = blockIdx.x; chunk < T / 128; chunk += gridDim.x) {
        int me0 = -1, me1 = -1; float mw0 = 0.f, mw1 = 0.f, mrs = 0.f;
        for (int r = 0; r < 16; ++r) {
            const int m = chunk * 128 + F.wave * 16 + r; const u32x4* xr = (const u32x4*)(x + (size_t)m * D) + F.lane;
            float lg[8], ssq = 0.f;
#pragma unroll
            for (int e = 0; e < 8; ++e) lg[e] = 0.f;
#pragma unroll
            for (int j = 0; j < 2; ++j) { f32x4 v, w; pg8::unpack8f(xr[64 * j], v, w); ssq += pg8::sumsq4(v) + pg8::sumsq4(w);
#pragma unroll
                for (int e = 0; e < 8; ++e) lg[e] += (v[0] * wr[8 * j][e] + v[1] * wr[8 * j + 1][e] + v[2] * wr[8 * j + 2][e] + v[3] * wr[8 * j + 3][e]) + (w[0] * wr[8 * j + 4][e] + w[1] * wr[8 * j + 5][e] + w[2] * wr[8 * j + 6][e] + w[3] * wr[8 * j + 7][e]); }
            ssq = wave_sum(ssq); const float rstd = 1.0f / sqrtf(ssq * (1.0f / D) + EPS);
            {
                const bool b5 = F.lane & 32, b4 = F.lane & 16, b3 = F.lane & 8; float t4[4], t2[2], t1;
#pragma unroll
                for (int k_ = 0; k_ < 4; ++k_) { const float snd = b5 ? lg[k_] : lg[4 + k_], kp = b5 ? lg[4 + k_] : lg[k_]; t4[k_] = kp + __shfl_xor(snd, 32); }
#pragma unroll
                for (int k_ = 0; k_ < 2; ++k_) { const float snd = b4 ? t4[k_] : t4[2 + k_], kp = b4 ? t4[2 + k_] : t4[k_]; t2[k_] = kp + __shfl_xor(snd, 16); }
                { const float snd = b3 ? t2[0] : t2[1], kp = b3 ? t2[1] : t2[0]; t1 = kp + __shfl_xor(snd, 8); }
                t1 += __shfl_xor(t1, 4); t1 += __shfl_xor(t1, 2); t1 += __shfl_xor(t1, 1);
#pragma unroll
                for (int e = 0; e < 8; ++e) lg[e] = __builtin_bit_cast(float, __builtin_amdgcn_readlane(__builtin_bit_cast(int, t1), 8 * e)) * rstd + bias[e];
            }
            int e0 = 0; float l0 = lg[0];
#pragma unroll
            for (int e = 1; e < 8; ++e) if (lg[e] > l0) { l0 = lg[e]; e0 = e; }
            int e1 = -1; float l1 = -3.0e38f;
#pragma unroll
            for (int e = 0; e < 8; ++e) if (e != e0 && lg[e] > l1) { l1 = lg[e]; e1 = e; }
            const float w1 = 1.0f / (1.0f + __expf(l0 - l1)), w0 = 1.0f - w1;
            if (F.lane == r) { me0 = e0; me1 = e1; mw0 = w0; mw1 = w1; mrs = rstd; }
        }
        unsigned long long m0[8], m1[8]; int nw[8];
#pragma unroll
        for (int e = 0; e < 8; ++e) { m0[e] = __ballot(me0 == e); m1[e] = __ballot(me1 == e); nw[e] = __popcll(m0[e]) + __popcll(m1[e]); }
        __syncthreads();
        if (F.lane < 8) { int v = 0;
#pragma unroll
            for (int e = 0; e < 8; ++e) if (F.lane == e) v = nw[e];
            lw[F.wave * 8 + F.lane] = v; }
        __syncthreads();
        if (F.wave == 0 && F.lane < 8) { int tot = 0; for (int w = 0; w < 8; ++w) tot += lw[w * 8 + F.lane]; lw[72 + F.lane] = tot;
            (void)xb_add(pub + chunk * 8 + F.lane, (unsigned)tot + 1u); }
        { int part = 0; const int e_ = F.lane & 7;
            for (int c2 = F.tid >> 3; c2 < chunk; c2 += NTHREADS / 8) { unsigned v, sp = 0u;
                while ((v = xb_ld(pub + c2 * 8 + e_)) == 0u) { __builtin_amdgcn_s_sleep(1); if (++sp > XB_SPIN_CAP) break; }
                part += (int)v - 1; }
            part += __shfl_xor(part, 8); part += __shfl_xor(part, 16); part += __shfl_xor(part, 32);
            if (F.lane < 8) lw[80 + F.wave * 8 + F.lane] = part; }
        __syncthreads();
        if (F.wave == 0 && F.lane < 8) { int base = 0; for (int w = 0; w < 8; ++w) base += lw[80 + w * 8 + F.lane]; lw[64 + F.lane] = base;
            if (chunk == T / 128 - 1) cnt[F.lane * 64] = (unsigned)(base + lw[72 + F.lane]); }
        __syncthreads();
        if (F.lane < 16) {
            const int m = chunk * 128 + F.wave * 16 + F.lane; const unsigned long long lt = (1ull << F.lane) - 1ull;
            int s0 = 0, s1 = 0;
#pragma unroll
            for (int e = 0; e < 8; ++e) { int base = lw[64 + e]; for (int w = 0; w < F.wave; ++w) base += lw[w * 8 + e];
                if (me0 == e) s0 = base + __popcll(m0[e] & lt); if (me1 == e) s1 = base + __popcll(m0[e]) + __popcll(m1[e] & lt); }
            idx[me0 * T + s0] = m; wl[me0 * T + s0] = mw0; rsl[me0 * T + s0] = mrs; idx[me1 * T + s1] = m; wl[me1 * T + s1] = mw1; rsl[me1 * T + s1] = mrs;
            tpos[2 * m] = me0 * T + s0; tpos[2 * m + 1] = me1 * T + s1;
        }
    }
}
__device__ __forceinline__ void moe_combine(const Frame& F, bf16* xb, ssq_t* ss, const bf16* Y, const unsigned* cnt, const int* tpos) {
    int tb[8]; { int base = 0;
#pragma unroll
        for (int e = 0; e < 8; ++e) { tb[e] = base; base += (((int)cnt[e * 64] + 255) >> 8) << 8; } }
    constexpr int R = 4;
    for (int m0 = F.gw * R; m0 < T; m0 += F.ngw * R) {
        int ra[R], rb[R];
#pragma unroll
        for (int r = 0; r < R; ++r) { const int p0 = tpos[2 * (m0 + r)], p1 = tpos[2 * (m0 + r) + 1]; ra[r] = 0; rb[r] = 0;
#pragma unroll
            for (int e = 0; e < 8; ++e) { if ((p0 / T) == e) ra[r] = tb[e] + (p0 % T); if ((p1 / T) == e) rb[r] = tb[e] + (p1 % T); } }
        u32x4 xv[R][2], ya[R][2], yb[R][2];
#pragma unroll
        for (int r = 0; r < R; ++r)
#pragma unroll
            for (int j = 0; j < 2; ++j) { xv[r][j] = ((const u32x4*)(xb + (size_t)(m0 + r) * D) + F.lane)[64 * j]; ya[r][j] = ((const u32x4*)(Y + (size_t)ra[r] * D) + F.lane)[64 * j]; yb[r][j] = ((const u32x4*)(Y + (size_t)rb[r] * D) + F.lane)[64 * j]; }
#pragma unroll
        for (int r = 0; r < R; ++r) { float sq = 0.f;
#pragma unroll
            for (int j = 0; j < 2; ++j) { f32x4 x0, x1, a0, a1, b0, b1; pg8::unpack8f(xv[r][j], x0, x1); pg8::unpack8f(ya[r][j], a0, a1); pg8::unpack8f(yb[r][j], b0, b1);
                x0 = x0 + a0 + b0; x1 = x1 + a1 + b1; sq += pg8::sumsq4(x0) + pg8::sumsq4(x1);
                ((u32x4*)(xb + (size_t)(m0 + r) * D) + F.lane)[64 * j] = (u32x4){hpk2(x0[0], x0[1]), hpk2(x0[2], x0[3]), hpk2(x1[0], x1[1]), hpk2(x1[2], x1[3])}; }
            sq = wave_sum(sq); if (F.lane == 0) ss_set(ss, m0 + r, sq); }
    }
}

__device__ __forceinline__ void tail_reduce(const Frame& F, const pg8::GroupedOrder<false>& So, int first, int ntail, int nsl, const float* P, bf16* Y, const float* wl) {
    for (int rw = F.gw; rw < ntail * 256; rw += F.ngw) { const int tu = rw >> 8, rr = rw & 255; pg8::Unit u; So.decode(first + tu, u);
        f32x4 s = {0.f, 0.f, 0.f, 0.f};
        for (int ks = 0; ks < nsl; ++ks) s += *(const f32x4*)(P + ((size_t)(ks * ntail + tu) * 65536 + rr * 256 + 4 * F.lane));
        const int slot = u.slot0 + rr; const float w_ = __builtin_nontemporal_load(wl + u.e * T + slot); const float w = slot < u.cnt ? w_ : 0.f;
        uint2 o; o.x = hpk2(s[0] * w, s[1] * w); o.y = hpk2(s[2] * w, s[3] * w);
        *(uint2*)(Y + (size_t)(u.pm * 256 + rr) * D + (u.pn - u.e * 4) * 256 + 4 * F.lane) = o; }
}

constexpr int N_STEPS = 32;
constexpr int PTR_TAB_OFF = RING_BYTES + 2048;
__device__ __forceinline__ const float* inp_ptr(LAS unsigned char* lds, int i) {
    const LAS unsigned* t = (const LAS unsigned*)(lds + PTR_TAB_OFF) + 2 * i;
    const unsigned lo_ = __builtin_amdgcn_readfirstlane(t[0]), hi_ = __builtin_amdgcn_readfirstlane(t[1]);
    return (const float*)(const GAS float*)(((unsigned long long)hi_ << 32) | lo_);
}
#ifndef PROBE_STEP
#define PROBE_STEP (-1)
#endif
#ifndef PROBE_REPS
#define PROBE_REPS 2
#endif
__device__ __forceinline__ void zero_fill16(const Frame& F, bf16* base, int nrows, int ld, int c0, int ncols) {
    const int per = ncols / 8;
    for (int i = F.gw * 64 + F.lane; i < nrows * per; i += F.ngw * 64) { const int r = i / per, c = i % per; *(u32x4*)(base + (size_t)r * ld + c0 + 8 * c) = (u32x4){0u, 0u, 0u, 0u}; }
}
__global__ void __launch_bounds__(NTHREADS, 2) mega(Args args) {
    extern __shared__ __attribute__((aligned(16))) unsigned char lds_raw[];
    Frame F; F.lds = (LAS unsigned char*)lds_raw; F.ctl = (unsigned*)(args.ws + WS_CTL);
    F.tid = threadIdx.x; F.lane = F.tid & 63; F.wave = __builtin_amdgcn_readfirstlane(F.tid >> 6);
    F.gw = blockIdx.x * NWAVES + F.wave; F.ngw = gridDim.x * NWAVES;
    volatile LAS unsigned* MISC = (volatile LAS unsigned*)(F.lds + MISC_OFF);
    for (int u = F.tid; u < (LDS_BYTES - RING_BYTES) / 4; u += NTHREADS) ((LAS unsigned*)(F.lds + RING_BYTES))[u] = 0u;
    __syncthreads();
    if (F.tid < N_IN) ((LAS unsigned long long*)(F.lds + PTR_TAB_OFF))[F.tid] = (unsigned long long)args.in[F.tid];
    if (F.tid == N_IN) ((LAS unsigned long long*)(F.lds + PTR_TAB_OFF))[N_IN] = (unsigned long long)args.ws;
    if (F.tid == N_IN + 1) ((LAS unsigned long long*)(F.lds + PTR_TAB_OFF))[N_IN + 1] = (unsigned long long)args.out;
    __syncthreads();
    XcdBarrier bar; bar.bar = F.ctl + CW_BAR; bar.x = 0; bar.st = nullptr;
    if (MK_N_LAUNCHES == 1) bar = xcd_barrier_post(F.ctl + CW_BAR, MISC + 8);
    const int lo = args.lo, hi = args.hi;
#define ws  ((unsigned char*)inp_ptr(F.lds, N_IN))
#define out ((float*)inp_ptr(F.lds, N_IN + 1))
#define act (ws + WS_ACT)
#define WT ((bf16*)(ws + WS_WT))
#define WM ((bf16*)(ws + WS_WMOE))
#define XB ((bf16*)(ws + WS_XB))
#define PB ((bf16*)(ws + WS_PB))
#define PT ((bf16*)(ws + WS_PT))
#define XA ((bf16*)(act + A_XA))
#define SS ((ssq_t*)(ws + CTL_SS))
#define SSC ((ssq_t*)(ws + CTL_SSC))
#define m_idx ((int*)(ws + WS_MOEL))
#define m_wl ((float*)(ws + WS_MOEL + 1 * MiB))
#define m_tpos ((int*)(ws + WS_MOEL + 2 * MiB))
#define m_rs ((float*)(ws + WS_MOEL + 3 * MiB))
    const int G = gridDim.x, cid = blockIdx.x;
    const int vcu = (G % 8 == 0) ? (cid % 8) * (G / 8) + cid / 8 : cid;
#define IN_(k) (lo <= (k) && (k) < hi)
#if PROBE_STEP >= 0
#define REPS(k) ((k) == PROBE_STEP ? PROBE_REPS : 1)
#define REP_LOOP(k) for (int rep_ = 0; rep_ < REPS(k); ++rep_)
#define SEAM(k) do { if (MK_N_LAUNCHES == 1 && ((k) + 1 < hi || rep_ + 1 < REPS(k))) xcd_barrier(bar); } while (0)
#else
#define REP_LOOP(k)
#define SEAM(k) do { if (MK_N_LAUNCHES == 1 && (k) + 1 < hi) xcd_barrier(bar); } while (0)
#endif
#define INP(i) inp_ptr(F.lds, (i))
#define REFRESH() do { F.tid = tid_now(); F.lane = F.tid & 63; F.wave = __builtin_amdgcn_readfirstlane(F.tid >> 6); F.gw = blockIdx.x * NWAVES + F.wave; } while (0)

    if (IN_(0)) REP_LOOP(0) { REFRESH();
        int wofs = 0;
        { constexpr int j = 0;
            cvt_job(F, INP(I_MLA_W_DOWN) + (size_t)j * D * 416, nullptr, 416, 416, INP(I_ATTN_NORM) + 3 * j * D, WT + WT_DOWN + (size_t)j * 512 * 1024, 1024, 512, 0, wofs); wofs += 16 * 16;
            cvt_job(F, INP(I_MLA_W_UQ) + (size_t)j * 256 * 1536, nullptr, 1536, 1536, INP(I_MLA_Q_NORM) + j * 256, WT + WT_UQ + (size_t)j * 1536 * 256, 256, 1536, 0, wofs); wofs += 4 * 48;
            cvt_job(F, INP(I_MLA_W_UKV) + (size_t)j * 128 * 2048, nullptr, 2048, 2048, INP(I_MLA_KV_NORM) + j * 128, WT + WT_UKV + (size_t)j * 2560 * 256, 128, 2048, 1, wofs); wofs += 2 * 64;
            cvt_job(F, INP(I_MLA_W_O) + (size_t)j * D * D, nullptr, D, D, nullptr, WT + WT_WO + (size_t)(3 * j) * D * D, 1024, 1024, 0, wofs); wofs += 16 * 32;
        }
        xb_rows(F, INP(I_X), XA, SS + 0 * T);
        SEAM(0);
    }

#define LATE_WEIGHTS() do { int wofs = 0; \
        for (int j = 0; j < 2; ++j) { \
            if (j == 1) { \
                cvt_job(F, INP(I_MLA_W_DOWN) + (size_t)j * D * 416, nullptr, 416, 416, INP(I_ATTN_NORM) + 3 * j * D, WT + WT_DOWN + (size_t)j * 512 * 1024, 1024, 512, 0, wofs); wofs += 16 * 16; \
                cvt_job(F, INP(I_MLA_W_UQ) + (size_t)j * 256 * 1536, nullptr, 1536, 1536, INP(I_MLA_Q_NORM) + j * 256, WT + WT_UQ + (size_t)j * 1536 * 256, 256, 1536, 0, wofs); wofs += 4 * 48; \
                cvt_job(F, INP(I_MLA_W_UKV) + (size_t)j * 128 * 2048, nullptr, 2048, 2048, INP(I_MLA_KV_NORM) + j * 128, WT + WT_UKV + (size_t)j * 2560 * 256, 128, 2048, 1, wofs); wofs += 2 * 64; \
                cvt_job(F, INP(I_MLA_W_O) + (size_t)j * D * D, nullptr, D, D, nullptr, WT + WT_WO + (size_t)(3 * j) * D * D, 1024, 1024, 0, wofs); wofs += 16 * 32; } \
            cvt_job(F, INP(I_FFN_W_GATE) + (size_t)j * D * FF, INP(I_FFN_W_UP) + (size_t)j * D * FF, FF, FF, INP(I_FFN_NORM) + 2 * j * D, WT + WT_FGU + (size_t)j * 5632 * 1024, 1024, 5632, 2, wofs); wofs += 16 * 88; \
            cvt_job(F, INP(I_FFN_W_DOWN) + (size_t)j * FF * D, nullptr, D, D, nullptr, WT + WT_FDN + (size_t)j * 1024 * FF, FF, 1024, 0, wofs); wofs += 44 * 16; \
        } \
        cvt_job(F, INP(I_SWA_W_QKV), nullptr, 1536, 1536, INP(I_ATTN_NORM) + 1 * D, WT + WT_SQKV, 1024, 1536, 0, wofs); wofs += 16 * 24; \
        cvt_job(F, INP(I_SWA_W_O), nullptr, D, D, nullptr, WT + WT_WO + (size_t)1 * D * D, 1024, 1024, 0, wofs); wofs += 16 * 16; \
        cvt_job(F, INP(I_AX_W_QKV), nullptr, 2048, 2048, INP(I_ATTN_NORM) + 2 * D, WT + WT_AQKV, 1024, 2048, 0, wofs); wofs += 16 * 32; \
        cvt_job(F, INP(I_AX_W_O), nullptr, D, D, nullptr, WT + WT_WO + (size_t)2 * D * D, 1024, 1024, 0, wofs); wofs += 16 * 16; \
        for (int l2 = 0; l2 < 4; ++l2) { \
            cvt_job(F, INP(I_PLE_W_IN) + (size_t)l2 * PLE * D, nullptr, D, D, nullptr, WT + WT_PIN + (size_t)l2 * 1024 * 256, 256, 1024, 0, wofs); wofs += 4 * 16; \
            cvt_job(F, INP(I_PLE_W_GATE) + (size_t)l2 * D * D, nullptr, D, D, INP(I_PLE_NORM) + l2 * D, WT + WT_PG + (size_t)l2 * D * D, 1024, 1024, 0, wofs); wofs += 16 * 16; } \
    } while (0)
    int k = 1;
    { constexpr int l = 0;
        const int kind = l % 3, jm = l / 3, f = l >> 1;
        const ssq_t* ss_attn = SS + (size_t)(3 * l) * T; ssq_t* ss_ffn = SS + (size_t)(3 * l + 1) * T; ssq_t* ss_ple = SS + (size_t)(3 * l + 2) * T; ssq_t* ss_next = l < 3 ? SS + (size_t)(3 * l + 3) * T : nullptr;
        if (kind == 0) {
            if (IN_(k)) REP_LOOP(k) { REFRESH(); pg8::Gemm g{XA, WT + WT_DOWN + (size_t)jm * 512 * 1024, 1024, 1024}; pg8::StaticOrder So; So.init(T, 512, G, cid);
                pg8::EpiPlain<true> E{(bf16*)(act + A_C), 512, 2, ss_attn, 1.0f / D, nullptr, SSC + (size_t)jm * T, SSC + (size_t)(2 + jm) * T};
                pg8::gemm_phase(F.lds, g, So, E); SEAM(k); } ++k;
            if (IN_(k)) REP_LOOP(k) { REFRESH(); { pg8::Gemm g{(const bf16*)(act + A_C), WT + WT_UQ + (size_t)jm * 1536 * 256, 256, 512}; pg8::StaticOrder So; So.init(T, 1536, G, cid);
                  pg8::EpiPlain<false> E{(bf16*)(act + A_QR), 1536, 6, SSC + (size_t)jm * T, 1.0f / 256, nullptr, nullptr, nullptr}; pg8::gemm_phase(F.lds, g, So, E); }
                { int k128_ = 128; asm volatile("" : "+s"(k128_));     pg8::Gemm g{(const bf16*)(act + A_C) + 256, WT + WT_UKV + (size_t)jm * 2560 * 256, k128_, 512}; pg8::StaticOrder So; So.init(T, 2048, G, cid);
                  pg8::EpiKN<true> E{(bf16*)(act + A_KV), 2560, 0, 4, 512, SSC + (size_t)(2 + jm) * T, 1.0f / 128, INP(I_MLA_K_GAIN) + jm * 96, (const bf16*)(act + A_C), (LAS float*)(F.lds + RING_BYTES + 4096)}; pg8::gemm_phase(F.lds, g, So, E); }
                SEAM(k); } ++k;
            if (IN_(k)) REP_LOOP(k) { REFRESH(); int it_ = 0; const int nit_ = (NB * 16 * 8 - vcu + G - 1) / G; const int stag_ = ((cid >> 3) & 7) % (nit_ > 0 ? nit_ : 1); constexpr int fc_ = l == 0 ? 0 : 1, lc_ = l == 0 ? 1 : 3;
                for (int u = vcu; u < NB * 16 * 8; u += G, ++it_) { const int qb = u & 7, h = (u >> 3) & 15, b = u >> 7;
                    if (it_ == stag_) {
                        __syncthreads();
                        REFRESH();
                        moe_cvt_all(F, INP(I_MOE_W_GATE) + (size_t)fc_ * NE * D * EF, INP(I_MOE_W_UP) + (size_t)fc_ * NE * D * EF, INP(I_MOE_W_DOWN) + (size_t)fc_ * NE * EF * D, INP(I_FFN_NORM) + lc_ * D, WM);
                        if (l == 0) { LATE_WEIGHTS(); cvt_flat(F, INP(I_P), PB, (size_t)4 * T * PLE / 8); }
                        __syncthreads(); }
                    fa::attn_unit<96, 64, 0, 0, 1536, 2560, 2560, D, 2>((const bf16*)(act + A_QR) + (size_t)(b * S + qb * 256) * 1536 + h * 96, (const bf16*)(act + A_KV) + (size_t)b * S * 2560 + h * 64,
                                          (const bf16*)(act + A_KV) + (size_t)b * S * 2560 + 1536 + h * 64, (bf16*)(act + A_O) + (size_t)(b * S + qb * 256) * D + h * 64, S / 64, qb * 256, 0, 0.f, 0.f, INP(I_MLA_Q_GAIN) + jm * 96, 1024 - 32 * h, F.lds); } SEAM(k); } ++k;
        } else if (kind == 1) {
            if (IN_(k)) REP_LOOP(k) { REFRESH(); pg8::Gemm g{XA, WT + WT_SQKV, 1024, 1024}; pg8::StaticOrder So; So.init(T, 1536, G, cid);
                pg8::EpiKN<false> E{(bf16*)(act + 0), 1536, 4, 5, 0, ss_attn, 1.0f / D, INP(I_SWA_K_GAIN), nullptr, (LAS float*)(F.lds + RING_BYTES + 4096)}; pg8::gemm_phase(F.lds, g, So, E); SEAM(k); } ++k;
            if (IN_(k)) REP_LOOP(k) { REFRESH(); for (int u = vcu; u < NB * 16 * 8; u += G) { const int qb = u & 7, h = (u >> 3) & 15, b = u >> 7; const int gq = h >> 2;
                    const float slope2 = exp2f(-8.0f * (float)(h + 1) / 16.0f) * LOG2E, sink2 = INP(I_SWA_SINK)[h] * LOG2E;
                    const int q0 = qb * 256, klo = q0 - 128 < 0 ? 0 : q0 - 128, khi = q0 + 384 > S ? S : q0 + 384;
                    fa::attn_unit<64, 64, 1, 1, 1536, 1536, 1536, D, 2>((const bf16*)(act + 0) + (size_t)(b * S + q0) * 1536 + h * 64, (const bf16*)(act + 0) + (size_t)(b * S + klo) * 1536 + 1024 + gq * 64,
                                          (const bf16*)(act + 0) + (size_t)(b * S + klo) * 1536 + 1280 + gq * 64, (bf16*)(act + A_O) + (size_t)(b * S + q0) * D + h * 64, (khi - klo) / 64, q0, klo, slope2, sink2, INP(I_SWA_Q_GAIN), 0, F.lds); } SEAM(k); } ++k;
        } else {
            if (IN_(k)) REP_LOOP(k) { REFRESH(); pg8::Gemm g{XA, WT + WT_AQKV, 1024, 1024}; pg8::StaticOrder So; So.init(T, 2048, G, cid);
                pg8::EpiPlain<false> E{(bf16*)(act + 0), 2048, 8, ss_attn, 1.0f / D, nullptr, nullptr, nullptr}; pg8::gemm_phase(F.lds, g, So, E); SEAM(k); } ++k;
            if (IN_(k)) REP_LOOP(k) { REFRESH(); ax_kprep(F, (bf16*)(act + 0), INP(I_AX_K_GAIN)); SEAM(k); } ++k;
            if (IN_(k)) REP_LOOP(k) { REFRESH(); for (int u = vcu; u < NB * 8 * 8; u += G) { const int qb = u & 7, h = (u >> 3) & 7, b = u >> 6; const int gq = h >> 1;
                    fa::attn_unit<128, 128, 0, 2, 2048, 2048, 2048, D, 1>((const bf16*)(act + 0) + (size_t)(b * S + qb * 256) * 2048 + h * 128, (const bf16*)(act + 0) + (size_t)b * S * 2048 + 1024 + gq * 128,
                                            (const bf16*)(act + 0) + (size_t)b * S * 2048 + 1536 + gq * 128, (bf16*)(act + A_O) + (size_t)(b * S + qb * 256) * D + h * 128, S / 64, qb * 256, 0, 0.f, 0.f, INP(I_AX_Q_GAIN), 0, F.lds); } SEAM(k); } ++k;
        }
        if (IN_(k)) REP_LOOP(k) { REFRESH(); __syncthreads(); pg8::Gemm g{(const bf16*)(act + A_O), WT + WT_WO + (size_t)l * D * D, 1024, 1024}; pg8::StaticOrder So; So.init(T, D, G, cid);
            pg8::EpiResid E{XA, XB, ss_ffn}; pg8::gemm_phase(F.lds, g, So, E); SEAM(k); } ++k;
        if ((l & 1) == 0) {
            if (IN_(k)) REP_LOOP(k) { REFRESH(); pg8::Gemm g{XB, WT + WT_FGU + (size_t)f * 5632 * 1024, 1024, 1024}; pg8::StaticOrder So; So.init(T, 5632, G, cid);
                pg8::EpiSwiglu E{(bf16*)(act + A_HID), FF, 22, ss_ffn, nullptr, (LAS float*)(F.lds + RING_BYTES + 4096)}; pg8::gemm_phase(F.lds, g, So, E); SEAM(k); } ++k;
            if (IN_(k)) REP_LOOP(k) { REFRESH(); pg8::Gemm g{(const bf16*)(act + A_HID), WT + WT_FDN + (size_t)f * 1024 * FF, FF, FF}; pg8::StaticOrder So; So.init(T, D, G, cid);
                pg8::EpiResid E{XB, XB, ss_ple}; pg8::gemm_phase(F.lds, g, So, E); SEAM(k); } ++k;
        } else {
            unsigned* cnt = F.ctl + CW_MOECNT + f * 1024;
            if (IN_(k)) REP_LOOP(k) { REFRESH();
                moe_route(F, XB, INP(I_FFN_NORM) + l * D, INP(I_MOE_W_ROUTER) + (size_t)f * D * NE, INP(I_MOE_B_ROUTER) + f * NE, cnt, F.ctl + CW_ROUTEPUB + f * 4096, m_idx, m_wl, m_rs, m_tpos); SEAM(k); } ++k;
            if (IN_(k)) REP_LOOP(k) { REFRESH(); __syncthreads(); pg8::Gemm g{XB, WM + WM_GU, 1024, 1024}; pg8::GroupedOrder<true> So; So.init(cnt, 28, G, cid, m_idx, (LAS int*)(F.lds + RING_BYTES + 1024));
                pg8::EpiSwiglu E{(bf16*)(act + A_HID), EF, 28, nullptr, m_rs, (LAS float*)(F.lds + RING_BYTES + 4096)}; pg8::gemm_phase(F.lds, g, So, E); SEAM(k); } ++k;
            if (IN_(k)) REP_LOOP(k) { REFRESH(); pg8::Gemm g{(const bf16*)(act + A_HID), WM + WM_DN, EF, EF}; pg8::GroupedOrder<false> So; So.init(cnt, 4, G, cid, nullptr, (LAS int*)(F.lds + RING_BYTES + 1024));
                const int ntail = So.nunits % G; int nsl = 0;
                if (ntail > 0 && So.nunits > G) nsl = ntail * 14 <= G ? 14 : ntail * 7 <= G ? 7 : ntail * 4 <= G ? 4 : ntail * 2 <= G ? 2 : 0;
                if (ntail * nsl > 256) nsl = 0;
                nsl = __builtin_amdgcn_readfirstlane(nsl);
                if (nsl) { So.nlim = So.nunits - ntail;
                    { const int ksl = EF / nsl; pg8::Gemm gs{(const bf16*)(act + A_HID), WM + WM_DN, ksl, EF, EF}; pg8::SliceOrder Ss{So, So.nlim, ntail, nsl, ksl * 2, G, cid};
                      pg8::EpiPartial Ep{(float*)(ws + WS_PT)}; pg8::gemm_phase(F.lds, gs, Ss, Ep); }
                    asm volatile("s_waitcnt vmcnt(0)" ::: "memory"); __syncthreads();
                    if (threadIdx.x == 0) { __builtin_amdgcn_fence(__ATOMIC_RELEASE, "agent"); asm volatile("s_waitcnt vmcnt(0)" ::: "memory"); xb_add(cnt + 768, 1u); } }
                pg8::EpiPlain<false> E{(bf16*)(act + A_Y), D, 4, nullptr, 0.f, m_wl, nullptr, nullptr}; pg8::gemm_phase(F.lds, g, So, E);
                if (nsl) { REFRESH();
                    if (threadIdx.x == 0) { XB_SPIN(xb_ld(cnt + 768) < (unsigned)G, F.ctl + CW_BAR); __builtin_amdgcn_fence(__ATOMIC_ACQUIRE, "agent"); asm volatile("s_waitcnt vmcnt(0)" ::: "memory"); }
                    __syncthreads();
                    tail_reduce(F, So, So.nlim, ntail, nsl, (const float*)(ws + WS_PT), (bf16*)(act + A_Y), m_wl); }
                SEAM(k); } ++k;
            if (IN_(k)) REP_LOOP(k) { REFRESH(); moe_combine(F, XB, ss_ple, (const bf16*)(act + A_Y), cnt, m_tpos); SEAM(k); } ++k;
        }
        if (IN_(k)) REP_LOOP(k) { REFRESH(); { pg8::Gemm g{PB + (size_t)l * T * PLE, WT + WT_PIN + (size_t)l * 1024 * 256, 256, 256}; pg8::StaticOrder So; So.init(T, D, G, cid);
              pg8::EpiPlain<false> E{PT, D, 4, nullptr, 0.f, nullptr, nullptr, nullptr}; pg8::gemm_phase(F.lds, g, So, E); }
            { pg8::Gemm g{XB, WT + WT_PG + (size_t)l * D * D, 1024, 1024}; pg8::StaticOrder So; So.init(T, D, G, cid);
              pg8::EpiPle E{PT, XB, XA, l == DEPTH - 1 ? out : nullptr, ss_ple, ss_next}; pg8::gemm_phase(F.lds, g, So, E); } SEAM(k); } ++k;
    }
    { constexpr int l = 1;
        const int kind = l % 3, jm = l / 3, f = l >> 1;
        const ssq_t* ss_attn = SS + (size_t)(3 * l) * T; ssq_t* ss_ffn = SS + (size_t)(3 * l + 1) * T; ssq_t* ss_ple = SS + (size_t)(3 * l + 2) * T; ssq_t* ss_next = l < 3 ? SS + (size_t)(3 * l + 3) * T : nullptr;
        if (kind == 0) {
            if (IN_(k)) REP_LOOP(k) { REFRESH(); pg8::Gemm g{XA, WT + WT_DOWN + (size_t)jm * 512 * 1024, 1024, 1024}; pg8::StaticOrder So; So.init(T, 512, G, cid);
                pg8::EpiPlain<true> E{(bf16*)(act + A_C), 512, 2, ss_attn, 1.0f / D, nullptr, SSC + (size_t)jm * T, SSC + (size_t)(2 + jm) * T};
                pg8::gemm_phase(F.lds, g, So, E); SEAM(k); } ++k;
            if (IN_(k)) REP_LOOP(k) { REFRESH(); { pg8::Gemm g{(const bf16*)(act + A_C), WT + WT_UQ + (size_t)jm * 1536 * 256, 256, 512}; pg8::StaticOrder So; So.init(T, 1536, G, cid);
                  pg8::EpiPlain<false> E{(bf16*)(act + A_QR), 1536, 6, SSC + (size_t)jm * T, 1.0f / 256, nullptr, nullptr, nullptr}; pg8::gemm_phase(F.lds, g, So, E); }
                { int k128_ = 128; asm volatile("" : "+s"(k128_));     pg8::Gemm g{(const bf16*)(act + A_C) + 256, WT + WT_UKV + (size_t)jm * 2560 * 256, k128_, 512}; pg8::StaticOrder So; So.init(T, 2048, G, cid);
                  pg8::EpiKN<true> E{(bf16*)(act + A_KV), 2560, 0, 4, 512, SSC + (size_t)(2 + jm) * T, 1.0f / 128, INP(I_MLA_K_GAIN) + jm * 96, (const bf16*)(act + A_C), (LAS float*)(F.lds + RING_BYTES + 4096)}; pg8::gemm_phase(F.lds, g, So, E); }
                SEAM(k); } ++k;
            if (IN_(k)) REP_LOOP(k) { REFRESH(); int it_ = 0; const int nit_ = (NB * 16 * 8 - vcu + G - 1) / G; const int stag_ = ((cid >> 3) & 7) % (nit_ > 0 ? nit_ : 1); constexpr int fc_ = l == 0 ? 0 : 1, lc_ = l == 0 ? 1 : 3;
                for (int u = vcu; u < NB * 16 * 8; u += G, ++it_) { const int qb = u & 7, h = (u >> 3) & 15, b = u >> 7;
                    if (it_ == stag_) {
                        __syncthreads();
                        REFRESH();
                        moe_cvt_all(F, INP(I_MOE_W_GATE) + (size_t)fc_ * NE * D * EF, INP(I_MOE_W_UP) + (size_t)fc_ * NE * D * EF, INP(I_MOE_W_DOWN) + (size_t)fc_ * NE * EF * D, INP(I_FFN_NORM) + lc_ * D, WM);
                        if (l == 0) { LATE_WEIGHTS(); cvt_flat(F, INP(I_P), PB, (size_t)4 * T * PLE / 8); }
                        __syncthreads(); }
                    fa::attn_unit<96, 64, 0, 0, 1536, 2560, 2560, D, 2>((const bf16*)(act + A_QR) + (size_t)(b * S + qb * 256) * 1536 + h * 96, (const bf16*)(act + A_KV) + (size_t)b * S * 2560 + h * 64,
                                          (const bf16*)(act + A_KV) + (size_t)b * S * 2560 + 1536 + h * 64, (bf16*)(act + A_O) + (size_t)(b * S + qb * 256) * D + h * 64, S / 64, qb * 256, 0, 0.f, 0.f, INP(I_MLA_Q_GAIN) + jm * 96, 1024 - 32 * h, F.lds); } SEAM(k); } ++k;
        } else if (kind == 1) {
            if (IN_(k)) REP_LOOP(k) { REFRESH(); pg8::Gemm g{XA, WT + WT_SQKV, 1024, 1024}; pg8::StaticOrder So; So.init(T, 1536, G, cid);
                pg8::EpiKN<false> E{(bf16*)(act + 0), 1536, 4, 5, 0, ss_attn, 1.0f / D, INP(I_SWA_K_GAIN), nullptr, (LAS float*)(F.lds + RING_BYTES + 4096)}; pg8::gemm_phase(F.lds, g, So, E); SEAM(k); } ++k;
            if (IN_(k)) REP_LOOP(k) { REFRESH(); for (int u = vcu; u < NB * 16 * 8; u += G) { const int qb = u & 7, h = (u >> 3) & 15, b = u >> 7; const int gq = h >> 2;
                    const float slope2 = exp2f(-8.0f * (float)(h + 1) / 16.0f) * LOG2E, sink2 = INP(I_SWA_SINK)[h] * LOG2E;
                    const int q0 = qb * 256, klo = q0 - 128 < 0 ? 0 : q0 - 128, khi = q0 + 384 > S ? S : q0 + 384;
                    fa::attn_unit<64, 64, 1, 1, 1536, 1536, 1536, D, 2>((const bf16*)(act + 0) + (size_t)(b * S + q0) * 1536 + h * 64, (const bf16*)(act + 0) + (size_t)(b * S + klo) * 1536 + 1024 + gq * 64,
                                          (const bf16*)(act + 0) + (size_t)(b * S + klo) * 1536 + 1280 + gq * 64, (bf16*)(act + A_O) + (size_t)(b * S + q0) * D + h * 64, (khi - klo) / 64, q0, klo, slope2, sink2, INP(I_SWA_Q_GAIN), 0, F.lds); } SEAM(k); } ++k;
        } else {
            if (IN_(k)) REP_LOOP(k) { REFRESH(); pg8::Gemm g{XA, WT + WT_AQKV, 1024, 1024}; pg8::StaticOrder So; So.init(T, 2048, G, cid);
                pg8::EpiPlain<false> E{(bf16*)(act + 0), 2048, 8, ss_attn, 1.0f / D, nullptr, nullptr, nullptr}; pg8::gemm_phase(F.lds, g, So, E); SEAM(k); } ++k;
            if (IN_(k)) REP_LOOP(k) { REFRESH(); ax_kprep(F, (bf16*)(act + 0), INP(I_AX_K_GAIN)); SEAM(k); } ++k;
            if (IN_(k)) REP_LOOP(k) { REFRESH(); for (int u = vcu; u < NB * 8 * 8; u += G) { const int qb = u & 7, h = (u >> 3) & 7, b = u >> 6; const int gq = h >> 1;
                    fa::attn_unit<128, 128, 0, 2, 2048, 2048, 2048, D, 1>((const bf16*)(act + 0) + (size_t)(b * S + qb * 256) * 2048 + h * 128, (const bf16*)(act + 0) + (size_t)b * S * 2048 + 1024 + gq * 128,
                                            (const bf16*)(act + 0) + (size_t)b * S * 2048 + 1536 + gq * 128, (bf16*)(act + A_O) + (size_t)(b * S + qb * 256) * D + h * 128, S / 64, qb * 256, 0, 0.f, 0.f, INP(I_AX_Q_GAIN), 0, F.lds); } SEAM(k); } ++k;
        }
        if (IN_(k)) REP_LOOP(k) { REFRESH(); __syncthreads(); pg8::Gemm g{(const bf16*)(act + A_O), WT + WT_WO + (size_t)l * D * D, 1024, 1024}; pg8::StaticOrder So; So.init(T, D, G, cid);
            pg8::EpiResid E{XA, XB, ss_ffn}; pg8::gemm_phase(F.lds, g, So, E); SEAM(k); } ++k;
        if ((l & 1) == 0) {
            if (IN_(k)) REP_LOOP(k) { REFRESH(); pg8::Gemm g{XB, WT + WT_FGU + (size_t)f * 5632 * 1024, 1024, 1024}; pg8::StaticOrder So; So.init(T, 5632, G, cid);
                pg8::EpiSwiglu E{(bf16*)(act + A_HID), FF, 22, ss_ffn, nullptr, (LAS float*)(F.lds + RING_BYTES + 4096)}; pg8::gemm_phase(F.lds, g, So, E); SEAM(k); } ++k;
            if (IN_(k)) REP_LOOP(k) { REFRESH(); pg8::Gemm g{(const bf16*)(act + A_HID), WT + WT_FDN + (size_t)f * 1024 * FF, FF, FF}; pg8::StaticOrder So; So.init(T, D, G, cid);
                pg8::EpiResid E{XB, XB, ss_ple}; pg8::gemm_phase(F.lds, g, So, E); SEAM(k); } ++k;
        } else {
            unsigned* cnt = F.ctl + CW_MOECNT + f * 1024;
            if (IN_(k)) REP_LOOP(k) { REFRESH();
                moe_route(F, XB, INP(I_FFN_NORM) + l * D, INP(I_MOE_W_ROUTER) + (size_t)f * D * NE, INP(I_MOE_B_ROUTER) + f * NE, cnt, F.ctl + CW_ROUTEPUB + f * 4096, m_idx, m_wl, m_rs, m_tpos); SEAM(k); } ++k;
            if (IN_(k)) REP_LOOP(k) { REFRESH(); __syncthreads(); pg8::Gemm g{XB, WM + WM_GU, 1024, 1024}; pg8::GroupedOrder<true> So; So.init(cnt, 28, G, cid, m_idx, (LAS int*)(F.lds + RING_BYTES + 1024));
                pg8::EpiSwiglu E{(bf16*)(act + A_HID), EF, 28, nullptr, m_rs, (LAS float*)(F.lds + RING_BYTES + 4096)}; pg8::gemm_phase(F.lds, g, So, E); SEAM(k); } ++k;
            if (IN_(k)) REP_LOOP(k) { REFRESH(); pg8::Gemm g{(const bf16*)(act + A_HID), WM + WM_DN, EF, EF}; pg8::GroupedOrder<false> So; So.init(cnt, 4, G, cid, nullptr, (LAS int*)(F.lds + RING_BYTES + 1024));
                const int ntail = So.nunits % G; int nsl = 0;
                if (ntail > 0 && So.nunits > G) nsl = ntail * 14 <= G ? 14 : ntail * 7 <= G ? 7 : ntail * 4 <= G ? 4 : ntail * 2 <= G ? 2 : 0;
                if (ntail * nsl > 256) nsl = 0;
                nsl = __builtin_amdgcn_readfirstlane(nsl);
                if (nsl) { So.nlim = So.nunits - ntail;
                    { const int ksl = EF / nsl; pg8::Gemm gs{(const bf16*)(act + A_HID), WM + WM_DN, ksl, EF, EF}; pg8::SliceOrder Ss{So, So.nlim, ntail, nsl, ksl * 2, G, cid};
                      pg8::EpiPartial Ep{(float*)(ws + WS_PT)}; pg8::gemm_phase(F.lds, gs, Ss, Ep); }
                    asm volatile("s_waitcnt vmcnt(0)" ::: "memory"); __syncthreads();
                    if (threadIdx.x == 0) { __builtin_amdgcn_fence(__ATOMIC_RELEASE, "agent"); asm volatile("s_waitcnt vmcnt(0)" ::: "memory"); xb_add(cnt + 768, 1u); } }
                pg8::EpiPlain<false> E{(bf16*)(act + A_Y), D, 4, nullptr, 0.f, m_wl, nullptr, nullptr}; pg8::gemm_phase(F.lds, g, So, E);
                if (nsl) { REFRESH();
                    if (threadIdx.x == 0) { XB_SPIN(xb_ld(cnt + 768) < (unsigned)G, F.ctl + CW_BAR); __builtin_amdgcn_fence(__ATOMIC_ACQUIRE, "agent"); asm volatile("s_waitcnt vmcnt(0)" ::: "memory"); }
                    __syncthreads();
                    tail_reduce(F, So, So.nlim, ntail, nsl, (const float*)(ws + WS_PT), (bf16*)(act + A_Y), m_wl); }
                SEAM(k); } ++k;
            if (IN_(k)) REP_LOOP(k) { REFRESH(); moe_combine(F, XB, ss_ple, (const bf16*)(act + A_Y), cnt, m_tpos); SEAM(k); } ++k;
        }
        if (IN_(k)) REP_LOOP(k) { REFRESH(); { pg8::Gemm g{PB + (size_t)l * T * PLE, WT + WT_PIN + (size_t)l * 1024 * 256, 256, 256}; pg8::StaticOrder So; So.init(T, D, G, cid);
              pg8::EpiPlain<false> E{PT, D, 4, nullptr, 0.f, nullptr, nullptr, nullptr}; pg8::gemm_phase(F.lds, g, So, E); }
            { pg8::Gemm g{XB, WT + WT_PG + (size_t)l * D * D, 1024, 1024}; pg8::StaticOrder So; So.init(T, D, G, cid);
              pg8::EpiPle E{PT, XB, XA, l == DEPTH - 1 ? out : nullptr, ss_ple, ss_next}; pg8::gemm_phase(F.lds, g, So, E); } SEAM(k); } ++k;
    }
    { constexpr int l = 2;
        const int kind = l % 3, jm = l / 3, f = l >> 1;
        const ssq_t* ss_attn = SS + (size_t)(3 * l) * T; ssq_t* ss_ffn = SS + (size_t)(3 * l + 1) * T; ssq_t* ss_ple = SS + (size_t)(3 * l + 2) * T; ssq_t* ss_next = l < 3 ? SS + (size_t)(3 * l + 3) * T : nullptr;
        if (kind == 0) {
            if (IN_(k)) REP_LOOP(k) { REFRESH(); pg8::Gemm g{XA, WT + WT_DOWN + (size_t)jm * 512 * 1024, 1024, 1024}; pg8::StaticOrder So; So.init(T, 512, G, cid);
                pg8::EpiPlain<true> E{(bf16*)(act + A_C), 512, 2, ss_attn, 1.0f / D, nullptr, SSC + (size_t)jm * T, SSC + (size_t)(2 + jm) * T};
                pg8::gemm_phase(F.lds, g, So, E); SEAM(k); } ++k;
            if (IN_(k)) REP_LOOP(k) { REFRESH(); { pg8::Gemm g{(const bf16*)(act + A_C), WT + WT_UQ + (size_t)jm * 1536 * 256, 256, 512}; pg8::StaticOrder So; So.init(T, 1536, G, cid);
                  pg8::EpiPlain<false> E{(bf16*)(act + A_QR), 1536, 6, SSC + (size_t)jm * T, 1.0f / 256, nullptr, nullptr, nullptr}; pg8::gemm_phase(F.lds, g, So, E); }
                { int k128_ = 128; asm volatile("" : "+s"(k128_));     pg8::Gemm g{(const bf16*)(act + A_C) + 256, WT + WT_UKV + (size_t)jm * 2560 * 256, k128_, 512}; pg8::StaticOrder So; So.init(T, 2048, G, cid);
                  pg8::EpiKN<true> E{(bf16*)(act + A_KV), 2560, 0, 4, 512, SSC + (size_t)(2 + jm) * T, 1.0f / 128, INP(I_MLA_K_GAIN) + jm * 96, (const bf16*)(act + A_C), (LAS float*)(F.lds + RING_BYTES + 4096)}; pg8::gemm_phase(F.lds, g, So, E); }
                SEAM(k); } ++k;
            if (IN_(k)) REP_LOOP(k) { REFRESH(); int it_ = 0; const int nit_ = (NB * 16 * 8 - vcu + G - 1) / G; const int stag_ = ((cid >> 3) & 7) % (nit_ > 0 ? nit_ : 1); constexpr int fc_ = l == 0 ? 0 : 1, lc_ = l == 0 ? 1 : 3;
                for (int u = vcu; u < NB * 16 * 8; u += G, ++it_) { const int qb = u & 7, h = (u >> 3) & 15, b = u >> 7;
                    if (it_ == stag_) {
                        __syncthreads();
                        REFRESH();
                        moe_cvt_all(F, INP(I_MOE_W_GATE) + (size_t)fc_ * NE * D * EF, INP(I_MOE_W_UP) + (size_t)fc_ * NE * D * EF, INP(I_MOE_W_DOWN) + (size_t)fc_ * NE * EF * D, INP(I_FFN_NORM) + lc_ * D, WM);
                        if (l == 0) { LATE_WEIGHTS(); cvt_flat(F, INP(I_P), PB, (size_t)4 * T * PLE / 8); }
                        __syncthreads(); }
                    fa::attn_unit<96, 64, 0, 0, 1536, 2560, 2560, D, 2>((const bf16*)(act + A_QR) + (size_t)(b * S + qb * 256) * 1536 + h * 96, (const bf16*)(act + A_KV) + (size_t)b * S * 2560 + h * 64,
                                          (const bf16*)(act + A_KV) + (size_t)b * S * 2560 + 1536 + h * 64, (bf16*)(act + A_O) + (size_t)(b * S + qb * 256) * D + h * 64, S / 64, qb * 256, 0, 0.f, 0.f, INP(I_MLA_Q_GAIN) + jm * 96, 1024 - 32 * h, F.lds); } SEAM(k); } ++k;
        } else if (kind == 1) {
            if (IN_(k)) REP_LOOP(k) { REFRESH(); pg8::Gemm g{XA, WT + WT_SQKV, 1024, 1024}; pg8::StaticOrder So; So.init(T, 1536, G, cid);
                pg8::EpiKN<false> E{(bf16*)(act + 0), 1536, 4, 5, 0, ss_attn, 1.0f / D, INP(I_SWA_K_GAIN), nullptr, (LAS float*)(F.lds + RING_BYTES + 4096)}; pg8::gemm_phase(F.lds, g, So, E); SEAM(k); } ++k;
            if (IN_(k)) REP_LOOP(k) { REFRESH(); for (int u = vcu; u < NB * 16 * 8; u += G) { const int qb = u & 7, h = (u >> 3) & 15, b = u >> 7; const int gq = h >> 2;
                    const float slope2 = exp2f(-8.0f * (float)(h + 1) / 16.0f) * LOG2E, sink2 = INP(I_SWA_SINK)[h] * LOG2E;
                    const int q0 = qb * 256, klo = q0 - 128 < 0 ? 0 : q0 - 128, khi = q0 + 384 > S ? S : q0 + 384;
                    fa::attn_unit<64, 64, 1, 1, 1536, 1536, 1536, D, 2>((const bf16*)(act + 0) + (size_t)(b * S + q0) * 1536 + h * 64, (const bf16*)(act + 0) + (size_t)(b * S + klo) * 1536 + 1024 + gq * 64,
                                          (const bf16*)(act + 0) + (size_t)(b * S + klo) * 1536 + 1280 + gq * 64, (bf16*)(act + A_O) + (size_t)(b * S + q0) * D + h * 64, (khi - klo) / 64, q0, klo, slope2, sink2, INP(I_SWA_Q_GAIN), 0, F.lds); } SEAM(k); } ++k;
        } else {
            if (IN_(k)) REP_LOOP(k) { REFRESH(); pg8::Gemm g{XA, WT + WT_AQKV, 1024, 1024}; pg8::StaticOrder So; So.init(T, 2048, G, cid);
                pg8::EpiPlain<false> E{(bf16*)(act + 0), 2048, 8, ss_attn, 1.0f / D, nullptr, nullptr, nullptr}; pg8::gemm_phase(F.lds, g, So, E); SEAM(k); } ++k;
            if (IN_(k)) REP_LOOP(k) { REFRESH(); ax_kprep(F, (bf16*)(act + 0), INP(I_AX_K_GAIN)); SEAM(k); } ++k;
            if (IN_(k)) REP_LOOP(k) { REFRESH(); for (int u = vcu; u < NB * 8 * 8; u += G) { const int qb = u & 7, h = (u >> 3) & 7, b = u >> 6; const int gq = h >> 1;
                    fa::attn_unit<128, 128, 0, 2, 2048, 2048, 2048, D, 1>((const bf16*)(act + 0) + (size_t)(b * S + qb * 256) * 2048 + h * 128, (const bf16*)(act + 0) + (size_t)b * S * 2048 + 1024 + gq * 128,
                                            (const bf16*)(act + 0) + (size_t)b * S * 2048 + 1536 + gq * 128, (bf16*)(act + A_O) + (size_t)(b * S + qb * 256) * D + h * 128, S / 64, qb * 256, 0, 0.f, 0.f, INP(I_AX_Q_GAIN), 0, F.lds); } SEAM(k); } ++k;
        }
        if (IN_(k)) REP_LOOP(k) { REFRESH(); __syncthreads(); pg8::Gemm g{(const bf16*)(act + A_O), WT + WT_WO + (size_t)l * D * D, 1024, 1024}; pg8::StaticOrder So; So.init(T, D, G, cid);
            pg8::EpiResid E{XA, XB, ss_ffn}; pg8::gemm_phase(F.lds, g, So, E); SEAM(k); } ++k;
        if ((l & 1) == 0) {
            if (IN_(k)) REP_LOOP(k) { REFRESH(); pg8::Gemm g{XB, WT + WT_FGU + (size_t)f * 5632 * 1024, 1024, 1024}; pg8::StaticOrder So; So.init(T, 5632, G, cid);
                pg8::EpiSwiglu E{(bf16*)(act + A_HID), FF, 22, ss_ffn, nullptr, (LAS float*)(F.lds + RING_BYTES + 4096)}; pg8::gemm_phase(F.lds, g, So, E); SEAM(k); } ++k;
            if (IN_(k)) REP_LOOP(k) { REFRESH(); pg8::Gemm g{(const bf16*)(act + A_HID), WT + WT_FDN + (size_t)f * 1024 * FF, FF, FF}; pg8::StaticOrder So; So.init(T, D, G, cid);
                pg8::EpiResid E{XB, XB, ss_ple}; pg8::gemm_phase(F.lds, g, So, E); SEAM(k); } ++k;
        } else {
            unsigned* cnt = F.ctl + CW_MOECNT + f * 1024;
            if (IN_(k)) REP_LOOP(k) { REFRESH();
                moe_route(F, XB, INP(I_FFN_NORM) + l * D, INP(I_MOE_W_ROUTER) + (size_t)f * D * NE, INP(I_MOE_B_ROUTER) + f * NE, cnt, F.ctl + CW_ROUTEPUB + f * 4096, m_idx, m_wl, m_rs, m_tpos); SEAM(k); } ++k;
            if (IN_(k)) REP_LOOP(k) { REFRESH(); __syncthreads(); pg8::Gemm g{XB, WM + WM_GU, 1024, 1024}; pg8::GroupedOrder<true> So; So.init(cnt, 28, G, cid, m_idx, (LAS int*)(F.lds + RING_BYTES + 1024));
                pg8::EpiSwiglu E{(bf16*)(act + A_HID), EF, 28, nullptr, m_rs, (LAS float*)(F.lds + RING_BYTES + 4096)}; pg8::gemm_phase(F.lds, g, So, E); SEAM(k); } ++k;
            if (IN_(k)) REP_LOOP(k) { REFRESH(); pg8::Gemm g{(const bf16*)(act + A_HID), WM + WM_DN, EF, EF}; pg8::GroupedOrder<false> So; So.init(cnt, 4, G, cid, nullptr, (LAS int*)(F.lds + RING_BYTES + 1024));
                const int ntail = So.nunits % G; int nsl = 0;
                if (ntail > 0 && So.nunits > G) nsl = ntail * 14 <= G ? 14 : ntail * 7 <= G ? 7 : ntail * 4 <= G ? 4 : ntail * 2 <= G ? 2 : 0;
                if (ntail * nsl > 256) nsl = 0;
                nsl = __builtin_amdgcn_readfirstlane(nsl);
                if (nsl) { So.nlim = So.nunits - ntail;
                    { const int ksl = EF / nsl; pg8::Gemm gs{(const bf16*)(act + A_HID), WM + WM_DN, ksl, EF, EF}; pg8::SliceOrder Ss{So, So.nlim, ntail, nsl, ksl * 2, G, cid};
                      pg8::EpiPartial Ep{(float*)(ws + WS_PT)}; pg8::gemm_phase(F.lds, gs, Ss, Ep); }
                    asm volatile("s_waitcnt vmcnt(0)" ::: "memory"); __syncthreads();
                    if (threadIdx.x == 0) { __builtin_amdgcn_fence(__ATOMIC_RELEASE, "agent"); asm volatile("s_waitcnt vmcnt(0)" ::: "memory"); xb_add(cnt + 768, 1u); } }
                pg8::EpiPlain<false> E{(bf16*)(act + A_Y), D, 4, nullptr, 0.f, m_wl, nullptr, nullptr}; pg8::gemm_phase(F.lds, g, So, E);
                if (nsl) { REFRESH();
                    if (threadIdx.x == 0) { XB_SPIN(xb_ld(cnt + 768) < (unsigned)G, F.ctl + CW_BAR); __builtin_amdgcn_fence(__ATOMIC_ACQUIRE, "agent"); asm volatile("s_waitcnt vmcnt(0)" ::: "memory"); }
                    __syncthreads();
                    tail_reduce(F, So, So.nlim, ntail, nsl, (const float*)(ws + WS_PT), (bf16*)(act + A_Y), m_wl); }
                SEAM(k); } ++k;
            if (IN_(k)) REP_LOOP(k) { REFRESH(); moe_combine(F, XB, ss_ple, (const bf16*)(act + A_Y), cnt, m_tpos); SEAM(k); } ++k;
        }
        if (IN_(k)) REP_LOOP(k) { REFRESH(); { pg8::Gemm g{PB + (size_t)l * T * PLE, WT + WT_PIN + (size_t)l * 1024 * 256, 256, 256}; pg8::StaticOrder So; So.init(T, D, G, cid);
              pg8::EpiPlain<false> E{PT, D, 4, nullptr, 0.f, nullptr, nullptr, nullptr}; pg8::gemm_phase(F.lds, g, So, E); }
            { pg8::Gemm g{XB, WT + WT_PG + (size_t)l * D * D, 1024, 1024}; pg8::StaticOrder So; So.init(T, D, G, cid);
              pg8::EpiPle E{PT, XB, XA, l == DEPTH - 1 ? out : nullptr, ss_ple, ss_next}; pg8::gemm_phase(F.lds, g, So, E); } SEAM(k); } ++k;
    }
    { constexpr int l = 3;
        const int kind = l % 3, jm = l / 3, f = l >> 1;
        const ssq_t* ss_attn = SS + (size_t)(3 * l) * T; ssq_t* ss_ffn = SS + (size_t)(3 * l + 1) * T; ssq_t* ss_ple = SS + (size_t)(3 * l + 2) * T; ssq_t* ss_next = l < 3 ? SS + (size_t)(3 * l + 3) * T : nullptr;
        if (kind == 0) {
            if (IN_(k)) REP_LOOP(k) { REFRESH(); pg8::Gemm g{XA, WT + WT_DOWN + (size_t)jm * 512 * 1024, 1024, 1024}; pg8::StaticOrder So; So.init(T, 512, G, cid);
                pg8::EpiPlain<true> E{(bf16*)(act + A_C), 512, 2, ss_attn, 1.0f / D, nullptr, SSC + (size_t)jm * T, SSC + (size_t)(2 + jm) * T};
                pg8::gemm_phase(F.lds, g, So, E); SEAM(k); } ++k;
            if (IN_(k)) REP_LOOP(k) { REFRESH(); { pg8::Gemm g{(const bf16*)(act + A_C), WT + WT_UQ + (size_t)jm * 1536 * 256, 256, 512}; pg8::StaticOrder So; So.init(T, 1536, G, cid);
                  pg8::EpiPlain<false> E{(bf16*)(act + A_QR), 1536, 6, SSC + (size_t)jm * T, 1.0f / 256, nullptr, nullptr, nullptr}; pg8::gemm_phase(F.lds, g, So, E); }
                { int k128_ = 128; asm volatile("" : "+s"(k128_));     pg8::Gemm g{(const bf16*)(act + A_C) + 256, WT + WT_UKV + (size_t)jm * 2560 * 256, k128_, 512}; pg8::StaticOrder So; So.init(T, 2048, G, cid);
                  pg8::EpiKN<true> E{(bf16*)(act + A_KV), 2560, 0, 4, 512, SSC + (size_t)(2 + jm) * T, 1.0f / 128, INP(I_MLA_K_GAIN) + jm * 96, (const bf16*)(act + A_C), (LAS float*)(F.lds + RING_BYTES + 4096)}; pg8::gemm_phase(F.lds, g, So, E); }
                SEAM(k); } ++k;
            if (IN_(k)) REP_LOOP(k) { REFRESH(); int it_ = 0; const int nit_ = (NB * 16 * 8 - vcu + G - 1) / G; const int stag_ = ((cid >> 3) & 7) % (nit_ > 0 ? nit_ : 1); constexpr int fc_ = l == 0 ? 0 : 1, lc_ = l == 0 ? 1 : 3;
                for (int u = vcu; u < NB * 16 * 8; u += G, ++it_) { const int qb = u & 7, h = (u >> 3) & 15, b = u >> 7;
                    if (it_ == stag_) {
                        __syncthreads();
                        REFRESH();
                        moe_cvt_all(F, INP(I_MOE_W_GATE) + (size_t)fc_ * NE * D * EF, INP(I_MOE_W_UP) + (size_t)fc_ * NE * D * EF, INP(I_MOE_W_DOWN) + (size_t)fc_ * NE * EF * D, INP(I_FFN_NORM) + lc_ * D, WM);
                        if (l == 0) { LATE_WEIGHTS(); cvt_flat(F, INP(I_P), PB, (size_t)4 * T * PLE / 8); }
                        __syncthreads(); }
                    fa::attn_unit<96, 64, 0, 0, 1536, 2560, 2560, D, 2>((const bf16*)(act + A_QR) + (size_t)(b * S + qb * 256) * 1536 + h * 96, (const bf16*)(act + A_KV) + (size_t)b * S * 2560 + h * 64,
                                          (const bf16*)(act + A_KV) + (size_t)b * S * 2560 + 1536 + h * 64, (bf16*)(act + A_O) + (size_t)(b * S + qb * 256) * D + h * 64, S / 64, qb * 256, 0, 0.f, 0.f, INP(I_MLA_Q_GAIN) + jm * 96, 1024 - 32 * h, F.lds); } SEAM(k); } ++k;
        } else if (kind == 1) {
            if (IN_(k)) REP_LOOP(k) { REFRESH(); pg8::Gemm g{XA, WT + WT_SQKV, 1024, 1024}; pg8::StaticOrder So; So.init(T, 1536, G, cid);
                pg8::EpiKN<false> E{(bf16*)(act + 0), 1536, 4, 5, 0, ss_attn, 1.0f / D, INP(I_SWA_K_GAIN), nullptr, (LAS float*)(F.lds + RING_BYTES + 4096)}; pg8::gemm_phase(F.lds, g, So, E); SEAM(k); } ++k;
            if (IN_(k)) REP_LOOP(k) { REFRESH(); for (int u = vcu; u < NB * 16 * 8; u += G) { const int qb = u & 7, h = (u >> 3) & 15, b = u >> 7; const int gq = h >> 2;
                    const float slope2 = exp2f(-8.0f * (float)(h + 1) / 16.0f) * LOG2E, sink2 = INP(I_SWA_SINK)[h] * LOG2E;
                    const int q0 = qb * 256, klo = q0 - 128 < 0 ? 0 : q0 - 128, khi = q0 + 384 > S ? S : q0 + 384;
                    fa::attn_unit<64, 64, 1, 1, 1536, 1536, 1536, D, 2>((const bf16*)(act + 0) + (size_t)(b * S + q0) * 1536 + h * 64, (const bf16*)(act + 0) + (size_t)(b * S + klo) * 1536 + 1024 + gq * 64,
                                          (const bf16*)(act + 0) + (size_t)(b * S + klo) * 1536 + 1280 + gq * 64, (bf16*)(act + A_O) + (size_t)(b * S + q0) * D + h * 64, (khi - klo) / 64, q0, klo, slope2, sink2, INP(I_SWA_Q_GAIN), 0, F.lds); } SEAM(k); } ++k;
        } else {
            if (IN_(k)) REP_LOOP(k) { REFRESH(); pg8::Gemm g{XA, WT + WT_AQKV, 1024, 1024}; pg8::StaticOrder So; So.init(T, 2048, G, cid);
                pg8::EpiPlain<false> E{(bf16*)(act + 0), 2048, 8, ss_attn, 1.0f / D, nullptr, nullptr, nullptr}; pg8::gemm_phase(F.lds, g, So, E); SEAM(k); } ++k;
            if (IN_(k)) REP_LOOP(k) { REFRESH(); ax_kprep(F, (bf16*)(act + 0), INP(I_AX_K_GAIN)); SEAM(k); } ++k;
            if (IN_(k)) REP_LOOP(k) { REFRESH(); for (int u = vcu; u < NB * 8 * 8; u += G) { const int qb = u & 7, h = (u >> 3) & 7, b = u >> 6; const int gq = h >> 1;
                    fa::attn_unit<128, 128, 0, 2, 2048, 2048, 2048, D, 1>((const bf16*)(act + 0) + (size_t)(b * S + qb * 256) * 2048 + h * 128, (const bf16*)(act + 0) + (size_t)b * S * 2048 + 1024 + gq * 128,
                                            (const bf16*)(act + 0) + (size_t)b * S * 2048 + 1536 + gq * 128, (bf16*)(act + A_O) + (size_t)(b * S + qb * 256) * D + h * 128, S / 64, qb * 256, 0, 0.f, 0.f, INP(I_AX_Q_GAIN), 0, F.lds); } SEAM(k); } ++k;
        }
        if (IN_(k)) REP_LOOP(k) { REFRESH(); __syncthreads(); pg8::Gemm g{(const bf16*)(act + A_O), WT + WT_WO + (size_t)l * D * D, 1024, 1024}; pg8::StaticOrder So; So.init(T, D, G, cid);
            pg8::EpiResid E{XA, XB, ss_ffn}; pg8::gemm_phase(F.lds, g, So, E); SEAM(k); } ++k;
        if ((l & 1) == 0) {
            if (IN_(k)) REP_LOOP(k) { REFRESH(); pg8::Gemm g{XB, WT + WT_FGU + (size_t)f * 5632 * 1024, 1024, 1024}; pg8::StaticOrder So; So.init(T, 5632, G, cid);
                pg8::EpiSwiglu E{(bf16*)(act + A_HID), FF, 22, ss_ffn, nullptr, (LAS float*)(F.lds + RING_BYTES + 4096)}; pg8::gemm_phase(F.lds, g, So, E); SEAM(k); } ++k;
            if (IN_(k)) REP_LOOP(k) { REFRESH(); pg8::Gemm g{(const bf16*)(act + A_HID), WT + WT_FDN + (size_t)f * 1024 * FF, FF, FF}; pg8::StaticOrder So; So.init(T, D, G, cid);
                pg8::EpiResid E{XB, XB, ss_ple}; pg8::gemm_phase(F.lds, g, So, E); SEAM(k); } ++k;
        } else {
            unsigned* cnt = F.ctl + CW_MOECNT + f * 1024;
            if (IN_(k)) REP_LOOP(k) { REFRESH();
                moe_route(F, XB, INP(I_FFN_NORM) + l * D, INP(I_MOE_W_ROUTER) + (size_t)f * D * NE, INP(I_MOE_B_ROUTER) + f * NE, cnt, F.ctl + CW_ROUTEPUB + f * 4096, m_idx, m_wl, m_rs, m_tpos); SEAM(k); } ++k;
            if (IN_(k)) REP_LOOP(k) { REFRESH(); __syncthreads(); pg8::Gemm g{XB, WM + WM_GU, 1024, 1024}; pg8::GroupedOrder<true> So; So.init(cnt, 28, G, cid, m_idx, (LAS int*)(F.lds + RING_BYTES + 1024));
                pg8::EpiSwiglu E{(bf16*)(act + A_HID), EF, 28, nullptr, m_rs, (LAS float*)(F.lds + RING_BYTES + 4096)}; pg8::gemm_phase(F.lds, g, So, E); SEAM(k); } ++k;
            if (IN_(k)) REP_LOOP(k) { REFRESH(); pg8::Gemm g{(const bf16*)(act + A_HID), WM + WM_DN, EF, EF}; pg8::GroupedOrder<false> So; So.init(cnt, 4, G, cid, nullptr, (LAS int*)(F.lds + RING_BYTES + 1024));
                const int ntail = So.nunits % G; int nsl = 0;
                if (ntail > 0 && So.nunits > G) nsl = ntail * 14 <= G ? 14 : ntail * 7 <= G ? 7 : ntail * 4 <= G ? 4 : ntail * 2 <= G ? 2 : 0;
                if (ntail * nsl > 256) nsl = 0;
                nsl = __builtin_amdgcn_readfirstlane(nsl);
                if (nsl) { So.nlim = So.nunits - ntail;
                    { const int ksl = EF / nsl; pg8::Gemm gs{(const bf16*)(act + A_HID), WM + WM_DN, ksl, EF, EF}; pg8::SliceOrder Ss{So, So.nlim, ntail, nsl, ksl * 2, G, cid};
                      pg8::EpiPartial Ep{(float*)(ws + WS_PT)}; pg8::gemm_phase(F.lds, gs, Ss, Ep); }
                    asm volatile("s_waitcnt vmcnt(0)" ::: "memory"); __syncthreads();
                    if (threadIdx.x == 0) { __builtin_amdgcn_fence(__ATOMIC_RELEASE, "agent"); asm volatile("s_waitcnt vmcnt(0)" ::: "memory"); xb_add(cnt + 768, 1u); } }
                pg8::EpiPlain<false> E{(bf16*)(act + A_Y), D, 4, nullptr, 0.f, m_wl, nullptr, nullptr}; pg8::gemm_phase(F.lds, g, So, E);
                if (nsl) { REFRESH();
                    if (threadIdx.x == 0) { XB_SPIN(xb_ld(cnt + 768) < (unsigned)G, F.ctl + CW_BAR); __builtin_amdgcn_fence(__ATOMIC_ACQUIRE, "agent"); asm volatile("s_waitcnt vmcnt(0)" ::: "memory"); }
                    __syncthreads();
                    tail_reduce(F, So, So.nlim, ntail, nsl, (const float*)(ws + WS_PT), (bf16*)(act + A_Y), m_wl); }
                SEAM(k); } ++k;
            if (IN_(k)) REP_LOOP(k) { REFRESH(); moe_combine(F, XB, ss_ple, (const bf16*)(act + A_Y), cnt, m_tpos); SEAM(k); } ++k;
        }
        if (IN_(k)) REP_LOOP(k) { REFRESH(); { pg8::Gemm g{PB + (size_t)l * T * PLE, WT + WT_PIN + (size_t)l * 1024 * 256, 256, 256}; pg8::StaticOrder So; So.init(T, D, G, cid);
              pg8::EpiPlain<false> E{PT, D, 4, nullptr, 0.f, nullptr, nullptr, nullptr}; pg8::gemm_phase(F.lds, g, So, E); }
            { pg8::Gemm g{XB, WT + WT_PG + (size_t)l * D * D, 1024, 1024}; pg8::StaticOrder So; So.init(T, D, G, cid);
              pg8::EpiPle E{PT, XB, XA, l == DEPTH - 1 ? out : nullptr, ss_ple, ss_next}; pg8::gemm_phase(F.lds, g, So, E); } SEAM(k); } ++k;
    }
}

#undef ws
#undef out
#undef act
#undef WT
#undef WM
#undef XB
#undef PB
#undef PT
#undef XA
#undef SS
#undef SSC
#undef m_idx
#undef m_wl
#undef m_tpos
#undef m_rs
extern "C" void kernel_launch(void* const* d_in, const int* in_sizes, int n_in, void* d_out, int out_size, void* d_ws, size_t ws_size, hipStream_t stream) {
    static int grid = 0;
    if (grid == 0) {
        if (n_in != N_IN || in_sizes[0] != T * D || out_size != T * D || ws_size < WS_END) { fprintf(stderr, "kernel_launch: shape mismatch n_in %d in0 %d out %d ws %zu (need %zu)\n", n_in, n_in > 0 ? in_sizes[0] : -1, out_size, ws_size, (size_t)WS_END); grid = -1; return; }
        int dev = 0, cus = 0;
        if (hipGetDevice(&dev) != hipSuccess || hipDeviceGetAttribute(&cus, hipDeviceAttributeMultiprocessorCount, dev) != hipSuccess) { grid = -1; return; }
        if (hipFuncSetAttribute((const void*)mega, hipFuncAttributeMaxDynamicSharedMemorySize, LDS_BYTES) != hipSuccess) { fprintf(stderr, "kernel_launch: hipFuncSetAttribute failed\n"); grid = -1; return; }
        int per_cu = 0;
        if (hipOccupancyMaxActiveBlocksPerMultiprocessor(&per_cu, (const void*)mega, NTHREADS, LDS_BYTES) != hipSuccess || per_cu < 1) fprintf(stderr, "kernel_launch: occupancy query says %d\n", per_cu);
        (void)hipGetLastError();
        grid = cus;
    }
    if (grid < 0) return;
    if (hipMemsetAsync((char*)d_ws + WS_CTL, 0, CTL_ZERO_BYTES, stream) != hipSuccess) { fprintf(stderr, "kernel_launch: memset failed\n"); return; }
    Args a{};
    for (int i = 0; i < N_IN; ++i) a.in[i] = (const float*)d_in[i];
    a.out = (float*)d_out; a.ws = (unsigned char*)d_ws;
    if (MK_N_LAUNCHES == 1) { a.lo = 0; a.hi = N_STEPS; hipLaunchKernelGGL(mega, dim3(grid), dim3(NTHREADS), LDS_BYTES, stream, a); }
    else for (int s = 0; s < N_STEPS; ++s) { a.lo = s; a.hi = s + 1; hipLaunchKernelGGL(mega, dim3(grid), dim3(NTHREADS), LDS_BYTES, stream, a); }
    const hipError_t le = hipPeekAtLastError();
    if (le != hipSuccess) fprintf(stderr, "kernel_launch: launch failed: %s\n", hipGetErrorName(le));
}
```
